# Optimizing an MI355X kernel written in HIP

```python
import math
import jax, jax.numpy as jnp
from jax import lax
import numpy as np

D_MODEL = 1024
BATCH = 8
SEQ = 8192
DEPTH = 4

MEM_LEN = 256
Q_BLOCK = 128
NSA_Q_BLOCK = 64
NEG_INF = -1e30
EPS = 1e-6
SEL_FORCE = 1e9

NUM_BUCKETS = 32
REL_MAX_DIST = 128
BIAS_HEADS = 8

MLA_HEADS = 8
MLA_Q_RANK = 256
MLA_KV_RANK = 128
MLA_NOPE = 64
MLA_ROPE = 32
MLA_V = 64
ROPE_BASE = 10000.0

SWA_HEADS = 8
SWA_KV_HEADS = 2
SWA_HEAD_DIM = 64
SWA_WINDOW = 128

NSA_HEADS = 8
NSA_KV_HEADS = 2
NSA_HEAD_DIM = 64
CMP_LEN = 32
CMP_STRIDE = 16
CMP_HIDDEN = 256
SEL_LEN = 64
SEL_TOP_N = 16
NSA_WINDOW = 512

MEM_HEADS = 4
MEM_HEAD_DIM = 128

MLA_W = MLA_HEADS * MLA_V
SWA_W = SWA_HEADS * SWA_HEAD_DIM
SWA_KV_W = SWA_KV_HEADS * SWA_HEAD_DIM
NSA_W = NSA_HEADS * NSA_HEAD_DIM
NSA_KV_W = NSA_KV_HEADS * NSA_HEAD_DIM
MEM_W = MEM_HEADS * MEM_HEAD_DIM

EVEN_SPLITS = (MLA_Q_RANK, MLA_KV_RANK, MLA_ROPE, MLA_W,
               SWA_W, SWA_KV_W, SWA_KV_W, SWA_W,
               MEM_W, MEM_W)
ODD_SPLITS = (NSA_W,
              NSA_KV_W, NSA_KV_W,
              NSA_KV_W, NSA_KV_W,
              NSA_KV_W, NSA_KV_W,
              NSA_HEADS * 3,
              NSA_W,
              MEM_W, MEM_W)
EVEN_IN = sum(EVEN_SPLITS)
ODD_IN = sum(ODD_SPLITS)
EVEN_OUT = MLA_W + SWA_W + MEM_W
ODD_OUT = NSA_W + MEM_W
N_EVEN = (DEPTH + 1) // 2
N_ODD = DEPTH // 2

kernel_name = "hybrid_mla_swa_nsa_memory_trunk"


def split_cols(x, sizes):
    cuts = [int(c) for c in np.cumsum(sizes)[:-1]]
    return jnp.split(x, cuts, axis=-1)


def rms_norm(x, g):
    xf = x.astype(jnp.float32)
    y = xf * lax.rsqrt(jnp.mean(jnp.square(xf), axis=-1, keepdims=True) + EPS)
    return (y * g.astype(jnp.float32)).astype(x.dtype)


def rope(x, pos):
    half = x.shape[-1] // 2
    inv = ROPE_BASE ** (-jnp.arange(half, dtype=jnp.float32) / half)
    ang = pos.astype(jnp.float32)[:, None] * inv[None, :]
    cos = jnp.cos(ang)[None, :, None, :]
    sin = jnp.sin(ang)[None, :, None, :]
    x1 = x[..., :half].astype(jnp.float32)
    x2 = x[..., half:].astype(jnp.float32)
    return jnp.concatenate([x1 * cos - x2 * sin, x2 * cos + x1 * sin], axis=-1).astype(x.dtype)


def t5_bucket(dist):
    max_exact = NUM_BUCKETS // 2
    d = jnp.maximum(dist, 0)
    log_ratio = jnp.log(jnp.maximum(d, 1).astype(jnp.float32) / max_exact) / math.log(REL_MAX_DIST / max_exact)
    large = max_exact + (log_ratio * (NUM_BUCKETS - max_exact)).astype(jnp.int32)
    return jnp.where(d < max_exact, d, jnp.minimum(large, NUM_BUCKETS - 1))


def rel_bias(table, dist, n_groups):
    b = table.astype(jnp.float32)[t5_bucket(dist)]
    q, k, h = b.shape
    return jnp.transpose(b, (2, 0, 1)).reshape(n_groups, h // n_groups, q, k)


def masked_softmax(logits, mask, sink=None):
    logits = jnp.where(mask, logits, NEG_INF)
    m = jnp.max(logits, axis=-1, keepdims=True)
    if sink is not None:
        m = jnp.maximum(m, sink)
    p = jnp.where(mask, jnp.exp(logits - m), 0.0)
    denom = jnp.sum(p, axis=-1, keepdims=True)
    if sink is not None:
        denom = denom + jnp.exp(sink - m)
    return p / jnp.maximum(denom, 1e-30)


def sweep(fn, n_blocks):
    out = lax.map(fn, jnp.arange(n_blocks))
    out = jnp.moveaxis(out, 0, 1)
    return out.reshape(out.shape[0], -1, *out.shape[3:])


def mla_attention(c_q, c_kv, k_rope, pos, q_norm, kv_norm, w_uq, w_ukv):
    B, S, _ = c_q.shape
    q = (rms_norm(c_q, q_norm) @ w_uq).reshape(B, S, MLA_HEADS, MLA_NOPE + MLA_ROPE)
    q_nope = q[..., :MLA_NOPE]
    q_pe = rope(q[..., MLA_NOPE:], pos)
    kv = (rms_norm(c_kv, kv_norm) @ w_ukv).reshape(B, S, MLA_HEADS, MLA_NOPE + MLA_V)
    k_nope, v = kv[..., :MLA_NOPE], kv[..., MLA_NOPE:]
    k_pe = rope(k_rope[:, :, None, :], pos)[:, :, 0, :]
    scale = (MLA_NOPE + MLA_ROPE) ** -0.5
    k_idx = jnp.arange(S)

    def block(i):
        s0 = i * Q_BLOCK
        qn = lax.dynamic_slice_in_dim(q_nope, s0, Q_BLOCK, axis=1)
        qp = lax.dynamic_slice_in_dim(q_pe, s0, Q_BLOCK, axis=1)
        logits = (jnp.einsum('bqhd,bkhd->bhqk', qn, k_nope)
                  + jnp.einsum('bqhd,bkd->bhqk', qp, k_pe)).astype(jnp.float32) * scale
        mask = (s0 + jnp.arange(Q_BLOCK))[:, None] >= k_idx[None, :]
        p = masked_softmax(logits, mask)
        return jnp.einsum('bhqk,bkhd->bqhd', p.astype(v.dtype), v).reshape(B, Q_BLOCK, MLA_W)

    return sweep(block, S // Q_BLOCK)


def banded_attention(q, k, v, pos, table, window, sinks=None):
    B, S, H, d = q.shape
    G = k.shape[2]
    R = H // G
    pad = -(-(window - 1) // Q_BLOCK) * Q_BLOCK
    kl = pad + Q_BLOCK
    kp = jnp.pad(k, ((0, 0), (pad, 0), (0, 0), (0, 0)))
    vp = jnp.pad(v, ((0, 0), (pad, 0), (0, 0), (0, 0)))
    posp = jnp.pad(pos, (pad, 0))
    scale = d ** -0.5
    sink = None if sinks is None else sinks.astype(jnp.float32).reshape(G, R)[None, :, :, None, None]

    def block(i):
        s0 = i * Q_BLOCK
        qb = lax.dynamic_slice_in_dim(q, s0, Q_BLOCK, axis=1).reshape(B, Q_BLOCK, G, R, d)
        kb = lax.dynamic_slice_in_dim(kp, s0, kl, axis=1)
        vb = lax.dynamic_slice_in_dim(vp, s0, kl, axis=1)
        q_idx = s0 + jnp.arange(Q_BLOCK)
        k_idx = s0 - pad + jnp.arange(kl)
        delta = q_idx[:, None] - k_idx[None, :]
        mask = (k_idx[None, :] >= 0) & (delta >= 0) & (delta < window)
        dist = (lax.dynamic_slice_in_dim(pos, s0, Q_BLOCK)[:, None]
                - lax.dynamic_slice_in_dim(posp, s0, kl)[None, :])
        logits = (jnp.einsum('bqgrd,bkgd->bgrqk', qb, kb).astype(jnp.float32) * scale
                  + rel_bias(table, dist, G))
        p = masked_softmax(logits, mask, sink)
        return jnp.einsum('bgrqk,bkgd->bqgrd', p.astype(v.dtype), vb).reshape(B, Q_BLOCK, H * d)

    return sweep(block, S // Q_BLOCK)


def memory_attention(q, mem_n, w_mem_kv):
    B, S, _ = q.shape
    M = mem_n.shape[1]
    kv = mem_n @ w_mem_kv
    k = kv[..., :MEM_W].reshape(B, M, MEM_HEADS, MEM_HEAD_DIM)
    v = kv[..., MEM_W:].reshape(B, M, MEM_HEADS, MEM_HEAD_DIM)
    qh = q.reshape(B, S, MEM_HEADS, MEM_HEAD_DIM)
    logits = jnp.einsum('bshd,bmhd->bhsm', qh, k).astype(jnp.float32) * MEM_HEAD_DIM ** -0.5
    p = jax.nn.softmax(logits, axis=-1)
    return jnp.einsum('bhsm,bmhd->bshd', p.astype(v.dtype), v).reshape(B, S, MEM_W)


def compress_blocks(x, pos_emb, w1, w2):
    B, S, G, d = x.shape
    nc = (S - CMP_LEN) // CMP_STRIDE + 1
    idx = jnp.arange(nc)[:, None] * CMP_STRIDE + jnp.arange(CMP_LEN)[None, :]
    blk = x[:, idx] + pos_emb[None, None, :, None, :]
    flat = jnp.transpose(blk, (0, 1, 3, 2, 4)).reshape(B, nc, G, CMP_LEN * d)
    return jax.nn.silu(flat @ w1) @ w2


def nsa_compressed_selected(q, k_cmp, v_cmp, k_slc, v_slc, pos, table,
                            cmp_pos_k, cmp_pos_v, w1k, w2k, w1v, w2v):
    B, S, H, d = q.shape
    G = k_slc.shape[2]
    R = H // G
    scale = d ** -0.5
    kc = compress_blocks(k_cmp, cmp_pos_k, w1k, w2k)
    vc = compress_blocks(v_cmp, cmp_pos_v, w1v, w2v)
    nc = kc.shape[1]
    c_start = jnp.arange(nc) * CMP_STRIDE
    c_end = c_start + CMP_LEN - 1
    c_pos = pos[c_end]
    ns = S // SEL_LEN
    top_n = min(SEL_TOP_N, ns)
    s_start = jnp.arange(ns) * SEL_LEN
    overlap = jnp.maximum(jnp.minimum(c_start[:, None] + CMP_LEN, s_start[None, :] + SEL_LEN)
                          - jnp.maximum(c_start[:, None], s_start[None, :]), 0)
    cmp_to_sel = overlap.astype(jnp.float32) / CMP_LEN
    ks = k_slc.reshape(B, ns, SEL_LEN, G, d).transpose(0, 3, 1, 2, 4)
    vs = v_slc.reshape(B, ns, SEL_LEN, G, d).transpose(0, 3, 1, 2, 4)
    gather = jax.vmap(jax.vmap(lambda blocks, ids: blocks[ids]))
    tbl_g = table.astype(jnp.float32).reshape(NUM_BUCKETS, G, R).transpose(1, 0, 2)
    QB = NSA_Q_BLOCK
    KS = top_n * SEL_LEN

    def block(i):
        s0 = i * QB
        qb = lax.dynamic_slice_in_dim(q, s0, QB, axis=1).reshape(B, QB, G, R, d)
        q_idx = s0 + jnp.arange(QB)
        q_pos = lax.dynamic_slice_in_dim(pos, s0, QB)
        logits = (jnp.einsum('bqgrd,bcgd->bgrqc', qb, kc).astype(jnp.float32) * scale
                  + rel_bias(table, q_pos[:, None] - c_pos[None, :], G))
        p_cmp = masked_softmax(logits, c_end[None, :] <= q_idx[:, None])
        o_cmp = jnp.einsum('bgrqc,bcgd->bqgrd', p_cmp.astype(vc.dtype), vc).reshape(B, QB, H * d)
        imp = jnp.einsum('bgqc,cj->bgqj', jnp.sum(p_cmp, axis=2), cmp_to_sel)
        j = jnp.arange(ns)[None, :]
        cur = (q_idx // SEL_LEN)[:, None]
        forced = (j == 0) | (j == cur) | (j == cur - 1)
        causal = j * SEL_LEN <= q_idx[:, None]
        score = jnp.where(forced, SEL_FORCE, jnp.where(causal, imp, -SEL_FORCE))
        _, sel = lax.top_k(score, top_n)
        kg = gather(ks, sel)
        vg = gather(vs, sel).reshape(B, G, QB, KS, d)
        tok = sel[..., None] * SEL_LEN + jnp.arange(SEL_LEN)
        tmask = (tok <= q_idx[None, None, :, None, None]).reshape(B, G, 1, QB, KS)
        bucket = t5_bucket(q_pos[None, None, :, None, None] - pos[tok])
        bias = tbl_g[jnp.arange(G)[None, :, None, None, None], bucket]
        bias = jnp.moveaxis(bias, -1, 2).reshape(B, G, R, QB, KS)
        logits = (jnp.einsum('bqgrd,bgqnld->bgrqnl', qb, kg).reshape(B, G, R, QB, KS).astype(jnp.float32)
                  * scale + bias)
        p_slc = masked_softmax(logits, tmask)
        o_slc = jnp.einsum('bgrqk,bgqkd->bqgrd', p_slc.astype(vg.dtype), vg).reshape(B, QB, H * d)
        return jnp.concatenate([o_cmp, o_slc], axis=-1)

    out = sweep(block, S // QB)
    return out[..., :H * d], out[..., H * d:]


def even_layer(h, mem_n, pos, table, w_in, q_norm, kv_norm, w_uq, w_ukv, sinks, w_mem_kv, w_out):
    B, S, _ = h.shape
    (c_q, c_kv, k_rope, g_mla, q_swa, k_swa, v_swa, g_swa,
     q_mem, g_mem) = split_cols(h @ w_in, EVEN_SPLITS)
    o_mla = mla_attention(c_q, c_kv, k_rope, pos, q_norm, kv_norm, w_uq, w_ukv) * jax.nn.silu(g_mla)
    o_swa = banded_attention(q_swa.reshape(B, S, SWA_HEADS, SWA_HEAD_DIM),
                             k_swa.reshape(B, S, SWA_KV_HEADS, SWA_HEAD_DIM),
                             v_swa.reshape(B, S, SWA_KV_HEADS, SWA_HEAD_DIM),
                             pos, table, SWA_WINDOW, sinks) * jax.nn.silu(g_swa)
    o_mem = memory_attention(q_mem, mem_n, w_mem_kv) * jax.nn.silu(g_mem)
    return jnp.concatenate([o_mla, o_swa, o_mem], axis=-1) @ w_out


def odd_layer(h, mem_n, pos, table, w_in, cmp_pos_k, cmp_pos_v, w1k, w2k, w1v, w2v, w_mem_kv, w_out):
    B, S, _ = h.shape
    (q, k_cmp, v_cmp, k_slc, v_slc, k_win, v_win, g_logit, g_nsa,
     q_mem, g_mem) = split_cols(h @ w_in, ODD_SPLITS)
    qh = q.reshape(B, S, NSA_HEADS, NSA_HEAD_DIM)
    kvh = lambda t: t.reshape(B, S, NSA_KV_HEADS, NSA_HEAD_DIM)
    o_cmp, o_slc = nsa_compressed_selected(qh, kvh(k_cmp), kvh(v_cmp), kvh(k_slc), kvh(v_slc), pos, table,
                                           cmp_pos_k, cmp_pos_v, w1k, w2k, w1v, w2v)
    o_win = banded_attention(qh, kvh(k_win), kvh(v_win), pos, table, NSA_WINDOW)
    g = jax.nn.sigmoid(g_logit.astype(jnp.float32)).reshape(B, S, NSA_HEADS, 3, 1).astype(h.dtype)
    per_head = lambda o: o.reshape(B, S, NSA_HEADS, NSA_HEAD_DIM)
    o_nsa = (g[..., 0, :] * per_head(o_cmp) + g[..., 1, :] * per_head(o_slc)
             + g[..., 2, :] * per_head(o_win)).reshape(B, S, NSA_W) * jax.nn.silu(g_nsa)
    o_mem = memory_attention(q_mem, mem_n, w_mem_kv) * jax.nn.silu(g_mem)
    return jnp.concatenate([o_nsa, o_mem], axis=-1) @ w_out


def setup_inputs(seed: int = 0) -> dict:
    key = jax.random.key(seed)
    ks = jax.random.split(key, 24)
    f32 = jnp.float32

    def nrm(k, shape, scale):
        return jax.random.normal(k, shape, f32) * scale

    def gain(k, shape):
        return 1.0 + 0.1 * jax.random.normal(k, shape, f32)

    offset = jax.random.randint(ks[2], (), 0, 1024, dtype=jnp.int32)
    d = NSA_HEAD_DIM
    return {
        "x": nrm(ks[0], (BATCH, SEQ, D_MODEL), 1.0),
        "mem": nrm(ks[1], (BATCH, MEM_LEN, D_MODEL), 1.0),
        "positions": offset + jnp.arange(SEQ, dtype=jnp.int32),
        "rel_bias_table": nrm(ks[3], (NUM_BUCKETS, BIAS_HEADS), 0.5),
        "norm_pre": gain(ks[4], (DEPTH, D_MODEL)),
        "norm_post": gain(ks[5], (DEPTH, D_MODEL)),
        "mem_norm": gain(ks[6], (DEPTH, D_MODEL)),
        "w_mem_kv": nrm(ks[7], (DEPTH, D_MODEL, 2 * MEM_W), D_MODEL ** -0.5),
        "w_in_even": nrm(ks[8], (N_EVEN, D_MODEL, EVEN_IN), D_MODEL ** -0.5),
        "mla_q_norm": gain(ks[9], (N_EVEN, MLA_Q_RANK)),
        "mla_kv_norm": gain(ks[10], (N_EVEN, MLA_KV_RANK)),
        "mla_w_uq": nrm(ks[11], (N_EVEN, MLA_Q_RANK, MLA_HEADS * (MLA_NOPE + MLA_ROPE)), MLA_Q_RANK ** -0.5),
        "mla_w_ukv": nrm(ks[12], (N_EVEN, MLA_KV_RANK, MLA_HEADS * (MLA_NOPE + MLA_V)), MLA_KV_RANK ** -0.5),
        "swa_sinks": nrm(ks[13], (N_EVEN, SWA_HEADS), 1.0),
        "w_out_even": nrm(ks[14], (N_EVEN, EVEN_OUT, D_MODEL), EVEN_OUT ** -0.5),
        "w_in_odd": nrm(ks[15], (N_ODD, D_MODEL, ODD_IN), D_MODEL ** -0.5),
        "cmp_pos_k": nrm(ks[16], (N_ODD, CMP_LEN, d), 0.1),
        "cmp_pos_v": nrm(ks[17], (N_ODD, CMP_LEN, d), 0.1),
        "cmp_w1_k": nrm(ks[18], (N_ODD, CMP_LEN * d, CMP_HIDDEN), (CMP_LEN * d) ** -0.5),
        "cmp_w2_k": nrm(ks[19], (N_ODD, CMP_HIDDEN, d), CMP_HIDDEN ** -0.5),
        "cmp_w1_v": nrm(ks[20], (N_ODD, CMP_LEN * d, CMP_HIDDEN), (CMP_LEN * d) ** -0.5),
        "cmp_w2_v": nrm(ks[21], (N_ODD, CMP_HIDDEN, d), CMP_HIDDEN ** -0.5),
        "w_out_odd": nrm(ks[22], (N_ODD, ODD_OUT, D_MODEL), ODD_OUT ** -0.5),
    }


def reference(x, mem, positions, rel_bias_table, norm_pre, norm_post, mem_norm, w_mem_kv,
              w_in_even, mla_q_norm, mla_kv_norm, mla_w_uq, mla_w_ukv, swa_sinks, w_out_even,
              w_in_odd, cmp_pos_k, cmp_pos_v, cmp_w1_k, cmp_w2_k, cmp_w1_v, cmp_w2_v, w_out_odd):
    for l in range(DEPTH):
        h = rms_norm(x, norm_pre[l])
        mem_n = rms_norm(mem, mem_norm[l])
        if l % 2 == 0:
            e = l // 2
            y = even_layer(h, mem_n, positions, rel_bias_table, w_in_even[e], mla_q_norm[e],
                           mla_kv_norm[e], mla_w_uq[e], mla_w_ukv[e], swa_sinks[e], w_mem_kv[l],
                           w_out_even[e])
        else:
            o = l // 2
            y = odd_layer(h, mem_n, positions, rel_bias_table, w_in_odd[o], cmp_pos_k[o], cmp_pos_v[o],
                          cmp_w1_k[o], cmp_w2_k[o], cmp_w1_v[o], cmp_w2_v[o], w_mem_kv[l], w_out_odd[o])
        x = x + rms_norm(y, norm_post[l])
    return x
```

```cpp
#include <hip/hip_runtime.h>
#include <stdint.h>
#include <stdio.h>

#ifndef MK_PER_PHASE
#define MK_PER_PHASE 0
#endif
#define LAS __attribute__((address_space(3)))
typedef unsigned short bf16_t;
typedef short bf16x8 __attribute__((ext_vector_type(8)));
typedef short s16x4 __attribute__((ext_vector_type(4)));
typedef float f32x16 __attribute__((ext_vector_type(16)));
typedef float f32x4 __attribute__((ext_vector_type(4)));
typedef float f32x2 __attribute__((ext_vector_type(2)));
typedef unsigned u32x4 __attribute__((ext_vector_type(4)));
typedef unsigned u32x2 __attribute__((ext_vector_type(2)));

constexpr int DM = 1024, NB = 8, S = 8192, T = NB * S, MEML = 256;
constexpr int PE = 3328, PO = 3072, QKVW = 1792;
constexpr float EPS = 1e-6f;
constexpr float LOG2E = 1.4426950408889634f;
constexpr float NEG = -1e30f;
constexpr int E_CQ = 0, E_CKV = 256, E_KSWA = 384, E_VSWA = 512, E_KPE = 640, E_GMLA = 768, E_QSWA = 1280, E_GSWA = 1792, E_QMEM = 2304, E_GMEM = 2816;
constexpr int O_Q = 0, O_KCMP = 512, O_VCMP = 640, O_KSLC = 768, O_VSLC = 896, O_KWIN = 1024, O_VWIN = 1152, O_GL = 1280, O_GNSA = 1536, O_QMEM = 2048, O_GMEM = 2560;

constexpr size_t MiB = 1u << 20;
constexpr size_t WS_CTL = 0, CTL_BYTES = 1 * MiB;
constexpr size_t WS_SSQX = 1 * MiB, WS_SSQQ = WS_SSQX + 256 * 1024, WS_SSQKV = WS_SSQQ + 256 * 1024, WS_SSQY = WS_SSQKV + 256 * 1024;
constexpr size_t WS_RSTDM = 2 * MiB;
constexpr size_t WS_PMM = 2 * MiB + 65536;
constexpr size_t WS_CPOS = 2 * MiB + 131072;
constexpr size_t WS_ROPE = 3 * MiB;
constexpr size_t WS_LUT = 4 * MiB;
constexpr size_t WS_PB = 4 * MiB + 65536;
constexpr size_t WS_WINE = 8 * MiB, WS_WINO = 21 * MiB, WS_WOUTE = 33 * MiB, WS_WOUTO = 39 * MiB, WS_WMKV = 43 * MiB, WS_WUP = 51 * MiB  , WS_WC1 = 54 * MiB;
constexpr size_t WS_MEMB = 58 * MiB, WS_MKV = 62 * MiB, WS_KC = 78 * MiB, WS_VC = 79 * MiB, WS_HC = 80 * MiB;
static_assert(WS_WUP + (size_t)2 * 1792 * 384 * 2 <= WS_WC1 && WS_WC1 + (size_t)4 * 256 * 2048 * 2 <= WS_MEMB && WS_HC + (size_t)2 * 8192 * 256 * 2 <= 88 * MiB, "workspace map");
constexpr size_t WS_SSQY16 = 90 * MiB, WS_SSQQ4 = 94 * MiB, WS_SSQKV4 = 95 * MiB;
constexpr size_t WS_A = 96 * MiB;
constexpr size_t WS_B = 288 * MiB;
constexpr size_t WS_C = 704 * MiB;
constexpr size_t WS_END = 928 * MiB;
constexpr int CW_BAR = 4096;
constexpr int CW_Q = 16384;

__device__ __forceinline__ float bf2f(bf16_t v) { return __uint_as_float(((unsigned)v) << 16); }
__device__ __forceinline__ bf16_t f2bf(float f) { unsigned u = __float_as_uint(f); return (bf16_t)((u + 0x7fffu + ((u >> 16) & 1u)) >> 16); }
__device__ __forceinline__ unsigned pk2(float lo, float hi) { typedef __bf16 bf2 __attribute__((ext_vector_type(2))); f32x2 v = {lo, hi}; return __builtin_bit_cast(unsigned, __builtin_convertvector(v, bf2)); }
__device__ __forceinline__ float silu_f(float v) { return v * __builtin_amdgcn_rcpf(1.f + __builtin_amdgcn_exp2f(-LOG2E * v)); }
__device__ __forceinline__ float sigm_f(float v) { return __builtin_amdgcn_rcpf(1.f + __builtin_amdgcn_exp2f(-LOG2E * v)); }
__device__ __forceinline__ int crow(int r, int hi) { return (r & 3) + 8 * (r >> 2) + 4 * hi; }
__device__ __forceinline__ float wave_sum(float v) {
#pragma unroll
    for (int o = 1; o < 64; o <<= 1) v += __shfl_xor(v, o);
    return v;
}
namespace pg8 {
#define PG8_LAS __attribute__((address_space(3)))
typedef unsigned short bf16_t;
typedef short bf16x8 __attribute__((ext_vector_type(8)));
typedef float f32x4 __attribute__((ext_vector_type(4)));
typedef unsigned u32x4 __attribute__((ext_vector_type(4)));
constexpr int BM = 256, BK = 64, HALF = 128, HTB = HALF * BK * 2  , STAGE_BYTES = 8 * HTB, NXCD = 8, WGM = 8;

__host__ __device__ __forceinline__ int lds_byte(int r, int c) { const int st = (r >> 4) * 2 + (c >> 5), rr = r & 15, cc = c & 31, ob = rr * 64 + cc * 2; return st * 1024 + (ob ^ (((ob >> 9) & 1) << 5)); }
__host__ __device__ __forceinline__ void stage_rc(int b, int& R, int& C) { const int st = b / 1024, sb = b % 1024, swz = sb ^ (((sb >> 9) & 1) << 5); R = (st >> 1) * 16 + swz / 64; C = (st & 1) * 32 + (swz % 64) / 2; }
__host__ __device__ __forceinline__ int perm32(int rho) { const int n = rho >> 4, i = rho & 15; return 8 * (i >> 2) + 4 * n + (i & 3); }

struct Unit { int pm, pn; };
struct Gemm { const bf16_t* A; const bf16_t* Bt; int K; int lda2, ldb2, kstepA, amode; };
__device__ __forceinline__ const char* a_tile(const Gemm& g, int pm) { if (g.amode == 0) return (const char*)g.A + (size_t)pm * 256 * g.lda2;
    const int kv = pm >> 7, kq = (pm >> 5) & 3, p32 = pm & 31, bg = p32 >> 1, b = bg >> 1, gg = bg & 1, half = p32 & 1;
    return (const char*)g.A + ((size_t)(b * 8192 + 4096 * half + 8 * kq) * 3072 + gg * 64 + kv * 128) * 2; }
__device__ __forceinline__ const char* b_tile(const Gemm& g, int pm, int pn) { if (g.amode == 0) return (const char*)g.Bt + (size_t)pn * 256 * g.ldb2;
    const int kv = pm >> 7, kq = (pm >> 5) & 3; return (const char*)g.Bt + ((size_t)kv * 256 * 2048 + kq * 512) * 2; }

struct StaticOrder {
    int nM, nN, nwg, G, c;
    __host__ __device__ void init(int nM_, int nN_, int G_, int c_) { nM = nM_; nN = nN_; nwg = nM * nN; G = G_; c = c_; }
    __host__ __device__ bool next(int i, Unit& u) const {
        const long L = (long)i * G + c; if (L >= nwg) return false;
        int wgid = (int)L; { const int q = nwg / NXCD, r = nwg % NXCD, xcd = wgid % NXCD, off = wgid / NXCD; wgid = (xcd < r ? xcd * (q + 1) : r * (q + 1) + (xcd - r) * q) + off; }
        const int nig = WGM * nN, gid = wgid / nig, fm = gid * WGM, gsz = (nM - fm) < WGM ? (nM - fm) : WGM;
        u.pm = fm + ((wgid % nig) % gsz); u.pn = (wgid % nig) / gsz; return true;
    }
    __device__ __forceinline__ void a_ready(const Unit&) const {}
    __device__ __forceinline__ void done(const Unit&) const {}
};

__device__ __forceinline__ unsigned cvt_pk_bf16(float lo, float hi) { unsigned r; asm volatile("v_cvt_pk_bf16_f32 %0, %1, %2" : "=v"(r) : "v"(lo), "v"(hi)); return r; }
template <class Epi, class Sched, bool ALIGN_EPI = false, bool SP2 = false>
__device__ __forceinline__ void gemm_phase(PG8_LAS unsigned char* lds, const Gemm g, const Sched& S, const Epi& E, const int wid) {
    unsigned ones_ = ~0u; asm volatile("" : "+s"(ones_)); const int lane = (int)__builtin_amdgcn_mbcnt_hi(ones_, __builtin_amdgcn_mbcnt_lo(ones_, 0u));
    const int tid = wid * 64 + lane, wr = wid >> 2, wc = wid & 3, fr = lane & 15, fq = lane >> 4;
    const int K = g.K, nt = K / BK;
    unsigned voffA[2], voffB[2];
#pragma unroll
    for (int i = 0; i < 2; ++i) { int R, C; stage_rc(tid * 16 + i * 8192, R, C); const int Rb = Epi::PERM ? ((R & ~31) + perm32(R & 31)) : R;
        voffA[i] = (unsigned)(R * g.lda2 + C * 2); voffB[i] = (unsigned)(Rb * g.ldb2 + C * 2); }
    const size_t kstepA = (size_t)g.kstepA, kstepB = (size_t)(BK * 2);
    const size_t hstepA = (size_t)HALF * g.lda2, hstepB = (size_t)HALF * g.ldb2;

    const unsigned ldsw = (unsigned)wid * 1024u;
    const int aoff = lds_byte(wr * 64 + fr, fq * 8), boff = lds_byte(wc * 32 + fr, fq * 8);
#define PG8_SA(b, h) (((b) * 2 + (h)) * HTB)
#define PG8_SB(b, h) ((4 + (b) * 2 + (h)) * HTB)
#define PG8_STAGE(bufoff, gbase, voff) do { _Pragma("unroll") for (int _i = 0; _i < 2; ++_i) \
        __builtin_amdgcn_global_load_lds((const unsigned*)((const char*)(gbase) + (voff)[_i]), (PG8_LAS unsigned*)(lds + (bufoff) + ldsw + _i * 8192), 16, 0, 0); } while (0)
#define PG8_LDA(dst, b, h) do { _Pragma("unroll") for (int m = 0; m < 4; ++m) _Pragma("unroll") for (int k = 0; k < 2; ++k) dst[m][k] = *(const PG8_LAS bf16x8*)(lds + PG8_SA(b, h) + aoff + m * 2048 + k * 1024); } while (0)
#define PG8_LDB(dst, b, h) do { _Pragma("unroll") for (int n = 0; n < 2; ++n) _Pragma("unroll") for (int k = 0; k < 2; ++k) dst[n][k] = *(const PG8_LAS bf16x8*)(lds + PG8_SB(b, h) + boff + n * 2048 + k * 1024); } while (0)
#define PG8_MMA(ai, bj, At, Bt) do { __builtin_amdgcn_s_setprio(1); _Pragma("unroll") for (int m = 0; m < 4; ++m) _Pragma("unroll") for (int n = 0; n < 2; ++n) _Pragma("unroll") for (int k = 0; k < 2; ++k) \
        acc[ai][bj][m][n] = __builtin_amdgcn_mfma_f32_16x16x32_bf16(Bt[n][k], At[m][k], acc[ai][bj][m][n], 0, 0, 0); __builtin_amdgcn_s_setprio(0); } while (0)
#define PG8_WAIT_V(n) asm volatile("s_waitcnt vmcnt(" #n ")" ::: "memory")
#define PG8_WAIT_L(n) asm volatile("s_waitcnt lgkmcnt(" #n ")" ::: "memory")
#define PG8_BAR __builtin_amdgcn_s_barrier()
#define PG8_SCHED __builtin_amdgcn_sched_barrier(0)
    Unit cur, nxt; int ui = 0;
    if (!S.next(0, cur)) return;
    f32x4 acc[2][2][4][2];
#pragma unroll
    for (int a = 0; a < 2; ++a)
#pragma unroll
        for (int b = 0; b < 2; ++b)
#pragma unroll
            for (int m = 0; m < 4; ++m)
#pragma unroll
                for (int n = 0; n < 2; ++n) acc[a][b][m][n] = (f32x4){0.f, 0.f, 0.f, 0.f};
    bf16x8 At[4][2], B0[2][2], B1[2][2];
    const char* cA = a_tile(g, cur.pm); const char* cB = b_tile(g, cur.pm, cur.pn);
    S.a_ready(cur);
    if constexpr (SP2) {
        PG8_STAGE(PG8_SB(0, 0), cB, voffB); PG8_STAGE(PG8_SB(0, 1), cB + hstepB, voffB); PG8_STAGE(PG8_SA(0, 0), cA, voffA); PG8_STAGE(PG8_SA(0, 1), cA + hstepA, voffA);
        if (wr == 1) PG8_BAR;
        PG8_WAIT_V(2); PG8_BAR;
        PG8_STAGE(PG8_SB(1, 0), cB + kstepB, voffB); PG8_STAGE(PG8_SA(1, 0), cA + kstepA, voffA); PG8_STAGE(PG8_SB(1, 1), cB + hstepB + kstepB, voffB);
        PG8_WAIT_V(6); PG8_BAR;
    } else {
        PG8_STAGE(PG8_SB(0, 0), cB, voffB); PG8_STAGE(PG8_SA(0, 0), cA, voffA); PG8_STAGE(PG8_SB(0, 1), cB + hstepB, voffB); PG8_STAGE(PG8_SA(0, 1), cA + hstepA, voffA);
        if (wr == 1) PG8_BAR;
        PG8_WAIT_V(4); PG8_BAR;
        PG8_STAGE(PG8_SB(1, 0), cB + kstepB, voffB); PG8_STAGE(PG8_SA(1, 0), cA + kstepA, voffA); PG8_STAGE(PG8_SB(1, 1), cB + hstepB + kstepB, voffB);
        PG8_WAIT_V(6); PG8_BAR;
    }
    for (;;) {
        const bool has_next = S.next(ui + 1, nxt);
        const char* nA = has_next ? a_tile(g, nxt.pm) : cA; const char* nB = has_next ? b_tile(g, nxt.pm, nxt.pn) : cB;
        for (int t = 0; t < nt; t += 2) {
            const bool last = (t == nt - 2);
            const char* a1 = cA + (size_t)(t + 1) * kstepA;
            const char* a2 = last ? nA : cA + (size_t)(t + 2) * kstepA; const char* b2 = last ? nB : cB + (size_t)(t + 2) * kstepB;
            const char* a3 = a2 + kstepA; const char* b3 = b2 + kstepB;
            if (last && has_next) S.a_ready(nxt);
            if constexpr (SP2) {
            PG8_LDB(B0, 0, 0); PG8_LDB(B1, 0, 1); PG8_SCHED; PG8_LDA(At, 0, 0); PG8_STAGE(PG8_SA(1, 1), a1 + hstepA, voffA);
            PG8_WAIT_V(8); PG8_WAIT_L(0); PG8_BAR; PG8_MMA(0, 0, At, B0); PG8_MMA(0, 1, At, B1); PG8_BAR; PG8_SCHED;
            PG8_LDA(At, 0, 1); PG8_STAGE(PG8_SB(0, 0), b2, voffB); PG8_STAGE(PG8_SB(0, 1), b2 + hstepB, voffB); PG8_STAGE(PG8_SA(0, 0), a2, voffA);
            PG8_WAIT_V(8); PG8_WAIT_L(0); PG8_BAR; PG8_MMA(1, 0, At, B0); PG8_MMA(1, 1, At, B1); PG8_BAR; PG8_SCHED;
            PG8_LDB(B0, 1, 0); PG8_LDB(B1, 1, 1); PG8_SCHED; PG8_LDA(At, 1, 0); PG8_STAGE(PG8_SA(0, 1), a2 + hstepA, voffA);
            PG8_WAIT_V(8); PG8_WAIT_L(0); PG8_BAR; PG8_MMA(0, 0, At, B0); PG8_MMA(0, 1, At, B1); PG8_BAR; PG8_SCHED;
            PG8_LDA(At, 1, 1); PG8_STAGE(PG8_SB(1, 0), b3, voffB); PG8_STAGE(PG8_SB(1, 1), b3 + hstepB, voffB); PG8_STAGE(PG8_SA(1, 0), a3, voffA);
            PG8_WAIT_V(8); PG8_WAIT_L(0); PG8_BAR; PG8_MMA(1, 0, At, B0); PG8_MMA(1, 1, At, B1); PG8_BAR; PG8_SCHED;
            } else {
            PG8_LDB(B0, 0, 0); PG8_SCHED; PG8_LDA(At, 0, 0); PG8_STAGE(PG8_SA(1, 1), a1 + hstepA, voffA);
            PG8_WAIT_L(8); PG8_BAR; PG8_WAIT_L(0); PG8_MMA(0, 0, At, B0); PG8_BAR; PG8_SCHED;
            PG8_LDB(B1, 0, 1); PG8_STAGE(PG8_SB(0, 0), b2, voffB);
            PG8_BAR; PG8_WAIT_L(0); PG8_MMA(0, 1, At, B1); PG8_BAR;
            PG8_LDA(At, 0, 1); PG8_STAGE(PG8_SA(0, 0), a2, voffA);
            PG8_BAR; PG8_WAIT_L(0); PG8_MMA(1, 0, At, B0); PG8_BAR; PG8_SCHED;
            PG8_STAGE(PG8_SB(0, 1), b2 + hstepB, voffB);
            PG8_WAIT_V(6); PG8_BAR; PG8_MMA(1, 1, At, B1); PG8_BAR;
            PG8_LDB(B0, 1, 0); PG8_SCHED; PG8_LDA(At, 1, 0); PG8_STAGE(PG8_SA(0, 1), a2 + hstepA, voffA);
            PG8_WAIT_L(8); PG8_BAR; PG8_WAIT_L(0); PG8_MMA(0, 0, At, B0); PG8_BAR; PG8_SCHED;
            PG8_LDB(B1, 1, 1); PG8_STAGE(PG8_SB(1, 0), b3, voffB);
            PG8_BAR; PG8_WAIT_L(0); PG8_MMA(0, 1, At, B1); PG8_BAR;
            PG8_LDA(At, 1, 1); PG8_STAGE(PG8_SA(1, 0), a3, voffA);
            PG8_BAR; PG8_WAIT_L(0); PG8_MMA(1, 0, At, B0); PG8_BAR; PG8_SCHED;
            PG8_STAGE(PG8_SB(1, 1), b3 + hstepB, voffB);
            PG8_WAIT_V(6); PG8_BAR; PG8_MMA(1, 1, At, B1); PG8_BAR;
            }
        }
        if constexpr (ALIGN_EPI) { if (wr == 0) PG8_BAR; }
        if constexpr (!Epi::AFTER_DRAIN) { unsigned on2_ = ~0u; asm volatile("" : "+s"(on2_)); const int l2_ = (int)__builtin_amdgcn_mbcnt_hi(on2_, __builtin_amdgcn_mbcnt_lo(on2_, 0u));
            E(acc, cur, wr, wc, l2_ & 15, l2_ >> 4); S.done(cur); }
        if (!has_next) break;
#pragma unroll
        for (int a = 0; a < 2; ++a)
#pragma unroll
            for (int b = 0; b < 2; ++b)
#pragma unroll
                for (int m = 0; m < 4; ++m)
#pragma unroll
                    for (int n = 0; n < 2; ++n) acc[a][b][m][n] = (f32x4){0.f, 0.f, 0.f, 0.f};
        cur = nxt; cA = nA; cB = nB; ++ui;
        if constexpr (ALIGN_EPI) { if (wr == 1) PG8_BAR; }
    }
    PG8_WAIT_V(0);
    if constexpr (!ALIGN_EPI) { if (wr == 0) PG8_BAR; }
    PG8_BAR;
    if constexpr (Epi::AFTER_DRAIN) { E.fused(acc, cur, wr, wc, fr, fq, lds, wid, lane); S.done(cur); }
#undef PG8_SA
#undef PG8_SB
#undef PG8_STAGE
#undef PG8_LDA
#undef PG8_LDB
#undef PG8_MMA
#undef PG8_WAIT_V
#undef PG8_WAIT_L
#undef PG8_BAR
#undef PG8_SCHED
}
}
namespace pg8 {
struct EpiWin {
    static constexpr bool PERM = true, AFTER_DRAIN = false; static constexpr int NST = 16;
    bf16_t* P; const float* ssqx; const float2* rope; float* ssqq; float* ssqkv; int ld, odd;
    __device__ __forceinline__ void operator()(const f32x4 (&acc)[2][2][4][2], const Unit& u, int wr, int wc, int fr, int fq) const {
        const int row0 = u.pm * BM + wr * 64 + fr, cw = u.pn * BM + wc * 32;
        float sx[2][4];
#pragma unroll
        for (int ai = 0; ai < 2; ++ai)
#pragma unroll
            for (int m = 0; m < 4; ++m) sx[ai][m] = ssqx[row0 + ai * HALF + m * 16];
#pragma unroll
        for (int ai = 0; ai < 2; ++ai)
#pragma unroll
            for (int m = 0; m < 4; ++m) {
                const int row = row0 + ai * HALF + m * 16; const float rs = rsqrtf(sx[ai][m] * (1.f / DM) + EPS);
                float sq = 0.f;
#pragma unroll
                for (int bj = 0; bj < 2; ++bj) {
                    const int cg = cw + bj * HALF, c = cg + 8 * fq;
                    f32x4 v0 = acc[ai][bj][m][0] * rs, v1 = acc[ai][bj][m][1] * rs;
                    if (!odd) {
                        if (cg < E_KSWA) sq += (v0[0] * v0[0] + v0[1] * v0[1]) + (v0[2] * v0[2] + v0[3] * v0[3]) + (v1[0] * v1[0] + v1[1] * v1[1]) + (v1[2] * v1[2] + v1[3] * v1[3]);
                        if (cg == E_KPE) { const float2* cs = rope + (size_t)(row & (S - 1)) * 16 + 4 * fq; const float2 c0 = cs[0], c1 = cs[1], c2 = cs[2], c3 = cs[3];
                            const f32x4 a = v0, b = v1;
                            v0[0] = a[0] * c0.x - a[1] * c0.y; v0[1] = a[1] * c0.x + a[0] * c0.y; v0[2] = a[2] * c1.x - a[3] * c1.y; v0[3] = a[3] * c1.x + a[2] * c1.y;
                            v1[0] = b[0] * c2.x - b[1] * c2.y; v1[1] = b[1] * c2.x + b[0] * c2.y; v1[2] = b[2] * c3.x - b[3] * c3.y; v1[3] = b[3] * c3.x + b[2] * c3.y; }
                        else if ((cg >= E_GMLA && cg < E_QSWA) || (cg >= E_GSWA && cg < E_QMEM) || cg >= E_GMEM) {
#pragma unroll
                            for (int i = 0; i < 4; ++i) { v0[i] = silu_f(v0[i]); v1[i] = silu_f(v1[i]); } }
                    } else {
                        if (cg == O_GL) { if (fq < 3) {
#pragma unroll
                            for (int i = 0; i < 4; ++i) { v0[i] = sigm_f(v0[i]); v1[i] = sigm_f(v1[i]); } } }
                        else if ((cg >= O_GNSA && cg < O_QMEM) || cg >= O_GMEM) {
#pragma unroll
                            for (int i = 0; i < 4; ++i) { v0[i] = silu_f(v0[i]); v1[i] = silu_f(v1[i]); } }
                    }
                    u32x4 w; w.x = pk2(v0[0], v0[1]); w.y = pk2(v0[2], v0[3]); w.z = pk2(v1[0], v1[1]); w.w = pk2(v1[2], v1[3]);
                    *(u32x4*)(P + (size_t)row * ld + c) = w;
                }
                if (!odd && u.pn < 2) {
                    sq += __shfl_xor(sq, 16); sq += __shfl_xor(sq, 32);
                    if (fq == 0) (u.pn == 0 ? ssqq : ssqkv)[(size_t)row * 4 + wc] = sq;
                }
            }
    }
};
struct EpiUp {
    static constexpr bool PERM = true, AFTER_DRAIN = false; static constexpr int NST = 0;
    bf16_t* O; const float* ssqq; const float* ssqkv; const float2* rope;
    __device__ __forceinline__ void operator()(const f32x4 (&acc)[2][2][4][2], const Unit& u, int wr, int wc, int fr, int fq) const {
        const int row0 = u.pm * BM + wr * 64 + fr, c0 = u.pn * BM + wc * 32 + 8 * fq; const bool isq = u.pn < 3;
#pragma unroll
        for (int ai = 0; ai < 2; ++ai)
#pragma unroll
            for (int m = 0; m < 4; ++m) {
                const int row = row0 + ai * HALF + m * 16;
                const f32x4 pq4 = *(const f32x4*)((isq ? ssqq : ssqkv) + (size_t)row * 4); const float ssum = (pq4[0] + pq4[1]) + (pq4[2] + pq4[3]);
                const float rs = rsqrtf(ssum * (isq ? (1.f / 256.f) : (1.f / 128.f)) + EPS);
#pragma unroll
                for (int bj = 0; bj < 2; ++bj) {
                    const int c = c0 + bj * HALF; f32x4 v0 = acc[ai][bj][m][0] * rs, v1 = acc[ai][bj][m][1] * rs;
                    if (isq) { const int j = c % 96;
                        if (j >= 64) { const float2* cs = rope + (size_t)(row & (S - 1)) * 16 + ((j - 64) >> 1); const float2 q0 = cs[0], q1 = cs[1], q2 = cs[2], q3 = cs[3];
                            const f32x4 a = v0, b = v1;
                            v0[0] = a[0] * q0.x - a[1] * q0.y; v0[1] = a[1] * q0.x + a[0] * q0.y; v0[2] = a[2] * q1.x - a[3] * q1.y; v0[3] = a[3] * q1.x + a[2] * q1.y;
                            v1[0] = b[0] * q2.x - b[1] * q2.y; v1[1] = b[1] * q2.x + b[0] * q2.y; v1[2] = b[2] * q3.x - b[3] * q3.y; v1[3] = b[3] * q3.x + b[2] * q3.y; } }
                    u32x4 w; w.x = pk2(v0[0], v0[1]); w.y = pk2(v0[2], v0[3]); w.z = pk2(v1[0], v1[1]); w.w = pk2(v1[2], v1[3]);
                    *(u32x4*)(O + (size_t)row * QKVW + c) = w;
                }
                asm volatile("" ::: "memory");
            }
    }
};
struct EpiStore {
    static constexpr bool PERM = true, AFTER_DRAIN = false; static constexpr int NST = 16;
    bf16_t* O; const float* rscale; float* ssq; int ld;
    __device__ __forceinline__ void operator()(const f32x4 (&acc)[2][2][4][2], const Unit& u, int wr, int wc, int fr, int fq) const {
        const int row0 = u.pm * BM + wr * 64 + fr, c0 = u.pn * BM + wc * 32 + 8 * fq;
        float sx[2][4];
#pragma unroll
        for (int ai = 0; ai < 2; ++ai)
#pragma unroll
            for (int m = 0; m < 4; ++m) sx[ai][m] = rscale ? rscale[row0 + ai * HALF + m * 16] : 1.f;
#pragma unroll
        for (int ai = 0; ai < 2; ++ai)
#pragma unroll
            for (int m = 0; m < 4; ++m) {
                const int row = row0 + ai * HALF + m * 16; const float rs = sx[ai][m]; float sq = 0.f;
#pragma unroll
                for (int bj = 0; bj < 2; ++bj) {
                    const f32x4 v0 = acc[ai][bj][m][0] * rs, v1 = acc[ai][bj][m][1] * rs;
                    sq += (v0[0] * v0[0] + v0[1] * v0[1]) + (v0[2] * v0[2] + v0[3] * v0[3]) + (v1[0] * v1[0] + v1[1] * v1[1]) + (v1[2] * v1[2] + v1[3] * v1[3]);
                    u32x4 w; w.x = pk2(v0[0], v0[1]); w.y = pk2(v0[2], v0[3]); w.z = pk2(v1[0], v1[1]); w.w = pk2(v1[2], v1[3]);
                    *(u32x4*)(O + (size_t)row * ld + c0 + bj * HALF) = w;
                }
                if (ssq) { sq += __shfl_xor(sq, 16); sq += __shfl_xor(sq, 32); if (fq == 0) ssq[(size_t)row * 16 + u.pn * 4 + wc] = sq; }
            }
    }
};
struct EpiPart {
    static constexpr bool PERM = true, AFTER_DRAIN = false; static constexpr int NST = 0;
    float* O;
    __device__ __forceinline__ void operator()(const f32x4 (&acc)[2][2][4][2], const Unit& u, int wr, int wc, int fr, int fq) const {
        const int kvq = u.pm >> 5, p32 = u.pm & 31; const int row0 = p32 * BM + wr * 64 + fr, c0 = wc * 32 + 8 * fq; float* base = O + (size_t)kvq * 8192 * 256;
#pragma unroll
        for (int ai = 0; ai < 2; ++ai)
#pragma unroll
            for (int m = 0; m < 4; ++m) { float* rp = base + (size_t)(row0 + ai * HALF + m * 16) * 256 + c0;
#pragma unroll
                for (int bj = 0; bj < 2; ++bj) { *(f32x4*)(rp + bj * HALF) = acc[ai][bj][m][0]; *(f32x4*)(rp + bj * HALF + 4) = acc[ai][bj][m][1]; } }
    }
};
struct EpiC1 {
    static constexpr bool PERM = true, AFTER_DRAIN = false; static constexpr int NST = 0;
    bf16_t* O; const float* pb;
    __device__ __forceinline__ void operator()(const f32x4 (&acc)[2][2][4][2], const Unit& u, int wr, int wc, int fr, int fq) const {
        const int row0 = u.pm * BM + wr * 64 + fr, c0 = wc * 32 + 8 * fq;
#pragma unroll
        for (int ai = 0; ai < 2; ++ai)
#pragma unroll
            for (int m = 0; m < 4; ++m) {
                const int row = row0 + ai * HALF + m * 16;
#pragma unroll
                for (int bj = 0; bj < 2; ++bj) { const int c = c0 + bj * HALF; const f32x4 b0 = *(const f32x4*)(pb + c), b1 = *(const f32x4*)(pb + c + 4);
                    f32x4 v0 = acc[ai][bj][m][0] + b0, v1 = acc[ai][bj][m][1] + b1;
#pragma unroll
                    for (int i = 0; i < 4; ++i) { v0[i] = silu_f(v0[i]); v1[i] = silu_f(v1[i]); }
                    u32x4 w; w.x = pk2(v0[0], v0[1]); w.y = pk2(v0[2], v0[3]); w.z = pk2(v1[0], v1[1]); w.w = pk2(v1[2], v1[3]);
                    *(u32x4*)(O + (size_t)row * 256 + c) = w; }
            }
    }
};
}
#ifndef ATT_PROBE
#define ATT_PROBE 0
#endif
namespace att {
constexpr float SM_THR = 8.f;
constexpr int KSLOT = 17408, VSLOT = 20480, KS0 = 0, VS0 = 3 * KSLOT, KPOS = VS0 + 2 * VSLOT  , IMP = 94208, SELW = IMP + 33024  , SELU = SELW + 1024, LUTO = 128512, ATT_LDS_END = LUTO + 4224;
__device__ __forceinline__ int kslot(int i) { return KS0 + i * KSLOT; }
__device__ __forceinline__ int vslot(int i) { return VS0 + i * VSLOT; }
template <int DQK> struct KPitch { static constexpr int v = DQK * 2 + 16; };
template <int DV> struct VPitch { static constexpr int v = (DV == 64) ? 192 : 320; };
__device__ __forceinline__ s16x4 vtr(const LAS char* p) { typedef short v4s __attribute__((ext_vector_type(4))); return __builtin_bit_cast(s16x4, __builtin_amdgcn_ds_read_tr16_b64_v4i16((LAS v4s*)p)); }
__device__ __forceinline__ float swapmax(float v) { auto rr = __builtin_amdgcn_permlane32_swap(__float_as_uint(v), __float_as_uint(v), false, false); return fmaxf(__uint_as_float(rr[0]), __uint_as_float(rr[1])); }
__device__ __forceinline__ float swapsum(float v) { auto rr = __builtin_amdgcn_permlane32_swap(__float_as_uint(v), __float_as_uint(v), false, false); return __uint_as_float(rr[0]) + __uint_as_float(rr[1]); }

struct Src { const bf16_t* K1; const bf16_t* K2; const bf16_t* V; int kld, kld2, vld; const int* kpos; };
template <int DQK, int DV> struct Stage { u32x4 k[(64 * DQK / 8 + 511) / 512]; u32x4 v[(64 * DV / 8 + 511) / 512]; int kp; };

template <int DQK, int DV, bool POS>
__device__ __forceinline__ void load_k(Stage<DQK, DV>& st, const Src& s, int kt0, int tid) {
    constexpr int CPRK = DQK / 8, NKC = 64 * CPRK;
#pragma unroll
    for (int i = 0; i < (NKC + 511) / 512; ++i) { const int c = tid + i * 512;
        if (NKC % 512 == 0 || c < NKC) { const int row = c / CPRK, ch = c % CPRK;
            const bf16_t* p = (DQK == 96 && ch >= 8) ? s.K2 + (size_t)(kt0 + row) * s.kld2 + (ch - 8) * 8 : s.K1 + (size_t)(kt0 + row) * s.kld + ch * 8;
            st.k[i] = *(const u32x4*)p; } }
    if (POS) st.kp = (tid < 64) ? s.kpos[kt0 + tid] : 0;
}
template <int DQK, int DV>
__device__ __forceinline__ void load_v(Stage<DQK, DV>& st, const Src& s, int kt0, int tid) {
    constexpr int CPRV = DV / 8, NVC = 64 * CPRV;
#pragma unroll
    for (int i = 0; i < NVC / 512; ++i) { const int c = tid + i * 512; const int row = c / CPRV, ch = c % CPRV; st.v[i] = *(const u32x4*)(s.V + (size_t)(kt0 + row) * s.vld + ch * 8); }
}
template <int DQK, int DV, bool POS>
__device__ __forceinline__ void store_k(const Stage<DQK, DV>& st, LAS char* lds, int ks, int tid) {
    constexpr int CPRK = DQK / 8, NKC = 64 * CPRK, KP = KPitch<DQK>::v;
    LAS char* kb = lds + kslot(ks);
#pragma unroll
    for (int i = 0; i < (NKC + 511) / 512; ++i) { const int c = tid + i * 512; if (NKC % 512 == 0 || c < NKC) { const int row = c / CPRK, ch = c % CPRK; *(LAS u32x4*)(kb + row * KP + ch * 16) = st.k[i]; } }
    if (POS) { if (tid < 64) ((LAS int*)(lds + KPOS))[ks * 64 + tid] = st.kp; }
}
template <int DQK, int DV>
__device__ __forceinline__ void store_v(const Stage<DQK, DV>& st, LAS char* lds, int vs, int tid) {
    constexpr int CPRV = DV / 8, NVC = 64 * CPRV, VP = VPitch<DV>::v;
    LAS char* vb = lds + vslot(vs);
#pragma unroll
    for (int i = 0; i < NVC / 512; ++i) { const int c = tid + i * 512; const int row = c / CPRV, ch = c % CPRV; *(LAS u32x4*)(vb + row * VP + ch * 16) = st.v[i]; }
}
template <int DQK, int DV, bool POS>
__device__ __forceinline__ void tile_load(Stage<DQK, DV>& st, const Src& s, int kt0, int tid) { load_k<DQK, DV, POS>(st, s, kt0, tid); load_v<DQK, DV>(st, s, kt0, tid); }
template <int DQK, int DV, bool POS>
__device__ __forceinline__ void tile_store(const Stage<DQK, DV>& st, LAS char* lds, int buf, int tid) { store_k<DQK, DV, POS>(st, lds, buf, tid); store_v<DQK, DV>(st, lds, buf, tid); }

struct Col { int qi; int qlim; int pq; int hcol; };
struct Flags { bool causal, window, bias, selm; };

template <int DQK, int DV, bool DO_PV, bool BIAS, bool WINDOWED>
__device__ __forceinline__ void tile_compute(const LAS char* lds, int buf, int kt0, int mode, bool incl, const Col& col, int W, const bf16x8 (&qf)[DQK / 16], f32x16 (&o)[DV / 32], float& m, float& l,
                                             f32x16& p0, f32x16& p1, int lane) {
    constexpr int KP = KPitch<DQK>::v, VP = VPitch<DV>::v;
    int hi = lane >> 5; asm volatile("" : "+v"(hi));
    const int r32 = lane & 31;
    const LAS char* kb = lds + kslot(buf) + r32 * KP + hi * 16;
    p0 = (f32x16){0}; p1 = (f32x16){0};
#pragma unroll
    for (int st = 0; st < DQK / 16; ++st) {
        const bf16x8 k0 = *(const LAS bf16x8*)(kb + st * 32), k1 = *(const LAS bf16x8*)(kb + 32 * KP + st * 32);
        p0 = __builtin_amdgcn_mfma_f32_32x32x16_bf16(k0, qf[st], p0, 0, 0, 0);
        p1 = __builtin_amdgcn_mfma_f32_32x32x16_bf16(k1, qf[st], p1, 0, 0, 0);
        if ((st & 1) == 1) asm volatile("" ::: "memory");
    }
    float cb = 0.f;
    if (BIAS) {
        const LAS float* lut = (const LAS float*)(lds + LUTO) + col.hcol * 132;
        if (mode == 2) {
            const LAS int* kp = (const LAS int*)(lds + KPOS) + buf * 64 + 4 * hi;
#pragma unroll
            for (int r = 0; r < 16; ++r) { const int ko = (r & 3) + 8 * (r >> 2);
                int d0 = col.pq - kp[ko], d1 = col.pq - kp[ko + 32]; d0 = d0 < 0 ? 0 : (d0 > 128 ? 128 : d0); d1 = d1 < 0 ? 0 : (d1 > 128 ? 128 : d1);
                p0[r] += lut[d0]; p1[r] += lut[d1]; if ((r & 3) == 3) asm volatile("" ::: "memory"); }
        } else cb = lut[128];
    }
    if (mode == 2) {
        const int up = col.qlim - kt0 - 4 * hi; const int lo = WINDOWED ? (col.qi - W - kt0 - 4 * hi) : -1;
#pragma unroll
        for (int r = 0; r < 16; ++r) { const int ko = (r & 3) + 8 * (r >> 2);
            bool v0 = ko <= up, v1 = (ko + 32) <= up;
            if (WINDOWED) { v0 = v0 && (ko > lo); v1 = v1 && ((ko + 32) > lo); }
            p0[r] = v0 ? p0[r] : NEG; p1[r] = v1 ? p1[r] : NEG; }
    }
    float a = fmaxf(fmaxf(p0[0], p0[1]), p1[0]), b = fmaxf(fmaxf(p0[2], p0[3]), p1[1]); a = fmaxf(fmaxf(a, p1[2]), p1[3]);
#pragma unroll
    for (int r = 4; r < 16; r += 4) { a = fmaxf(fmaxf(a, p0[r]), p0[r + 1]); b = fmaxf(fmaxf(b, p0[r + 2]), p0[r + 3]); a = fmaxf(fmaxf(a, p1[r]), p1[r + 1]); b = fmaxf(fmaxf(b, p1[r + 2]), p1[r + 3]); }
    float tmax = swapmax(fmaxf(a, b)) + cb;
    if (!incl) tmax = NEG;
    if (__builtin_amdgcn_ballot_w64(tmax - m > SM_THR) != 0ull) { const float mnew = fmaxf(m, tmax); const float f = __builtin_amdgcn_exp2f(m - mnew); l *= f; m = mnew;
        if (DO_PV) {
#pragma unroll
            for (int bk = 0; bk < DV / 32; ++bk)
#pragma unroll
                for (int r = 0; r < 16; ++r) o[bk][r] *= f; } }
    const float off = (incl && m > -1e29f) ? (cb - m) : NEG;
    float sum = 0.f;
#pragma unroll
    for (int r = 0; r < 16; ++r) { p0[r] = __builtin_amdgcn_exp2f(p0[r] + off); p1[r] = __builtin_amdgcn_exp2f(p1[r] + off); sum += p0[r] + p1[r]; }
    l += sum;
    if (DO_PV) {
        const LAS char* vb = lds + vslot(buf) + (4 * hi + ((lane & 15) >> 2)) * VP + (((lane >> 4) & 1) * 16 + (lane & 3) * 4) * 2;
#pragma unroll
        for (int sub = 0; sub < 2; ++sub)
#pragma unroll
            for (int ks = 0; ks < 2; ++ks) {
                u32x4 pw;
                if (sub == 0) { pw.x = pk2(p0[8 * ks], p0[8 * ks + 1]); pw.y = pk2(p0[8 * ks + 2], p0[8 * ks + 3]); pw.z = pk2(p0[8 * ks + 4], p0[8 * ks + 5]); pw.w = pk2(p0[8 * ks + 6], p0[8 * ks + 7]); }
                else          { pw.x = pk2(p1[8 * ks], p1[8 * ks + 1]); pw.y = pk2(p1[8 * ks + 2], p1[8 * ks + 3]); pw.z = pk2(p1[8 * ks + 4], p1[8 * ks + 5]); pw.w = pk2(p1[8 * ks + 6], p1[8 * ks + 7]); }
                const bf16x8 pb = __builtin_bit_cast(bf16x8, pw);
#pragma unroll
                for (int bk = 0; bk < DV / 32; ++bk) {
                    const LAS char* vp = vb + (32 * sub + 16 * ks) * VP + bk * 64;
                    const s16x4 lo = vtr(vp), hi4 = vtr(vp + 8 * VP);
                    const bf16x8 va = __builtin_shufflevector(lo, hi4, 0, 1, 2, 3, 4, 5, 6, 7);
                    o[bk] = __builtin_amdgcn_mfma_f32_32x32x16_bf16(va, pb, o[bk], 0, 0, 0);
                }
                asm volatile("" ::: "memory");
            }
    }
}

template <int DQK> __device__ __forceinline__ void qk_part(const LAS char* lds, int ks, const bf16x8 (&qf)[DQK / 16], f32x16& s0, f32x16& s1, int lane) {
    constexpr int KP = KPitch<DQK>::v; const LAS char* kb = lds + kslot(ks) + (lane & 31) * KP + (lane >> 5) * 16;
    s0 = (f32x16){0}; s1 = (f32x16){0};
#pragma unroll
    for (int st = 0; st < DQK / 16; ++st) {
        const bf16x8 k0 = *(const LAS bf16x8*)(kb + st * 32), k1 = *(const LAS bf16x8*)(kb + 32 * KP + st * 32);
        s0 = __builtin_amdgcn_mfma_f32_32x32x16_bf16(k0, qf[st], s0, 0, 0, 0);
        s1 = __builtin_amdgcn_mfma_f32_32x32x16_bf16(k1, qf[st], s1, 0, 0, 0);
    }
}
template <int DQK> __device__ __forceinline__ void load_kf(const LAS char* lds, int ks, bf16x8 (&kf)[DQK / 16][2], int lane) {
    constexpr int KP = KPitch<DQK>::v; const LAS char* kb = lds + kslot(ks) + (lane & 31) * KP + (lane >> 5) * 16;
#pragma unroll
    for (int st = 0; st < DQK / 16; ++st) { kf[st][0] = *(const LAS bf16x8*)(kb + st * 32); kf[st][1] = *(const LAS bf16x8*)(kb + 32 * KP + st * 32); }
}
template <int DQK> __device__ __forceinline__ void qk_pipe(const LAS char* lds, int ks, const bf16x8 (&qf)[DQK / 16], f32x16& n0, f32x16& n1, int lane) {
    constexpr int KP = KPitch<DQK>::v, NG = DQK / 8; const LAS char* kb = lds + kslot(ks) + (lane & 31) * KP + (lane >> 5) * 16;
    n0 = (f32x16){0}; n1 = (f32x16){0};
    bf16x8 f0 = *(const LAS bf16x8*)(kb), f1 = *(const LAS bf16x8*)(kb + 32 * KP), f2 = *(const LAS bf16x8*)(kb + 32);
#pragma unroll
    for (int g = 0; g < NG; ++g) {
        bf16x8 f3 = f2;
        if (g + 3 < NG) f3 = *(const LAS bf16x8*)(kb + ((g + 3) & 1) * 32 * KP + ((g + 3) >> 1) * 32);
        if (g & 1) n1 = __builtin_amdgcn_mfma_f32_32x32x16_bf16(f0, qf[g >> 1], n1, 0, 0, 0); else n0 = __builtin_amdgcn_mfma_f32_32x32x16_bf16(f0, qf[g >> 1], n0, 0, 0, 0);
        __builtin_amdgcn_sched_barrier(0);
        f0 = f1; f1 = f2; f2 = f3;
    }
}
template <int DV, bool BIAS, bool WINDOWED, bool DO_PV>
__device__ __forceinline__ float max_part(const LAS char* lds, int ks, int kt0, int mode, bool incl, const Col& col, int W, f32x16 (&o)[DV / 32], float& m, float& l, f32x16& p0, f32x16& p1, int lane) {
    int hi = lane >> 5; asm volatile("" : "+v"(hi));
    float cb = 0.f;
    if (BIAS) {
        const LAS float* lut = (const LAS float*)(lds + LUTO) + col.hcol * 132;
        if (mode == 2) {
            const LAS int* kp = (const LAS int*)(lds + KPOS) + ks * 64 + 4 * hi;
#pragma unroll
            for (int r = 0; r < 16; ++r) { const int ko = (r & 3) + 8 * (r >> 2);
                int d0 = col.pq - kp[ko], d1 = col.pq - kp[ko + 32]; d0 = d0 < 0 ? 0 : (d0 > 128 ? 128 : d0); d1 = d1 < 0 ? 0 : (d1 > 128 ? 128 : d1);
                p0[r] += lut[d0]; p1[r] += lut[d1]; if ((r & 3) == 3) asm volatile("" ::: "memory"); }
        } else cb = lut[128];
    }
    if (mode == 2) {
        const int up = col.qlim - kt0 - 4 * hi; const int lo = WINDOWED ? (col.qi - W - kt0 - 4 * hi) : -1;
#pragma unroll
        for (int r = 0; r < 16; ++r) { const int ko = (r & 3) + 8 * (r >> 2);
            bool v0 = ko <= up, v1 = (ko + 32) <= up;
            if (WINDOWED) { v0 = v0 && (ko > lo); v1 = v1 && ((ko + 32) > lo); }
            p0[r] = v0 ? p0[r] : NEG; p1[r] = v1 ? p1[r] : NEG; }
    }
    float a = fmaxf(fmaxf(p0[0], p0[1]), p1[0]), b = fmaxf(fmaxf(p0[2], p0[3]), p1[1]); a = fmaxf(fmaxf(a, p1[2]), p1[3]);
#pragma unroll
    for (int r = 4; r < 16; r += 4) { a = fmaxf(fmaxf(a, p0[r]), p0[r + 1]); b = fmaxf(fmaxf(b, p0[r + 2]), p0[r + 3]); a = fmaxf(fmaxf(a, p1[r]), p1[r + 1]); b = fmaxf(fmaxf(b, p1[r + 2]), p1[r + 3]); }
    float tmax = swapmax(fmaxf(a, b)) + cb;
    if (!incl) tmax = NEG;
    if (__builtin_amdgcn_ballot_w64(tmax - m > SM_THR) != 0ull) { const float mnew = fmaxf(m, tmax); const float f = __builtin_amdgcn_exp2f(m - mnew); l *= f; m = mnew;
        if (DO_PV) {
#pragma unroll
            for (int bk = 0; bk < DV / 32; ++bk)
#pragma unroll
                for (int r = 0; r < 16; ++r) o[bk][r] *= f; } }
    return (incl && m > -1e29f) ? (cb - m) : NEG;
}
template <int DQK, bool WITHQK>
__device__ __forceinline__ void exp_part(const bf16x8 (&kf)[DQK / 16][2], const bf16x8 (&qf)[DQK / 16], float off, float& l, f32x16& p0, f32x16& p1, f32x16& n0, f32x16& n1, int lane) {
    if (WITHQK) { n0 = (f32x16){0}; n1 = (f32x16){0};
#pragma unroll
        for (int st = 0; st < DQK / 16; ++st) { n0 = __builtin_amdgcn_mfma_f32_32x32x16_bf16(kf[st][0], qf[st], n0, 0, 0, 0); n1 = __builtin_amdgcn_mfma_f32_32x32x16_bf16(kf[st][1], qf[st], n1, 0, 0, 0); }
#if ATT_PROBE == 1
        { f32x16 x0 = (f32x16){0}, x1 = (f32x16){0};
#pragma unroll
          for (int st = 0; st < DQK / 16; ++st) { x0 = __builtin_amdgcn_mfma_f32_32x32x16_bf16(kf[st][0], qf[st], x0, 0, 0, 0); x1 = __builtin_amdgcn_mfma_f32_32x32x16_bf16(kf[st][1], qf[st], x1, 0, 0, 0); }
          asm volatile("" :: "v"(x0), "v"(x1)); }
#endif
    }
#if ATT_PROBE == 7
    { float j0 = p0[0], j1 = p0[1], j2 = p0[2], j3 = p0[3], j4 = p0[4], j5 = p0[5], j6 = p0[6], j7 = p0[7];
#pragma unroll
      for (int i = 0; i < 8; ++i) { j0 = j0 * 1.0001f + 0.5f; j1 = j1 * 1.0001f + 0.5f; j2 = j2 * 1.0001f + 0.5f; j3 = j3 * 1.0001f + 0.5f; j4 = j4 * 1.0001f + 0.5f; j5 = j5 * 1.0001f + 0.5f; j6 = j6 * 1.0001f + 0.5f; j7 = j7 * 1.0001f + 0.5f; }
      asm volatile("" :: "v"(j0), "v"(j1), "v"(j2), "v"(j3), "v"(j4), "v"(j5), "v"(j6), "v"(j7)); }
#endif
#if ATT_PROBE == 8
    { float e0 = __builtin_amdgcn_exp2f(p0[0] + 1.f), e1 = __builtin_amdgcn_exp2f(p0[1] + 1.f), e2 = __builtin_amdgcn_exp2f(p0[2] + 1.f), e3 = __builtin_amdgcn_exp2f(p0[3] + 1.f);
      float e4 = __builtin_amdgcn_exp2f(p0[4] + 1.f), e5 = __builtin_amdgcn_exp2f(p0[5] + 1.f), e6 = __builtin_amdgcn_exp2f(p0[6] + 1.f), e7 = __builtin_amdgcn_exp2f(p0[7] + 1.f);
      float f0 = __builtin_amdgcn_exp2f(p1[0] + 1.f), f1 = __builtin_amdgcn_exp2f(p1[1] + 1.f), f2 = __builtin_amdgcn_exp2f(p1[2] + 1.f), f3 = __builtin_amdgcn_exp2f(p1[3] + 1.f);
      float f4 = __builtin_amdgcn_exp2f(p1[4] + 1.f), f5 = __builtin_amdgcn_exp2f(p1[5] + 1.f), f6 = __builtin_amdgcn_exp2f(p1[6] + 1.f), f7 = __builtin_amdgcn_exp2f(p1[7] + 1.f);
      asm volatile("" :: "v"(e0), "v"(e1), "v"(e2), "v"(e3), "v"(e4), "v"(e5), "v"(e6), "v"(e7), "v"(f0), "v"(f1), "v"(f2), "v"(f3), "v"(f4), "v"(f5), "v"(f6), "v"(f7)); }
#endif
    float sum = 0.f;
#if ATT_PROBE == 2
    { float junk = 0.f;
#pragma unroll
      for (int r = 0; r < 16; ++r) { junk += __builtin_amdgcn_exp2f(p0[r] + off + 1.f) + __builtin_amdgcn_exp2f(p1[r] + off + 1.f); }
      asm volatile("" :: "v"(junk)); }
#endif
#pragma unroll
    for (int r = 0; r < 16; ++r) { p0[r] = __builtin_amdgcn_exp2f(p0[r] + off); p1[r] = __builtin_amdgcn_exp2f(p1[r] + off); sum += p0[r] + p1[r]; }
    l += sum;
}
template <int DQK> __device__ __forceinline__ void exp_part_qk(const bf16x8 (&kf)[DQK / 16][2], const bf16x8 (&qf)[DQK / 16], f32x16& n0, f32x16& n1) {
    n0 = (f32x16){0}; n1 = (f32x16){0};
#pragma unroll
    for (int st = 0; st < DQK / 16; ++st) { n0 = __builtin_amdgcn_mfma_f32_32x32x16_bf16(kf[st][0], qf[st], n0, 0, 0, 0); n1 = __builtin_amdgcn_mfma_f32_32x32x16_bf16(kf[st][1], qf[st], n1, 0, 0, 0); }
}
template <int DV> __device__ __forceinline__ void pv_part(const LAS char* lds, int vs, const f32x16& p0, const f32x16& p1, f32x16 (&o)[DV / 32], int lane) {
    constexpr int VP = VPitch<DV>::v; const int hi = lane >> 5;
    const LAS char* vb = lds + vslot(vs) + (4 * hi + ((lane & 15) >> 2)) * VP + (((lane >> 4) & 1) * 16 + (lane & 3) * 4) * 2;
#pragma unroll
    for (int sub = 0; sub < 2; ++sub)
#pragma unroll
        for (int ks = 0; ks < 2; ++ks) {
            u32x4 pw;
            if (sub == 0) { pw.x = pk2(p0[8 * ks], p0[8 * ks + 1]); pw.y = pk2(p0[8 * ks + 2], p0[8 * ks + 3]); pw.z = pk2(p0[8 * ks + 4], p0[8 * ks + 5]); pw.w = pk2(p0[8 * ks + 6], p0[8 * ks + 7]); }
            else          { pw.x = pk2(p1[8 * ks], p1[8 * ks + 1]); pw.y = pk2(p1[8 * ks + 2], p1[8 * ks + 3]); pw.z = pk2(p1[8 * ks + 4], p1[8 * ks + 5]); pw.w = pk2(p1[8 * ks + 6], p1[8 * ks + 7]); }
            const bf16x8 pb = __builtin_bit_cast(bf16x8, pw);
#pragma unroll
            for (int bk = 0; bk < DV / 32; ++bk) {
                const LAS char* vp = vb + (32 * sub + 16 * ks) * VP + bk * 64;
                const s16x4 lo = vtr(vp), hi4 = vtr(vp + 8 * VP);
                const bf16x8 va = __builtin_shufflevector(lo, hi4, 0, 1, 2, 3, 4, 5, 6, 7);
                o[bk] = __builtin_amdgcn_mfma_f32_32x32x16_bf16(va, pb, o[bk], 0, 0, 0);
            }
        }
}
}
namespace att {
struct Wv { int l0, l1, q0, q1; };
__device__ __forceinline__ float headsum4(float w) {
    const float t = w + __builtin_bit_cast(float, __builtin_amdgcn_update_dpp(0, __builtin_bit_cast(int, w), 0x128  , 0xf, 0xf, false));
    auto rr = __builtin_amdgcn_permlane16_swap(__float_as_uint(t), __float_as_uint(t), false, false);
    return __uint_as_float(rr[0]) + __uint_as_float(rr[1]);
}
template <int CTRL> __device__ __forceinline__ float dppf(float v) { return __builtin_bit_cast(float, __builtin_amdgcn_update_dpp(0, __builtin_bit_cast(int, v), CTRL, 0xf, 0xf, false)); }
template <int CTRL> __device__ __forceinline__ int dppi(int v) { return __builtin_amdgcn_update_dpp(0, v, CTRL, 0xf, 0xf, false); }
__device__ __forceinline__ void imp_add(LAS char* lds, const f32x16& p0, const f32x16& p1, int kt0, float il, int ql, int lane) {
    LAS float* imp = (LAS float*)(lds + IMP); const int r32 = lane & 31, hi = lane >> 5;
#pragma unroll
    for (int sub = 0; sub < 2; ++sub)
#pragma unroll
        for (int g4 = 0; g4 < 4; ++g4) {
            const float a0 = sub ? p1[4 * g4] : p0[4 * g4], a1 = sub ? p1[4 * g4 + 1] : p0[4 * g4 + 1], a2 = sub ? p1[4 * g4 + 2] : p0[4 * g4 + 2], a3 = sub ? p1[4 * g4 + 3] : p0[4 * g4 + 3];
            float w = (a0 + a1 + a2 + 0.5f * a3) * il, w2 = 0.5f * a3 * il;
            w = headsum4(w); w2 = headsum4(w2);
            const int j = (kt0 + 32 * sub + 8 * g4 + 4 * hi) >> 2;
            if ((r32 >> 3) == 0) { atomicAdd((float*)(imp + ql * 129 + j), w); if (j + 1 < 128) atomicAdd((float*)(imp + ql * 129 + j + 1), w2); }
        }
}
template <int DQK, int DV, bool DO_PV, bool BIAS, bool WINDOWED, bool CAUSAL, bool SELM, bool IMPT = false>
__device__ __forceinline__ void run_branch(LAS char* lds, const Src& src, int t_lo, int t_hi, const Wv& wv, const Col& col, int W, int pmq, const int2* pmm,
                                           const unsigned long long sello, const unsigned long long selhi, const bf16x8 (&qf)[DQK / 16], f32x16 (&o)[DV / 32], float& m, float& l, f32x16& pA0, f32x16& pA1, int tid_in, int lane_in, float imp_il = 0.f, int imp_ql = 0) {
    int lane = lane_in; asm volatile("" : "+v"(lane));
    const int tid = (tid_in & ~63) | lane;
    unsigned long long ulo = 0ull, uhi = 0ull;
    if (SELM) { const LAS unsigned* selu = (const LAS unsigned*)(lds + SELU);
        ulo = (unsigned long long)(unsigned)__builtin_amdgcn_readfirstlane((int)selu[0]) | ((unsigned long long)(unsigned)__builtin_amdgcn_readfirstlane((int)selu[1]) << 32);
        uhi = (unsigned long long)(unsigned)__builtin_amdgcn_readfirstlane((int)selu[2]) | ((unsigned long long)(unsigned)__builtin_amdgcn_readfirstlane((int)selu[3]) << 32); }
    auto want = [&](int t) -> bool { return !SELM || ((((t < 64) ? ulo : uhi) >> (t & 63)) & 1ull); };
    auto nxt = [&](int t) -> int { ++t; while (t <= t_hi && !want(t)) ++t; return t; };
    auto classify = [&](int t) -> int { const int kt0 = t * 64; bool skip = false, allv = true;
        if (CAUSAL) { skip = kt0 > wv.l1; allv = (kt0 + 63 <= wv.l0); }
        if (WINDOWED) { skip = skip || (wv.q0 - (kt0 + 63) >= W); allv = allv && (wv.q1 - kt0 < W); }
        bool farb = true; if (BIAS) { farb = (pmq - pmm[t].y >= 128); }
        return (!skip && allv && farb) ? 1 : 2; };
    auto inc = [&](int t) -> bool { if (!SELM) return true; const unsigned long long w = (t < 64) ? sello : selhi; return (w >> (t & 63)) & 1ull; };
    int tc = t_lo - 1; tc = nxt(tc);
    if (tc > t_hi) return;
    int tn = nxt(tc), tnn = (tn <= t_hi) ? nxt(tn) : tn;
    Stage<DQK, DV> st;
    {   Stage<DQK, DV> s2;
        tile_load<DQK, DV, BIAS>(st, src, tc * 64, tid); if (tn <= t_hi) load_k<DQK, DV, BIAS>(s2, src, tn * 64, tid);
        tile_store<DQK, DV, BIAS>(st, lds, 0, tid); if (tn <= t_hi) store_k<DQK, DV, BIAS>(s2, lds, 1, tid); }
    __syncthreads();
    int ik = 0, iv = 0;
    f32x16 pB0, pB1;
    qk_part<DQK>(lds, 0, qf, pA0, pA1, lane);
#define ATT_STEP(c0, c1, n0, n1) { \
        const bool hasNN = tnn <= t_hi; \
        if (ATT_PROBE == 3) { Stage<DQK, DV> sj; if (hasNN) load_k<DQK, DV, BIAS>(sj, src, tnn * 64, tid); load_v<DQK, DV>(sj, src, tn * 64, tid); asm volatile("" :: "v"(sj.k[0]), "v"(sj.v[0])); } \
        if (hasNN) load_k<DQK, DV, BIAS>(st, src, tnn * 64, tid); \
        load_v<DQK, DV>(st, src, tn * 64, tid); \
        const int ikn = (ik == 2) ? 0 : ik + 1, iknn = (ikn == 2) ? 0 : ikn + 1; \
        if (!SELM || __builtin_amdgcn_ballot_w64(inc(tn)) != 0ull) qk_pipe<DQK>(lds, ikn, qf, n0, n1, lane);     \
        const bool incl_ = inc(tc); \
        if (!SELM || __builtin_amdgcn_ballot_w64(incl_) != 0ull) {     \
            const float off = max_part<DV, BIAS, WINDOWED, DO_PV>(lds, ik, tc * 64, classify(tc), incl_, col, W, o, m, l, c0, c1, lane); \
            bf16x8 kfd_[DQK / 16][2]; exp_part<DQK, false>(kfd_, qf, off, l, c0, c1, n0, n1, lane); \
            if (IMPT) imp_add(lds, c0, c1, tc * 64, imp_il, imp_ql, lane); \
            if (DO_PV) pv_part<DV>(lds, iv, c0, c1, o, lane); } \
        if (hasNN) store_k<DQK, DV, BIAS>(st, lds, iknn, tid); \
        store_v<DQK, DV>(st, lds, iv ^ 1, tid); \
        __syncthreads(); if (ATT_PROBE == 4) { __syncthreads(); __syncthreads(); } \
        tc = tn; tn = tnn; tnn = hasNN ? nxt(tnn) : tnn; ik = ikn; iv ^= 1; }
    bool inA = true;
    while (tn <= t_hi) {
        ATT_STEP(pA0, pA1, pB0, pB1)
        if (!(tn <= t_hi)) { inA = false; break; }
        ATT_STEP(pB0, pB1, pA0, pA1)
    }
#undef ATT_STEP
    if (!inA) { pA0 = pB0; pA1 = pB1; }
    {   const bool inclf = inc(tc);
        if (!SELM || __builtin_amdgcn_ballot_w64(inclf) != 0ull) {
            const float off = max_part<DV, BIAS, WINDOWED, DO_PV>(lds, ik, tc * 64, classify(tc), inclf, col, W, o, m, l, pA0, pA1, lane);
            bf16x8 kfd[DQK / 16][2]; exp_part<DQK, false>(kfd, qf, off, l, pA0, pA1, pB0, pB1, lane);
            if (IMPT) imp_add(lds, pA0, pA1, tc * 64, imp_il, imp_ql, lane);
            if (DO_PV) pv_part<DV>(lds, iv, pA0, pA1, o, lane); } }
    __syncthreads();
}
template <int DQK, int DV, bool DO_PV, bool BIAS, bool WINDOWED, bool CAUSAL, bool SELM>
__device__ __forceinline__ void run_branch_np(LAS char* lds, const Src& src, int t_lo, int t_hi, const Wv& wv, const Col& col, int W, int pmq, const int2* pmm,
                                           const unsigned long long sello, const unsigned long long selhi, const bf16x8 (&qf)[DQK / 16], f32x16 (&o)[DV / 32], float& m, float& l, f32x16& p0, f32x16& p1, int tid, int lane) {
    const LAS unsigned* selu = (const LAS unsigned*)(lds + SELU);
    auto want = [&](int t) -> bool { return !SELM || ((selu[t >> 5] >> (t & 31)) & 1u); };
    int t = t_lo; while (t <= t_hi && !want(t)) ++t;
    if (t > t_hi) return;
    Stage<DQK, DV> st;
    tile_load<DQK, DV, BIAS>(st, src, t * 64, tid); tile_store<DQK, DV, BIAS>(st, lds, 0, tid); __syncthreads();
    int buf = 0;
    for (;;) {
        int tn = t + 1; while (tn <= t_hi && !want(tn)) ++tn;
        const bool has = tn <= t_hi;
        if (has) tile_load<DQK, DV, BIAS>(st, src, tn * 64, tid);
        const int kt0 = t * 64;
        int mode;
        {   bool skip = false, allv = true;
            if (CAUSAL) { skip = kt0 > wv.l1; allv = (kt0 + 63 <= wv.l0); }
            if (WINDOWED) { skip = skip || (wv.q0 - (kt0 + 63) >= W); allv = allv && (wv.q1 - kt0 < W); }
            bool farb = true; if (BIAS) { farb = (pmq - pmm[t].y >= 128); }
            mode = skip ? 0 : ((allv && farb) ? 1 : 2); }
        bool incl = true;
        if (SELM) { const unsigned long long w = (t < 64) ? sello : selhi; incl = (w >> (t & 63)) & 1ull; }
        if (mode) tile_compute<DQK, DV, DO_PV, BIAS, WINDOWED>(lds, buf, kt0, mode, incl, col, W, qf, o, m, l, p0, p1, lane);
        if (has) tile_store<DQK, DV, BIAS>(st, lds, buf ^ 1, tid);
        __syncthreads();
        if (!has) break;
        t = tn; buf ^= 1;
    }
}
template <int DV> __device__ __forceinline__ void store_col(const f32x16 (&o)[DV / 32], float inv, const bf16_t* gate, bf16_t* out, int hi) {
    u32x2 gw[DV / 32][4];
#pragma unroll
    for (int bk = 0; bk < DV / 32; ++bk)
#pragma unroll
        for (int g4 = 0; g4 < 4; ++g4) gw[bk][g4] = *(const u32x2*)(gate + 32 * bk + 8 * g4 + 4 * hi);
#pragma unroll
    for (int bk = 0; bk < DV / 32; ++bk)
#pragma unroll
        for (int gp = 0; gp < 2; ++gp) {
            u32x2 w[2];
#pragma unroll
            for (int e = 0; e < 2; ++e) { const int g4 = 2 * gp + e; const u32x2 g = gw[bk][g4];
                const float g0 = __uint_as_float(g.x << 16), g1 = __uint_as_float(g.x & 0xffff0000u), g2 = __uint_as_float(g.y << 16), g3 = __uint_as_float(g.y & 0xffff0000u);
                w[e].x = pk2(o[bk][4 * g4] * inv * g0, o[bk][4 * g4 + 1] * inv * g1); w[e].y = pk2(o[bk][4 * g4 + 2] * inv * g2, o[bk][4 * g4 + 3] * inv * g3); }
            auto sx = __builtin_amdgcn_permlane32_swap(w[0].x, w[1].x, false, false); auto sy = __builtin_amdgcn_permlane32_swap(w[0].y, w[1].y, false, false);
            u32x4 v; v.x = sx[0]; v.y = sy[0]; v.z = sx[1]; v.w = sy[1];
            *(u32x4*)(out + 32 * bk + 8 * (2 * gp + hi)) = v; }
}
struct Ptrs { const bf16_t* PROJ; const bf16_t* QKV; const bf16_t* MKV; const bf16_t* KC; const bf16_t* VC; bf16_t* ATT; const int* pos; const int* cpos; const int2* pmm; const int2* cpmm; const float* sinks; int layer; };

__device__ __forceinline__ void unit_mla(LAS char* lds, const Ptrs& P, int b, int h, int qb, int tid_in, int lane_in, int wid) {
    int lane = lane_in; asm volatile("" : "+v"(lane)); const int tid = (tid_in & ~63) | lane;
    const int r32 = lane & 31, hi = lane >> 5, q0 = qb * 256, wq0 = q0 + 32 * wid, qi = wq0 + r32; const size_t row = (size_t)b * S + qi;
    bf16x8 qf[6]; { const bf16_t* qp = P.QKV + row * QKVW + h * 96 + 8 * hi;
#pragma unroll
        for (int s = 0; s < 6; ++s) qf[s] = *(const bf16x8*)(qp + 16 * s); }
    const Src src{P.QKV + (size_t)b * S * QKVW + 768 + h * 128, P.PROJ + (size_t)b * S * PE + E_KPE, P.QKV + (size_t)b * S * QKVW + 768 + h * 128 + 64, QKVW, PE, QKVW, nullptr};
    const Wv wv{wq0, wq0 + 31, wq0, wq0 + 31}; const Col col{qi, qi, 0, 0};
    f32x16 o[2] = {{0}, {0}}, p0, p1; float m = NEG, l = 0.f;
    run_branch<96, 64, true, false, false, true, false>(lds, src, 0, (q0 + 255) >> 6, wv, col, 0, 0, nullptr, 0ull, 0ull, qf, o, m, l, p0, p1, tid, lane);
    l = swapsum(l);
    store_col<64>(o, 1.f / fmaxf(l, 1e-30f), P.PROJ + row * PE + E_GMLA + h * 64, P.ATT + row * 1536 + h * 64, hi);
}
__device__ __forceinline__ void sm_update(f32x16& p0, f32x16& p1, bool near, int up, float& m, float& l, f32x16 (&o)[2]) {
    if (near) {
#pragma unroll
        for (int r = 0; r < 16; ++r) { const int ko = (r & 3) + 8 * (r >> 2); p0[r] = (ko <= up) ? p0[r] : NEG; p1[r] = (ko + 32 <= up) ? p1[r] : NEG; } }
    float a = fmaxf(fmaxf(p0[0], p0[1]), p1[0]), b = fmaxf(fmaxf(p0[2], p0[3]), p1[1]); a = fmaxf(fmaxf(a, p1[2]), p1[3]);
#pragma unroll
    for (int r = 4; r < 16; r += 4) { a = fmaxf(fmaxf(a, p0[r]), p0[r + 1]); b = fmaxf(fmaxf(b, p0[r + 2]), p0[r + 3]); a = fmaxf(fmaxf(a, p1[r]), p1[r + 1]); b = fmaxf(fmaxf(b, p1[r + 2]), p1[r + 3]); }
    const float tmax = swapmax(fmaxf(a, b));
    if (__builtin_amdgcn_ballot_w64(tmax - m > SM_THR) != 0ull) { const float mnew = fmaxf(m, tmax); const float f = __builtin_amdgcn_exp2f(m - mnew); l *= f; m = mnew;
#pragma unroll
        for (int bk = 0; bk < 2; ++bk)
#pragma unroll
            for (int r = 0; r < 16; ++r) o[bk][r] *= f; }
    const float off = (m > -1e29f) ? -m : NEG; float sum = 0.f;
#pragma unroll
    for (int r = 0; r < 16; ++r) { p0[r] = __builtin_amdgcn_exp2f(p0[r] + off); p1[r] = __builtin_amdgcn_exp2f(p1[r] + off); sum += p0[r] + p1[r]; }
    l += sum;
}
__device__ __forceinline__ void unit_mla2(LAS char* lds, const Ptrs& P, int b, int h, int qb2, int tid_in, int lane_in, int wid) {
    int lane = lane_in; asm volatile("" : "+v"(lane)); const int tid = (tid_in & ~63) | lane;
    constexpr int KP = KPitch<96>::v, VP = VPitch<64>::v;
    const int r32 = lane & 31, hi = lane >> 5, q0 = qb2 * 512, wq0 = q0 + 64 * wid, qiA = wq0 + r32, qiB = qiA + 32; const size_t rowA = (size_t)b * S + qiA;
    bf16x8 qfA[6], qfB[6]; { const bf16_t* qp = P.QKV + rowA * QKVW + h * 96 + 8 * hi;
#pragma unroll
        for (int s = 0; s < 6; ++s) { qfA[s] = *(const bf16x8*)(qp + 16 * s); qfB[s] = *(const bf16x8*)(qp + (size_t)32 * QKVW + 16 * s); } }
    const Src src{P.QKV + (size_t)b * S * QKVW + 768 + h * 128, P.PROJ + (size_t)b * S * PE + E_KPE, P.QKV + (size_t)b * S * QKVW + 768 + h * 128 + 64, QKVW, PE, QKVW, nullptr};
    f32x16 oA[2] = {{0}, {0}}, oB[2] = {{0}, {0}}; float mA = NEG, lA = 0.f, mB = NEG, lB = 0.f;
    const int T = (q0 + 511) >> 6, tw = wq0 >> 6;
    Stage<96, 64> st;
    tile_load<96, 64, false>(st, src, 0, tid); tile_store<96, 64, false>(st, lds, 0, tid); __syncthreads();
    int buf = 0;
    for (int t = 0; t <= T; ++t) {
        const bool has = t < T;
        if (has) tile_load<96, 64, false>(st, src, (t + 1) * 64, tid);
        if (t <= tw) {
            const int kt0 = t * 64; const bool near = (t == tw);
            int hl = lane >> 5; asm volatile("" : "+v"(hl));
            const LAS char* kb = lds + kslot(buf) + r32 * KP + hl * 16;
            f32x16 pA0 = {0}, pA1 = {0}, pB0 = {0}, pB1 = {0};
            __builtin_amdgcn_s_setprio(1);
#pragma unroll
            for (int s = 0; s < 6; ++s) { const bf16x8 k0 = *(const LAS bf16x8*)(kb + s * 32), k1 = *(const LAS bf16x8*)(kb + 32 * KP + s * 32);
                pA0 = __builtin_amdgcn_mfma_f32_32x32x16_bf16(k0, qfA[s], pA0, 0, 0, 0); pB0 = __builtin_amdgcn_mfma_f32_32x32x16_bf16(k0, qfB[s], pB0, 0, 0, 0);
                pA1 = __builtin_amdgcn_mfma_f32_32x32x16_bf16(k1, qfA[s], pA1, 0, 0, 0); pB1 = __builtin_amdgcn_mfma_f32_32x32x16_bf16(k1, qfB[s], pB1, 0, 0, 0); }
            __builtin_amdgcn_s_setprio(0);
            sm_update(pA0, pA1, near, qiA - kt0 - 4 * hl, mA, lA, oA);
            sm_update(pB0, pB1, near, qiB - kt0 - 4 * hl, mB, lB, oB);
            __builtin_amdgcn_s_setprio(1);
            const LAS char* vb = lds + vslot(buf) + (4 * hl + ((lane & 15) >> 2)) * VP + (((lane >> 4) & 1) * 16 + (lane & 3) * 4) * 2;
#pragma unroll
            for (int sub = 0; sub < 2; ++sub)
#pragma unroll
                for (int ks = 0; ks < 2; ++ks) {
                    u32x4 wa, wb;
                    if (sub == 0) { wa.x = pk2(pA0[8 * ks], pA0[8 * ks + 1]); wa.y = pk2(pA0[8 * ks + 2], pA0[8 * ks + 3]); wa.z = pk2(pA0[8 * ks + 4], pA0[8 * ks + 5]); wa.w = pk2(pA0[8 * ks + 6], pA0[8 * ks + 7]);
                                    wb.x = pk2(pB0[8 * ks], pB0[8 * ks + 1]); wb.y = pk2(pB0[8 * ks + 2], pB0[8 * ks + 3]); wb.z = pk2(pB0[8 * ks + 4], pB0[8 * ks + 5]); wb.w = pk2(pB0[8 * ks + 6], pB0[8 * ks + 7]); }
                    else          { wa.x = pk2(pA1[8 * ks], pA1[8 * ks + 1]); wa.y = pk2(pA1[8 * ks + 2], pA1[8 * ks + 3]); wa.z = pk2(pA1[8 * ks + 4], pA1[8 * ks + 5]); wa.w = pk2(pA1[8 * ks + 6], pA1[8 * ks + 7]);
                                    wb.x = pk2(pB1[8 * ks], pB1[8 * ks + 1]); wb.y = pk2(pB1[8 * ks + 2], pB1[8 * ks + 3]); wb.z = pk2(pB1[8 * ks + 4], pB1[8 * ks + 5]); wb.w = pk2(pB1[8 * ks + 6], pB1[8 * ks + 7]); }
                    const bf16x8 pa = __builtin_bit_cast(bf16x8, wa), pb = __builtin_bit_cast(bf16x8, wb);
#pragma unroll
                    for (int bk = 0; bk < 2; ++bk) { const LAS char* vp = vb + (32 * sub + 16 * ks) * VP + bk * 64;
                        const s16x4 lo = vtr(vp), hi4 = vtr(vp + 8 * VP); const bf16x8 va = __builtin_shufflevector(lo, hi4, 0, 1, 2, 3, 4, 5, 6, 7);
                        oA[bk] = __builtin_amdgcn_mfma_f32_32x32x16_bf16(va, pa, oA[bk], 0, 0, 0); oB[bk] = __builtin_amdgcn_mfma_f32_32x32x16_bf16(va, pb, oB[bk], 0, 0, 0); }
                }
            __builtin_amdgcn_s_setprio(0);
        }
        if (has) tile_store<96, 64, false>(st, lds, buf ^ 1, tid);
        __syncthreads();
        buf ^= 1;
    }
    lA = swapsum(lA); lB = swapsum(lB);
    store_col<64>(oA, 1.f / fmaxf(lA, 1e-30f), P.PROJ + rowA * PE + E_GMLA + h * 64, P.ATT + rowA * 1536 + h * 64, hi);
    store_col<64>(oB, 1.f / fmaxf(lB, 1e-30f), P.PROJ + (rowA + 32) * PE + E_GMLA + h * 64, P.ATT + (rowA + 32) * 1536 + h * 64, hi);
}
__device__ __forceinline__ void unit_mem(LAS char* lds, const Ptrs& P, int b, int h, int qb, int ld, int qc, int gc, int ldo, int oc, int tid_in, int lane_in, int wid) {
    int lane = lane_in; asm volatile("" : "+v"(lane)); const int tid = (tid_in & ~63) | lane;
    const int r32 = lane & 31, hi = lane >> 5, qi = qb * 256 + 32 * wid + r32; const size_t row = (size_t)b * S + qi;
    bf16x8 qf[8]; { const bf16_t* qp = P.PROJ + row * ld + qc + h * 128 + 8 * hi;
#pragma unroll
        for (int s = 0; s < 8; ++s) qf[s] = *(const bf16x8*)(qp + 16 * s); }
    const bf16_t* kv = P.MKV + (size_t)b * MEML * 4096 + P.layer * 1024 + h * 128;
    const Src src{kv, nullptr, kv + 512, 4096, 0, 4096, nullptr};
    const Wv wv{1 << 30, 1 << 30, qi, qi}; const Col col{qi, 1 << 30, 0, 0};
    f32x16 o[4] = {{0}, {0}, {0}, {0}}, p0, p1; float m = NEG, l = 0.f;
    run_branch_np<128, 128, true, false, false, false, false>(lds, src, 0, 3, wv, col, 0, 0, nullptr, 0ull, 0ull, qf, o, m, l, p0, p1, tid, lane);
    l = swapsum(l);
    store_col<128>(o, 1.f / l, P.PROJ + row * ld + gc + h * 128, P.ATT + row * ldo + oc + h * 128, hi);
}
__device__ __forceinline__ void unit_swa(LAS char* lds, const Ptrs& P, int b, int g, int qblk, int tid_in, int lane_in, int wid) {
    int lane = lane_in; asm volatile("" : "+v"(lane)); const int tid = (tid_in & ~63) | lane;
    const int r32 = lane & 31, hi = lane >> 5, q0 = qblk * 64, wq0 = q0 + 8 * wid, qi = wq0 + (r32 & 7), hc = 4 * g + (r32 >> 3); const size_t row = (size_t)b * S + qi;
    bf16x8 qf[4]; { const bf16_t* qp = P.PROJ + row * PE + E_QSWA + hc * 64 + 8 * hi;
#pragma unroll
        for (int s = 0; s < 4; ++s) qf[s] = *(const bf16x8*)(qp + 16 * s); }
    const Src src{P.PROJ + (size_t)b * S * PE + E_KSWA + g * 64, nullptr, P.PROJ + (size_t)b * S * PE + E_VSWA + g * 64, PE, 0, PE, P.pos};
    const Wv wv{wq0, wq0 + 7, wq0, wq0 + 7}; const Col col{qi, qi, P.pos[qi], hc};
    f32x16 o[2] = {{0}, {0}}, p0, p1; float m = P.sinks[hc] * LOG2E, l = hi ? 0.f : 1.f;
    run_branch<64, 64, true, true, true, true, false>(lds, src, qblk >= 2 ? qblk - 2 : 0, qblk, wv, col, 128, P.pmm[qblk].x, P.pmm, 0ull, 0ull, qf, o, m, l, p0, p1, tid, lane);
    l = swapsum(l);
    store_col<64>(o, 1.f / fmaxf(l, 1e-30f), P.PROJ + row * PE + E_GSWA + hc * 64, P.ATT + row * 1536 + 512 + hc * 64, hi);
}
__device__ __forceinline__ void unit_nsa(LAS char* lds, const Ptrs& P, int b, int g, int cur, int tid_in, int lane_in, int wid) {
    int lane = lane_in; asm volatile("" : "+v"(lane)); const int tid = (tid_in & ~63) | lane;
    const int r32 = lane & 31, hi = lane >> 5, q0 = cur * 64, ql = 8 * wid + (r32 & 7), qi = q0 + ql, hc = 4 * g + (r32 >> 3); const size_t row = (size_t)b * S + qi;
    bf16x8 qf[4]; { const bf16_t* qp = P.PROJ + row * PO + O_Q + hc * 64 + 8 * hi;
#pragma unroll
        for (int s = 0; s < 4; ++s) qf[s] = *(const bf16x8*)(qp + 16 * s); }
    LAS float* imp = (LAS float*)(lds + IMP); LAS unsigned* selws = (LAS unsigned*)(lds + SELW); LAS unsigned* selu = (LAS unsigned*)(lds + SELU);
    for (int i = tid; i < 64 * 129; i += 512) imp[i] = 0.f;
    if (tid < 4) selu[tid] = 0u;
    const int pq = P.pos[qi], pmq = P.pmm[cur].x, wq0 = q0 + 8 * wid;
    f32x16 o[2], p0, p1; unsigned long long sello = 0ull, selhi = 0ull;
#define NSA_GL (P.PROJ + ((size_t)b * S + qi) * PO + O_GL + hc * 3)
    {   const int cl = (qi >= 31) ? ((qi - 31) >> 4) : -1; const int cl0 = (wq0 >= 31) ? ((wq0 - 31) >> 4) : -1, cl1 = (wq0 + 7 >= 31) ? ((wq0 + 7 - 31) >> 4) : -1;
        const int tmax = ((q0 + 63 - 31) >> 4) >> 6;
        const Src src{P.KC + (size_t)(b * 2 + g) * 512 * 64, nullptr, P.VC + (size_t)(b * 2 + g) * 512 * 64, 64, 0, 64, P.cpos};
        const Wv wv{cl0, cl1, wq0, wq0 + 7}; const Col col{qi, cl, pq, hc};
        float m = NEG, l = 0.f; o[0] = (f32x16){0}; o[1] = (f32x16){0};
        run_branch<64, 64, false, true, false, true, false>(lds, src, 0, tmax, wv, col, 0, pmq, P.cpmm, 0ull, 0ull, qf, o, m, l, p0, p1, tid, lane);
        l = swapsum(l); const float il = 1.f / fmaxf(l, 1e-30f);
        {   float l2 = 0.f;
            run_branch<64, 64, true, true, false, true, false, true>(lds, src, 0, tmax, wv, col, 0, pmq, P.cpmm, 0ull, 0ull, qf, o, m, l2, p0, p1, tid, lane, il, ql); }
#pragma unroll
        for (int bk = 0; bk < 2; ++bk)
#pragma unroll
            for (int r = 0; r < 16; ++r) o[bk][r] *= bf2f(NSA_GL[0]) * il;
    }
    {   int lk = lane; asm volatile("" : "+v"(lk)); const int qsel = 8 * wid + (lk >> 3), s = lk & 7; unsigned mk[4] = {0, 0, 0, 0};
        if (cur <= 15) { mk[0] = (cur == 31) ? 0xffffffffu : ((1u << (cur + 1)) - 1u); }
        else {
            float v[16];
#pragma unroll
            for (int t = 0; t < 16; ++t) { const int j = 16 * s + t; v[t] = (j >= 1 && j <= cur - 2) ? imp[qsel * 129 + j] : -1.f; }
            mk[0] = 1u;
            #pragma unroll
            for (int w = 0; w < 4; ++w) { if ((cur >> 5) == w) mk[w] |= 1u << (cur & 31); if (((cur - 1) >> 5) == w) mk[w] |= 1u << ((cur - 1) & 31); }
            for (int rnd = 0; rnd < 13; ++rnd) {
                float best = v[0]; int bi = 0;
#pragma unroll
                for (int t = 1; t < 16; ++t) if (v[t] > best) { best = v[t]; bi = t; }
                int bj = 16 * s + bi;
                { const float ov = dppf<0xB1>(best); const int oj = dppi<0xB1>(bj); if (ov > best || (ov == best && oj < bj)) { best = ov; bj = oj; } }
                { const float ov = dppf<0x4E>(best); const int oj = dppi<0x4E>(bj); if (ov > best || (ov == best && oj < bj)) { best = ov; bj = oj; } }
                { const float ov = dppf<0x141>(best); const int oj = dppi<0x141>(bj); if (ov > best || (ov == best && oj < bj)) { best = ov; bj = oj; } }
                if (best >= 0.f) {
#pragma unroll
                    for (int t = 0; t < 16; ++t) if (16 * s + t == bj) v[t] = -1.f;
#pragma unroll
                    for (int w = 0; w < 4; ++w) if ((bj >> 5) == w) mk[w] |= 1u << (bj & 31);
                }
            }
        }
        if (s == 0) {
#pragma unroll
            for (int w = 0; w < 4; ++w) { selws[qsel * 4 + w] = mk[w]; atomicOr((unsigned*)(selu + w), mk[w]); } }
    }
    __syncthreads();
    sello = (unsigned long long)selws[ql * 4 + 0] | ((unsigned long long)selws[ql * 4 + 1] << 32); selhi = (unsigned long long)selws[ql * 4 + 2] | ((unsigned long long)selws[ql * 4 + 3] << 32);
#define NSA_STASH ((LAS bf16_t*)(lds + IMP) + wid * 2048 + r32 * 64 + 4 * hi)
#pragma unroll
    for (int bk = 0; bk < 2; ++bk)
#pragma unroll
        for (int g4 = 0; g4 < 4; ++g4) { u32x2 w; w.x = pk2(o[bk][4 * g4], o[bk][4 * g4 + 1]); w.y = pk2(o[bk][4 * g4 + 2], o[bk][4 * g4 + 3]); *(LAS u32x2*)(NSA_STASH + 32 * bk + 8 * g4) = w; }
    {   const Src src{P.PROJ + (size_t)b * S * PO + O_KSLC + g * 64, nullptr, P.PROJ + (size_t)b * S * PO + O_VSLC + g * 64, PO, 0, PO, P.pos};
        const Wv wv{wq0, wq0 + 7, wq0, wq0 + 7}; const Col col{qi, qi, pq, hc};
        float m = NEG, l = 0.f; o[0] = (f32x16){0}; o[1] = (f32x16){0};
        run_branch<64, 64, true, true, false, true, true>(lds, src, 0, cur, wv, col, 0, pmq, P.pmm, sello, selhi, qf, o, m, l, p0, p1, tid, lane);
        l = swapsum(l); const float il = bf2f(NSA_GL[1]) / fmaxf(l, 1e-30f);
#pragma unroll
        for (int bk = 0; bk < 2; ++bk)
#pragma unroll
            for (int g4 = 0; g4 < 4; ++g4) { const u32x2 pv = *(const LAS u32x2*)(NSA_STASH + 32 * bk + 8 * g4);
                u32x2 w; w.x = pk2(__uint_as_float(pv.x << 16) + il * o[bk][4 * g4], __uint_as_float(pv.x & 0xffff0000u) + il * o[bk][4 * g4 + 1]);
                w.y = pk2(__uint_as_float(pv.y << 16) + il * o[bk][4 * g4 + 2], __uint_as_float(pv.y & 0xffff0000u) + il * o[bk][4 * g4 + 3]); *(LAS u32x2*)(NSA_STASH + 32 * bk + 8 * g4) = w; }
    }
    {   const Src src{P.PROJ + (size_t)b * S * PO + O_KWIN + g * 64, nullptr, P.PROJ + (size_t)b * S * PO + O_VWIN + g * 64, PO, 0, PO, P.pos};
        const Wv wv{wq0, wq0 + 7, wq0, wq0 + 7}; const Col col{qi, qi, pq, hc};
        float m = NEG, l = 0.f; o[0] = (f32x16){0}; o[1] = (f32x16){0};
        run_branch<64, 64, true, true, true, true, false>(lds, src, cur >= 8 ? cur - 8 : 0, cur, wv, col, 512, pmq, P.pmm, 0ull, 0ull, qf, o, m, l, p0, p1, tid, lane);
        l = swapsum(l); const float il = bf2f(NSA_GL[2]) / fmaxf(l, 1e-30f);
#pragma unroll
        for (int bk = 0; bk < 2; ++bk)
#pragma unroll
            for (int g4 = 0; g4 < 4; ++g4) { const u32x2 pv = *(const LAS u32x2*)(NSA_STASH + 32 * bk + 8 * g4);
                o[bk][4 * g4] = __uint_as_float(pv.x << 16) + il * o[bk][4 * g4]; o[bk][4 * g4 + 1] = __uint_as_float(pv.x & 0xffff0000u) + il * o[bk][4 * g4 + 1];
                o[bk][4 * g4 + 2] = __uint_as_float(pv.y << 16) + il * o[bk][4 * g4 + 2]; o[bk][4 * g4 + 3] = __uint_as_float(pv.y & 0xffff0000u) + il * o[bk][4 * g4 + 3]; }
    }
    store_col<64>(o, 1.f, P.PROJ + ((size_t)b * S + qi) * PO + O_GNSA + hc * 64, P.ATT + ((size_t)b * S + qi) * 1024 + hc * 64, hi);
#undef NSA_GL
#undef NSA_STASH
}
}
#define XB_TMO      128
#define XB_XCNT(j)  (256  + 64 * (j))
#define XB_XSUB(j)  (1280 + 64 * (j))
#define XB_XGEN(j)  (2304 + 64 * (j))
#define XB_TOP      3328
#define XB_TOPGEN   3392
#define XCD_BAR_WORDS 3456
#define XB_SPIN_CAP (1u << 18)
__device__ __forceinline__ unsigned xb_ld(unsigned* p)              { return __hip_atomic_load(p, __ATOMIC_RELAXED, __HIP_MEMORY_SCOPE_AGENT); }
__device__ __forceinline__ unsigned xb_add(unsigned* p, unsigned v) { return __hip_atomic_fetch_add(p, v, __ATOMIC_RELAXED, __HIP_MEMORY_SCOPE_AGENT); }
__device__ __forceinline__ unsigned xb_xcc_id() { return (unsigned)__builtin_amdgcn_s_getreg((3 << 11) | 20) & 0xFu; }
#define XB_SPIN(cond, bar) do { unsigned _sp = 0; while (cond) { __builtin_amdgcn_s_sleep(1); \
    if ((++_sp & 255u) == 0u) { if (xb_ld(&(bar)[XB_TMO])) break; if (_sp > XB_SPIN_CAP) { atomicAdd(&(bar)[XB_TMO], 1u); break; } } } } while (0)
struct XcdBarrier { unsigned* bar; unsigned x; volatile LAS unsigned* st; };
__device__ __forceinline__ XcdBarrier xcd_barrier_post(unsigned* bar, volatile LAS unsigned* st, bool leader) {
    XcdBarrier b; b.bar = bar; b.x = xb_xcc_id(); b.st = st;
    if (leader) (void)xb_add(&bar[XB_XCNT(b.x)], 1u);
    return b;
}
__device__ __forceinline__ void xcd_barrier_complete(unsigned* bar, unsigned x, unsigned& nloc, unsigned& nx) {
    const unsigned G = gridDim.x * gridDim.y * gridDim.z;
    unsigned sum, cnt, mine, sp = 0u;
    for (;;) {
        sum = 0u; cnt = 0u; mine = 0u;
#pragma unroll
        for (unsigned j = 0; j < 16; ++j) { const unsigned c = xb_ld(&bar[XB_XCNT(j)]); sum += c; cnt += (c > 0u) ? 1u : 0u; mine = (j == x) ? c : mine; }
        if (sum == G) break;
        __builtin_amdgcn_s_sleep(1);
        if ((++sp & 255u) == 0u) { if (xb_ld(&bar[XB_TMO])) break; if (sp > XB_SPIN_CAP) { atomicAdd(&bar[XB_TMO], 1u); break; } }
    }
    nloc = mine > 0u ? mine : 1u; nx = cnt > 0u ? cnt : 1u;
}
__device__ __forceinline__ void xcd_barrier(const XcdBarrier& b, bool leader) {
    asm volatile("s_waitcnt vmcnt(0)" ::: "memory");
    __syncthreads();
    if (leader) {
        unsigned* bar = b.bar;
        __builtin_amdgcn_s_waitcnt(0);
        unsigned nloc = b.st[0], nx = b.st[1];
        if (nloc == 0u) { xcd_barrier_complete(bar, b.x, nloc, nx); b.st[0] = nloc; b.st[1] = nx; }
        const unsigned old = xb_add(&bar[XB_XSUB(b.x)], 1u);
        const unsigned gen = old / nloc;
        if (old + 1u == (gen + 1u) * nloc) {
            __builtin_amdgcn_fence(__ATOMIC_RELEASE, "agent");
            asm volatile("s_waitcnt vmcnt(0)" ::: "memory");
            const unsigned og = xb_add(&bar[XB_TOP], 1u);
            const unsigned tg = og / nx;
            if (og + 1u == (tg + 1u) * nx) xb_add(&bar[XB_TOPGEN], 1u);
            else XB_SPIN(xb_ld(&bar[XB_TOPGEN]) == tg, bar);
            __builtin_amdgcn_fence(__ATOMIC_ACQUIRE, "agent");
            xb_add(&bar[XB_XGEN(b.x)], 1u);
            asm volatile("s_waitcnt vmcnt(0)" ::: "memory");
        } else {
            XB_SPIN(xb_ld(&bar[XB_XGEN(b.x)]) == gen, bar);
            __builtin_amdgcn_fence(__ATOMIC_ACQUIRE, "agent");
            asm volatile("s_waitcnt vmcnt(0)" ::: "memory");
        }
    }
    __syncthreads();
}

constexpr int NWAVES = 8, RING_BYTES = 131072, MISC_OFF = 143360, LDS_BYTES = 147456;
struct Args { const void* in[23]; float* out; unsigned char* ws; int ph_lo, ph_hi, li, pad; };

template <class F> __device__ __forceinline__ void conv_item(F val, int K, bf16_t* Wt, LAS float* scr, int item, int nblk, int lane) {
    const int kb = item / nblk, nb = item % nblk, k0 = 64 * kb, n0 = 32 * nb;
#pragma unroll 8
    for (int i = 0; i < 32; ++i) { const int kk = 2 * i + (lane >> 5); scr[kk * 33 + (lane & 31)] = val(k0 + kk, n0 + (lane & 31)); }
    asm volatile("s_waitcnt lgkmcnt(0)" ::: "memory");
    const int c = lane & 7;
#pragma unroll
    for (int j = 0; j < 4; ++j) { const int n = (lane >> 3) + 8 * j; const LAS float* sp = scr + (8 * c) * 33 + n;
        u32x4 o; o.x = pk2(sp[0], sp[33]); o.y = pk2(sp[2 * 33], sp[3 * 33]); o.z = pk2(sp[4 * 33], sp[5 * 33]); o.w = pk2(sp[6 * 33], sp[7 * 33]);
        *(u32x4*)(Wt + (size_t)(n0 + n) * K + k0 + 8 * c) = o; }
    asm volatile("s_waitcnt lgkmcnt(0)" ::: "memory");
}
__device__ __forceinline__ int map_even(int n, float& sc) {
    sc = 1.f;
    if (n < 256) return n; if (n < 384) return 256 + (n - 256); if (n < 512) return 1440 + (n - 384); if (n < 640) return 1568 + (n - 512);
    if (n < 672) { const int j = n - 640; return 384 + ((j & 1) ? (j >> 1) + 16 : (j >> 1)); }
    if (n < 768) return -1; if (n < 1280) return 416 + (n - 768);
    if (n < 1792) { sc = 0.125f * LOG2E; return 928 + (n - 1280); } if (n < 2304) return 1696 + (n - 1792);
    if (n < 2816) { sc = 0.08838834764831845f * LOG2E; return 2208 + (n - 2304); } return 2720 + (n - 2816);
}
__device__ __forceinline__ int map_odd(int n, float& sc) {
    sc = 1.f;
    if (n < 512) { sc = 0.125f * LOG2E; return n; } if (n < 1304) return n; if (n < 1536) return -1; if (n < 2048) return 1304 + (n - 1536);
    if (n < 2560) { sc = 0.08838834764831845f * LOG2E; return 1816 + (n - 2048); } return 2328 + (n - 2560);
}
constexpr int N_PHASES = 24;
#ifndef MK_SITES
#define MK_SITES 0x1fff
#endif
#define SITE(k) (((MK_SITES) >> (k)) & 1)
#ifndef MK_UNITS
#define MK_UNITS 15
#endif
#ifndef MK_DUP
#define MK_DUP 0
#endif
#define NREP(k) ((((MK_DUP) >> (k)) & 1) ? 2 : 1)
__global__ void __launch_bounds__(NWAVES * 64, 2) mega(Args a) {
    extern __shared__ __attribute__((aligned(16))) unsigned char lds_raw[];
    LAS unsigned char* lds = (LAS unsigned char*)lds_raw;
    volatile LAS unsigned* MISC = (volatile LAS unsigned*)(lds + MISC_OFF);
    const int tid0 = threadIdx.x; const int wid0 = __builtin_amdgcn_readfirstlane(tid0 >> 6);
    const int G = gridDim.x, bx = blockIdx.x, NGW = G * NWAVES;
#define WSB() unsigned long long wz_ = 0ull; asm volatile("" : "+s"(wz_)); unsigned char* ws = a.ws + wz_;     unsigned* ctl = (unsigned*)(ws + WS_CTL); (void)ctl; \
    unsigned ones_ = ~0u; asm volatile("" : "+s"(ones_)); const int lane = (int)__builtin_amdgcn_mbcnt_hi(ones_, __builtin_amdgcn_mbcnt_lo(ones_, 0u)); int wid_ = wid0; asm volatile("" : "+s"(wid_)); const int wid = wid_, tid = wid * 64 + lane, gw = bx * NWAVES + wid; (void)tid; (void)gw
#define PTR_STATS() float* ssqx = (float*)(ws + WS_SSQX); float* ssqq = (float*)(ws + WS_SSQQ4); float* ssqkv = (float*)(ws + WS_SSQKV4); float* ssqy = (float*)(ws + WS_SSQY16); (void)ssqx; (void)ssqq; (void)ssqkv; (void)ssqy
#define PTR_ACT() bf16_t* XB = (bf16_t*)(ws + WS_A); bf16_t* ATT = (bf16_t*)(ws + WS_A); bf16_t* PROJ = (bf16_t*)(ws + WS_B); bf16_t* Y = (bf16_t*)(ws + WS_B); bf16_t* QKV = (bf16_t*)(ws + WS_C); (void)XB; (void)ATT; (void)PROJ; (void)Y; (void)QKV
    float* const out = a.out;
    for (int u = tid0; u < (LDS_BYTES - MISC_OFF) / 4; u += NWAVES * 64) ((LAS unsigned*)(lds + MISC_OFF))[u] = 0u;
    __syncthreads();
    XcdBarrier bar; bar.bar = (unsigned*)(a.ws + WS_CTL) + CW_BAR + a.li * XCD_BAR_WORDS; bar.x = 0; bar.st = nullptr;
    if (!MK_PER_PHASE) bar = xcd_barrier_post((unsigned*)(a.ws + WS_CTL) + CW_BAR + a.li * XCD_BAR_WORDS, MISC + 8, tid0 == 0);
    const int lo = a.ph_lo, hi = a.ph_hi;
#define IN(k) (lo <= (k) && (k) < hi)
#define SEAM(k) do { if ((k) + 1 < hi) xcd_barrier(bar, tid == 0); } while (0)
#define Q_INIT() do { if (tid == 0) { MISC[5] = 0u; MISC[6] = 0u; } } while (0)
#define Q_NEXT(head, NQ, dst, dq) do { __syncthreads(); if (tid == 0) { unsigned q_ = MISC[5], tr_ = MISC[6]; int u_ = -1; const unsigned x_ = xb_xcc_id() & 7u; \
        while (tr_ < 8u) { const unsigned v_ = __hip_atomic_fetch_add((head) + ((x_ + q_) & 7u) * 64, 1u, __ATOMIC_RELAXED, __HIP_MEMORY_SCOPE_AGENT); if (v_ < (unsigned)(NQ)) { u_ = (int)v_; break; } ++q_; ++tr_; } \
        MISC[5] = q_; MISC[6] = tr_; MISC[4] = (unsigned)u_; MISC[7] = (x_ + q_) & 7u; } __syncthreads(); (dst) = (int)MISC[4]; (dq) = (int)MISC[7]; } while (0)
#define STAGE_LUT() do { const float* lut_ = (const float*)(ws + WS_LUT); for (int i_ = tid; i_ < 8 * 132; i_ += NWAVES * 64) ((LAS float*)(lds + att::LUTO))[i_] = lut_[i_]; __syncthreads(); } while (0)

    if (SITE(0) && IN(0)) {
        WSB(); PTR_STATS(); PTR_ACT();
        const float* x = (const float*)a.in[0]; const float* mem = (const float*)a.in[1]; const int* pos = (const int*)a.in[2]; const float* table = (const float*)a.in[3];
        const float* norm_pre = (const float*)a.in[4]; const float* mem_norm = (const float*)a.in[6]; const float* w_mem_kv = (const float*)a.in[7];
        const float* w_in_even = (const float*)a.in[8]; const float* mla_q_norm = (const float*)a.in[9]; const float* mla_kv_norm = (const float*)a.in[10]; const float* mla_w_uq = (const float*)a.in[11];
        const float* mla_w_ukv = (const float*)a.in[12]; const float* w_out_even = (const float*)a.in[14]; const float* w_in_odd = (const float*)a.in[15];
        const float* cmp_pos_k = (const float*)a.in[16]; const float* cmp_pos_v = (const float*)a.in[17]; const float* cmp_w1_k = (const float*)a.in[18]; const float* cmp_w1_v = (const float*)a.in[20]; const float* w_out_odd = (const float*)a.in[22];
        float* rstdm = (float*)(ws + WS_RSTDM); int2* pmm = (int2*)(ws + WS_PMM); int2* cpmm = pmm + 128; int* cpos = (int*)(ws + WS_CPOS);
        float2* rope = (float2*)(ws + WS_ROPE); float* lut = (float*)(ws + WS_LUT); float* pb = (float*)(ws + WS_PB);
        bf16_t* WINE = (bf16_t*)(ws + WS_WINE); bf16_t* WINO = (bf16_t*)(ws + WS_WINO); bf16_t* WOUTE = (bf16_t*)(ws + WS_WOUTE); bf16_t* WOUTO = (bf16_t*)(ws + WS_WOUTO);
        bf16_t* WMKV = (bf16_t*)(ws + WS_WMKV); bf16_t* WUP = (bf16_t*)(ws + WS_WUP); bf16_t* WC1 = (bf16_t*)(ws + WS_WC1); bf16_t* MEMB = (bf16_t*)(ws + WS_MEMB);
        LAS float* scr = (LAS float*)(lds + wid * 16384);
        constexpr int I0 = 1664, I1 = 1536, I2 = 768, I3 = 512, I4 = 512, I5 = 336, I6 = 256;
        constexpr int S1 = 2 * I0, S2 = S1 + 2 * I1, S3 = S2 + 2 * I2, S4 = S3 + 2 * I3, S5 = S4 + 4 * I4, S6 = S5 + 2 * I5, S7 = S6 + 4 * I6;
        for (int it = gw; it < S7; it += NGW) {
            if (it < S1) { const int e = it / I0, r = it % I0; const float* W = w_in_even + (size_t)e * DM * 3232; const float* gn = norm_pre + (2 * e) * DM;
                conv_item([&](int k, int n) -> float { float sc; const int s = map_even(n, sc); return s < 0 ? 0.f : W[(size_t)k * 3232 + s] * sc * gn[k]; }, DM, WINE + (size_t)e * PE * DM, scr, r, PE / 32, lane); }
            else if (it < S2) { const int e = (it - S1) / I1, r = (it - S1) % I1; const float* W = w_in_odd + (size_t)e * DM * 2840; const float* gn = norm_pre + (2 * e + 1) * DM;
                conv_item([&](int k, int n) -> float { float sc; const int s = map_odd(n, sc); return s < 0 ? 0.f : W[(size_t)k * 2840 + s] * sc * gn[k]; }, DM, WINO + (size_t)e * PO * DM, scr, r, PO / 32, lane); }
            else if (it < S3) { const int e = (it - S2) / I2, r = (it - S2) % I2; const float* W = w_out_even + (size_t)e * 1536 * DM;
                conv_item([&](int k, int n) -> float { return W[(size_t)k * DM + n]; }, 1536, WOUTE + (size_t)e * DM * 1536, scr, r, DM / 32, lane); }
            else if (it < S4) { const int e = (it - S3) / I3, r = (it - S3) % I3; const float* W = w_out_odd + (size_t)e * DM * DM;
                conv_item([&](int k, int n) -> float { return W[(size_t)k * DM + n]; }, DM, WOUTO + (size_t)e * DM * DM, scr, r, DM / 32, lane); }
            else if (it < S5) { const int l = (it - S4) / I4, r = (it - S4) % I4; const float* W = w_mem_kv + (size_t)l * DM * DM; const float* gn = mem_norm + l * DM;
                conv_item([&](int k, int n) -> float { return W[(size_t)k * DM + n] * gn[k]; }, DM, WMKV + (size_t)l * DM * DM, scr, r, DM / 32, lane); }
            else if (it < S6) { const int e = (it - S5) / I5, r = (it - S5) % I5; const float* Wq = mla_w_uq + (size_t)e * 256 * 768; const float* Wk = mla_w_ukv + (size_t)e * 128 * 1024;
                const float* gq = mla_q_norm + e * 256; const float* gk = mla_kv_norm + e * 128;
                conv_item([&](int k, int n) -> float {
                    if (n < 768) { if (k >= 256) return 0.f; const int h = n / 96, j = n % 96; const int s = (j < 64) ? n : h * 96 + 64 + (((j - 64) & 1) ? ((j - 64) >> 1) + 16 : ((j - 64) >> 1));
                        return Wq[(size_t)k * 768 + s] * (0.10206207261596575f * LOG2E) * gq[k]; }
                    if (k < 256) return 0.f; return Wk[(size_t)(k - 256) * 1024 + (n - 768)] * gk[k - 256]; }, 384, WUP + (size_t)e * QKVW * 384, scr, r, QKVW / 32, lane); }
            else { const int m4 = (it - S6) / I6, r = (it - S6) % I6; const float* W = ((m4 & 1) ? cmp_w1_v : cmp_w1_k) + (size_t)(m4 >> 1) * 2048 * 256;
                conv_item([&](int k, int n) -> float { return W[(size_t)k * 256 + n]; }, 2048, WC1 + (size_t)m4 * 256 * 2048, scr, r, 256 / 32, lane); }
        }
        for (int row = gw; row < T + NB * MEML; row += NGW) {
            const bool isx = row < T; const int r = isx ? row : row - T; const float* src = (isx ? x : mem) + (size_t)r * DM; bf16_t* dst = (isx ? XB : MEMB) + (size_t)r * DM;
            float s = 0.f;
#pragma unroll
            for (int j = 0; j < 4; ++j) { const f32x4 v = *(const f32x4*)(src + 4 * (lane + 64 * j)); s += (v[0] * v[0] + v[1] * v[1]) + (v[2] * v[2] + v[3] * v[3]);
                u32x2 w; w.x = pk2(v[0], v[1]); w.y = pk2(v[2], v[3]); *(u32x2*)(dst + 4 * (lane + 64 * j)) = w; }
            s = wave_sum(s);
            if (lane == 0) { if (isx) ssqx[r] = s; else rstdm[r] = rsqrtf(s * (1.f / DM) + EPS); }
        }
        for (int idx = bx * (NWAVES * 64) + tid; idx < S * 16; idx += G * NWAVES * 64) {
            { const int s = idx >> 4, i = idx & 15; const float inv = powf(10000.0f, -(float)i / 16.0f); const float ang = (float)pos[s] * inv; float sn, cs; sincosf(ang, &sn, &cs); rope[idx] = make_float2(cs, sn); }
            if (idx < 8 * 132) { const int h = idx / 132, d = idx % 132; int bucket;
                if (d < 16) bucket = d; else { const float lr = logf((float)d / 16.0f) / logf(8.0f); const int lg = 16 + (int)(lr * 16.0f); bucket = lg < 31 ? lg : 31; }
                lut[idx] = table[bucket * 8 + h] * LOG2E; }
            if (idx < 128) { int mn = pos[idx * 64], mx = mn; for (int i = 1; i < 64; ++i) { const int p = pos[idx * 64 + i]; mn = p < mn ? p : mn; mx = p > mx ? p : mx; } pmm[idx] = make_int2(mn, mx); }
            if (idx < 512) { const int tk = 16 * idx + 31; cpos[idx] = pos[tk < S ? tk : S - 1]; }
            if (idx < 8) { int mn = 0x7fffffff, mx = -0x7fffffff; for (int i = 0; i < 64; ++i) { const int tk = 16 * (idx * 64 + i) + 31; const int p = pos[tk < S ? tk : S - 1]; mn = p < mn ? p : mn; mx = p > mx ? p : mx; } cpmm[idx] = make_int2(mn, mx); }
        }
        for (int it = gw; it < 256; it += NGW) { const int kc = it >> 4, m4 = (it >> 2) & 3, n = (it & 3) * 64 + lane;
            const float* pe = ((m4 & 1) ? cmp_pos_v : cmp_pos_k) + (size_t)(m4 >> 1) * 2048 + kc * 128; const float* w = ((m4 & 1) ? cmp_w1_v : cmp_w1_k) + (size_t)(m4 >> 1) * 2048 * 256 + (size_t)kc * 128 * 256 + n;
            float s0 = 0.f, s1 = 0.f, s2 = 0.f, s3 = 0.f;
#pragma unroll 8
            for (int k = 0; k < 128; k += 4) { s0 += pe[k] * w[(size_t)k * 256]; s1 += pe[k + 1] * w[(size_t)(k + 1) * 256]; s2 += pe[k + 2] * w[(size_t)(k + 2) * 256]; s3 += pe[k + 3] * w[(size_t)(k + 3) * 256]; }
            pb[(kc * 4 + m4) * 256 + n] = (s0 + s1) + (s2 + s3); }
        SEAM(0);
    }
    if (SITE(1) && IN(1)) {
        WSB(); bf16_t* MEMB = (bf16_t*)(ws + WS_MEMB); bf16_t* WMKV = (bf16_t*)(ws + WS_WMKV); bf16_t* MKV = (bf16_t*)(ws + WS_MKV); float* rstdm = (float*)(ws + WS_RSTDM);
        pg8::Gemm g{MEMB, WMKV, DM, DM * 2, DM * 2, 128, 0}; pg8::StaticOrder SO; SO.init(NB * MEML / 256, 4096 / 256, G, bx);
        pg8::EpiStore E{MKV, rstdm, nullptr, 4096};
        pg8::gemm_phase<pg8::EpiStore, pg8::StaticOrder, true, true>(lds, g, SO, E, wid);
        SEAM(1);
    }
    for (int pr = 0; pr < 2; ++pr) {
        const int base = 2 + pr * 11;
        if (SITE(2) && IN(base + 0)) {
            WSB(); PTR_STATS(); PTR_ACT(); bf16_t* WINE = (bf16_t*)(ws + WS_WINE); const float2* rope = (const float2*)(ws + WS_ROPE);
            pg8::Gemm g{XB, WINE + (size_t)pr * PE * DM, DM, DM * 2, DM * 2, 128, 0}; pg8::StaticOrder SO; SO.init(T / 256, PE / 256, G, bx);
            pg8::EpiWin E{PROJ, ssqx, rope, ssqq, ssqkv, PE, 0};
            pg8::gemm_phase<pg8::EpiWin, pg8::StaticOrder, true, true>(lds, g, SO, E, wid);
            SEAM(base + 0);
        }
        if (SITE(3) && IN(base + 1)) {
            WSB(); PTR_STATS(); PTR_ACT(); bf16_t* WUP = (bf16_t*)(ws + WS_WUP); const float2* rope = (const float2*)(ws + WS_ROPE);
            pg8::Gemm g{PROJ, WUP + (size_t)pr * QKVW * 384, 384, PE * 2, 384 * 2, 128, 0}; pg8::StaticOrder SO; SO.init(T / 256, QKVW / 256, G, bx);
            pg8::EpiUp E{QKV, ssqq, ssqkv, rope};
            pg8::gemm_phase<pg8::EpiUp, pg8::StaticOrder, true, true>(lds, g, SO, E, wid);
            SEAM(base + 1);
        }
        if (SITE(4) && IN(base + 2)) {
            WSB(); PTR_ACT(); const int* pos = (const int*)a.in[2]; const float* swa_sinks = (const float*)a.in[13]; bf16_t* MKV = (bf16_t*)(ws + WS_MKV); bf16_t* KC = (bf16_t*)(ws + WS_KC); bf16_t* VC = (bf16_t*)(ws + WS_VC);
            const int2* pmm = (const int2*)(ws + WS_PMM); const int2* cpmm = pmm + 128; const int* cpos = (const int*)(ws + WS_CPOS);
            STAGE_LUT();
            const att::Ptrs P{PROJ, QKV, MKV, KC, VC, ATT, pos, cpos, pmm, cpmm, swa_sinks + pr * 8, 2 * pr};
            unsigned* head = ctl + CW_Q + (pr * 2 + 0) * 512 + a.li * 16;
            Q_INIT();
            for (;;) { int u, xq; Q_NEXT(head, 512, u, xq); if (u < 0) break;
                if (u < 128) { const int bh = xq + 8 * (u >> 4); if (MK_UNITS & 1) att::unit_mla2((LAS char*)lds, P, bh >> 3, bh & 7, 15 - (u & 15), tid, lane, wid); }
                else if (u < 256) { const int v = u - 128, bh = xq + 8 * (v >> 5); if (MK_UNITS & 2) att::unit_mem((LAS char*)lds, P, bh >> 2, bh & 3, v & 31, PE, E_QMEM, E_GMEM, 1536, 1024, tid, lane, wid); }
                else { const int v = u - 256, bg = xq + 8 * (v >> 7); if (MK_UNITS & 4) att::unit_swa((LAS char*)lds, P, bg >> 1, bg & 1, 127 - (v & 127), tid, lane, wid); } }
            SEAM(base + 2);
        }
        if (SITE(5) && IN(base + 3)) {
            WSB(); PTR_STATS(); PTR_ACT(); bf16_t* WOUTE = (bf16_t*)(ws + WS_WOUTE);
            pg8::Gemm g{ATT, WOUTE + (size_t)pr * DM * 1536, 1536, 1536 * 2, 1536 * 2, 128, 0}; pg8::StaticOrder SO; SO.init(T / 256, DM / 256, G, bx);
            pg8::EpiStore E{Y, nullptr, ssqy, DM};
            pg8::gemm_phase<pg8::EpiStore, pg8::StaticOrder, true, true>(lds, g, SO, E, wid);
            SEAM(base + 3);
        }
#define RESID(L, XIN, WXB) do { const float* gp_ = norm_post + (L) * DM; const float* xin_ = (XIN); \
            for (int row = gw; row < T; row += NGW) { float sy_; { const f32x4* q_ = (const f32x4*)(ssqy + (size_t)row * 16); const f32x4 a_ = q_[0], b_ = q_[1], c_ = q_[2], d_ = q_[3]; \
                    sy_ = (((a_[0] + a_[1]) + (a_[2] + a_[3])) + ((b_[0] + b_[1]) + (b_[2] + b_[3]))) + (((c_[0] + c_[1]) + (c_[2] + c_[3])) + ((d_[0] + d_[1]) + (d_[2] + d_[3]))); } \
                const float rs = rsqrtf(sy_ * (1.f / DM) + EPS); float s2 = 0.f; \
                _Pragma("unroll") for (int j = 0; j < 4; ++j) { const int c = 4 * (lane + 64 * j); const u32x2 yw = *(const u32x2*)(Y + (size_t)row * DM + c); const f32x4 xv = *(const f32x4*)(xin_ + (size_t)row * DM + c); const f32x4 gv = *(const f32x4*)(gp_ + c); \
                    f32x4 v; v[0] = xv[0] + __uint_as_float(yw.x << 16) * rs * gv[0]; v[1] = xv[1] + __uint_as_float(yw.x & 0xffff0000u) * rs * gv[1]; v[2] = xv[2] + __uint_as_float(yw.y << 16) * rs * gv[2]; v[3] = xv[3] + __uint_as_float(yw.y & 0xffff0000u) * rs * gv[3]; \
                    *(f32x4*)(out + (size_t)row * DM + c) = v; if (WXB) { u32x2 w; w.x = pk2(v[0], v[1]); w.y = pk2(v[2], v[3]); *(u32x2*)(XB + (size_t)row * DM + c) = w; } s2 += (v[0] * v[0] + v[1] * v[1]) + (v[2] * v[2] + v[3] * v[3]); } \
                s2 = wave_sum(s2); if (lane == 0) ssqx[row] = s2; } } while (0)
        if (SITE(6) && IN(base + 4)) { WSB(); PTR_STATS(); PTR_ACT(); const float* norm_post = (const float*)a.in[5]; RESID(2 * pr, (pr == 0) ? (const float*)a.in[0] : (const float*)out, true); SEAM(base + 4); }
        if (SITE(7) && IN(base + 5)) {
            WSB(); PTR_STATS(); PTR_ACT(); bf16_t* WINO = (bf16_t*)(ws + WS_WINO); const float2* rope = (const float2*)(ws + WS_ROPE);
            pg8::Gemm g{XB, WINO + (size_t)pr * PO * DM, DM, DM * 2, DM * 2, 128, 0}; pg8::StaticOrder SO; SO.init(T / 256, PO / 256, G, bx);
            pg8::EpiWin E{PROJ, ssqx, rope, ssqq, ssqkv, PO, 1};
            pg8::gemm_phase<pg8::EpiWin, pg8::StaticOrder, true, true>(lds, g, SO, E, wid);
            SEAM(base + 5);
        }
        if (SITE(8) && IN(base + 6)) { WSB(); PTR_ACT(); bf16_t* WC1 = (bf16_t*)(ws + WS_WC1); float* PART = (float*)(ws + WS_C);
            pg8::Gemm gk{PROJ + O_KCMP, WC1 + (size_t)(pr * 2) * 256 * 2048, 512, 16 * PO * 2, 2048 * 2, PO * 2, 2}; pg8::StaticOrder S1; S1.init(256, 1, G, bx);
            pg8::EpiPart Ek{PART};
            pg8::gemm_phase<pg8::EpiPart, pg8::StaticOrder, true, true>(lds, gk, S1, Ek, wid);
            SEAM(base + 6);
        }
        if (SITE(9) && IN(base + 7)) { WSB(); const float* PART = (const float*)(ws + WS_C); bf16_t* KC = (bf16_t*)(ws + WS_KC); bf16_t* VC = (bf16_t*)(ws + WS_VC); const float* pb = (const float*)(ws + WS_PB) + pr * 512;     const float* cmp_w2_k = (const float*)a.in[19]; const float* cmp_w2_v = (const float*)a.in[21];
            LAS float* w2s = (LAS float*)lds;
            const float* w2k = cmp_w2_k + (size_t)pr * 256 * 64; const float* w2v = cmp_w2_v + (size_t)pr * 256 * 64;
            for (int i = tid; i < 256 * 64; i += NWAVES * 64) { w2s[i] = w2k[i]; w2s[256 * 64 + i] = w2v[i]; }
            __syncthreads();
            f32x4 pbs[2];
#pragma unroll
            for (int kv_ = 0; kv_ < 2; ++kv_) { f32x4 acc_ = (f32x4){0.f, 0.f, 0.f, 0.f};
                for (int kc = 0; kc < 16; ++kc) acc_ += *(const f32x4*)(pb + (kc * 4 + kv_) * 256 + 4 * lane);
                pbs[kv_] = acc_; }
            for (int it = gw; it < 2 * 8192; it += NGW) { const int kv = it >> 13, row = it & 8191; const f32x4 pbsum = kv ? pbs[1] : pbs[0]; const float* pp = PART + ((size_t)kv * 4 * 8192 + row) * 256 + 4 * lane; const LAS float* wp = w2s + kv * 256 * 64 + lane;
                const f32x4 q0 = *(const f32x4*)pp, q1 = *(const f32x4*)(pp + (size_t)8192 * 256), q2 = *(const f32x4*)(pp + (size_t)2 * 8192 * 256), q3 = *(const f32x4*)(pp + (size_t)3 * 8192 * 256), bb = pbsum;
                f32x4 h = ((q0 + q1) + (q2 + q3)) + bb;
#pragma unroll
                for (int i = 0; i < 4; ++i) h[i] = silu_f(h[i]);
                float s = 0.f;
#pragma unroll
                for (int k4 = 0; k4 < 64; ++k4) { const float h0 = __uint_as_float(__builtin_amdgcn_readlane(__float_as_uint(h[0]), k4)), h1 = __uint_as_float(__builtin_amdgcn_readlane(__float_as_uint(h[1]), k4)),
                                                              h2 = __uint_as_float(__builtin_amdgcn_readlane(__float_as_uint(h[2]), k4)), h3 = __uint_as_float(__builtin_amdgcn_readlane(__float_as_uint(h[3]), k4));
                    s += h0 * wp[(4 * k4) * 64] + h1 * wp[(4 * k4 + 1) * 64] + h2 * wp[(4 * k4 + 2) * 64] + h3 * wp[(4 * k4 + 3) * 64]; }
                (kv ? VC : KC)[(size_t)row * 64 + lane] = ((row & 511) == 511) ? (bf16_t)0 : f2bf(s); }
            __syncthreads();
            SEAM(base + 7);
        }
        if (SITE(10) && IN(base + 8)) {
            WSB(); PTR_ACT(); const int* pos = (const int*)a.in[2]; const float* swa_sinks = (const float*)a.in[13]; bf16_t* MKV = (bf16_t*)(ws + WS_MKV); bf16_t* KC = (bf16_t*)(ws + WS_KC); bf16_t* VC = (bf16_t*)(ws + WS_VC);
            const int2* pmm = (const int2*)(ws + WS_PMM); const int2* cpmm = pmm + 128; const int* cpos = (const int*)(ws + WS_CPOS);
            STAGE_LUT();
            const att::Ptrs P{PROJ, QKV, MKV, KC, VC, ATT, pos, cpos, pmm, cpmm, swa_sinks, 2 * pr + 1};
            unsigned* head = ctl + CW_Q + (pr * 2 + 1) * 512 + a.li * 16;
            Q_INIT();
            for (;;) { int u, xq; Q_NEXT(head, 384, u, xq); if (u < 0) break;
                if (u < 256) { const int bg = xq + 8 * (u >> 7); if (MK_UNITS & 8) att::unit_nsa((LAS char*)lds, P, bg >> 1, bg & 1, 127 - (u & 127), tid, lane, wid); }
                else { const int v = u - 256, bh = xq + 8 * (v >> 5); if (MK_UNITS & 2) att::unit_mem((LAS char*)lds, P, bh >> 2, bh & 3, v & 31, PO, O_QMEM, O_GMEM, 1024, 512, tid, lane, wid); } }
            SEAM(base + 8);
        }
        if (SITE(11) && IN(base + 9)) {
            WSB(); PTR_STATS(); PTR_ACT(); bf16_t* WOUTO = (bf16_t*)(ws + WS_WOUTO);
            pg8::Gemm g{ATT, WOUTO + (size_t)pr * DM * DM, DM, DM * 2, DM * 2, 128, 0}; pg8::StaticOrder SO; SO.init(T / 256, DM / 256, G, bx);
            pg8::EpiStore E{Y, nullptr, ssqy, DM};
            pg8::gemm_phase<pg8::EpiStore, pg8::StaticOrder, true, true>(lds, g, SO, E, wid);
            SEAM(base + 9);
        }
        if (SITE(12) && IN(base + 10)) { WSB(); PTR_STATS(); PTR_ACT(); const float* norm_post = (const float*)a.in[5]; RESID(2 * pr + 1, (const float*)out, pr == 0); SEAM(base + 10); }
    }
}

extern "C" void kernel_launch(void* const* d_in, const int* in_sizes, int n_in, void* d_out, int out_size, void* d_ws, size_t ws_size, hipStream_t stream) {
    static int ready = 0;
    if (ready == 0) {
        if (n_in != 23 || ws_size < WS_END) { fprintf(stderr, "kernel_launch: unexpected problem (n_in %d, ws %zu)\n", n_in, ws_size); ready = -1; return; }
        if (hipFuncSetAttribute((const void*)mega, hipFuncAttributeMaxDynamicSharedMemorySize, LDS_BYTES) != hipSuccess) { fprintf(stderr, "kernel_launch: hipFuncSetAttribute failed\n"); ready = -1; return; }
        int nb = 0, dev = 0, ncu = 0;
        if (hipOccupancyMaxActiveBlocksPerMultiprocessor(&nb, (const void*)mega, NWAVES * 64, LDS_BYTES) != hipSuccess) nb = 0;
        if (hipGetDevice(&dev) != hipSuccess || hipDeviceGetAttribute(&ncu, hipDeviceAttributeMultiprocessorCount, dev) != hipSuccess) ncu = 0;
        (void)hipGetLastError();
        ready = ((long)nb * ncu >= 256) ? 1 : 2;
    }
    if (ready < 0) return;
    (void)hipMemsetAsync((char*)d_ws + WS_CTL, 0, CTL_BYTES, stream);
    Args a{};
    for (int i = 0; i < 23; ++i) a.in[i] = d_in[i];
    a.out = (float*)d_out; a.ws = (unsigned char*)d_ws;
    const int grid = 256;
#if MK_PER_PHASE
    for (int p = 0; p < N_PHASES; ++p) { a.ph_lo = p; a.ph_hi = p + 1; hipLaunchKernelGGL(mega, dim3(grid), dim3(NWAVES * 64), LDS_BYTES, stream, a); }
#elif defined(MK_PROBE)
    a.ph_lo = 0; a.ph_hi = MK_PROBE + 1; a.li = 0; hipLaunchKernelGGL(mega, dim3(grid), dim3(NWAVES * 64), LDS_BYTES, stream, a);
    a.ph_lo = MK_PROBE; a.ph_hi = MK_PROBE + 1; a.li = 1; hipLaunchKernelGGL(mega, dim3(grid), dim3(NWAVES * 64), LDS_BYTES, stream, a);
    if (MK_PROBE + 1 < N_PHASES) { a.ph_lo = MK_PROBE + 1; a.ph_hi = N_PHASES; a.li = 2; hipLaunchKernelGGL(mega, dim3(grid), dim3(NWAVES * 64), LDS_BYTES, stream, a); }
#else
    if (ready == 1) { a.ph_lo = 0; a.ph_hi = N_PHASES; hipLaunchKernelGGL(mega, dim3(grid), dim3(NWAVES * 64), LDS_BYTES, stream, a); }
    else for (int p = 0; p < N_PHASES; ++p) { a.ph_lo = p; a.ph_hi = p + 1; hipLaunchKernelGGL(mega, dim3(grid), dim3(NWAVES * 64), LDS_BYTES, stream, a); }
#endif
}
```

```cpp
#include <hip/hip_runtime.h>
#include <stdint.h>
#include <stdio.h>

#ifndef MK_PER_PHASE
#define MK_PER_PHASE 0
#endif
#define LAS __attribute__((address_space(3)))
typedef unsigned short bf16_t;
typedef short bf16x8 __attribute__((ext_vector_type(8)));
typedef short s16x4 __attribute__((ext_vector_type(4)));
typedef float f32x16 __attribute__((ext_vector_type(16)));
typedef float f32x4 __attribute__((ext_vector_type(4)));
typedef float f32x2 __attribute__((ext_vector_type(2)));
typedef unsigned u32x4 __attribute__((ext_vector_type(4)));
typedef unsigned u32x2 __attribute__((ext_vector_type(2)));

constexpr int DM = 1024, NB = 8, S = 8192, T = NB * S, MEML = 256;
constexpr int PE = 3328, PO = 3072, QKVW = 1792;
constexpr float EPS = 1e-6f;
constexpr float LOG2E = 1.4426950408889634f;
constexpr float NEG = -1e30f;
constexpr int E_CQ = 0, E_CKV = 256, E_KSWA = 384, E_VSWA = 512, E_KPE = 640, E_GMLA = 768, E_QSWA = 1280, E_GSWA = 1792, E_QMEM = 2304, E_GMEM = 2816;
constexpr int O_Q = 0, O_KCMP = 512, O_VCMP = 640, O_KSLC = 768, O_VSLC = 896, O_KWIN = 1024, O_VWIN = 1152, O_GL = 1280, O_GNSA = 1536, O_QMEM = 2048, O_GMEM = 2560;

constexpr size_t MiB = 1u << 20;
constexpr size_t WS_CTL = 0, CTL_BYTES = 1 * MiB;
constexpr size_t WS_SSQX = 1 * MiB, WS_SSQQ = WS_SSQX + 256 * 1024, WS_SSQKV = WS_SSQQ + 256 * 1024, WS_SSQY = WS_SSQKV + 256 * 1024;
constexpr size_t WS_RSTDM = 2 * MiB;
constexpr size_t WS_PMM = 2 * MiB + 65536;
constexpr size_t WS_CPOS = 2 * MiB + 131072;
constexpr size_t WS_ROPE = 3 * MiB;
constexpr size_t WS_LUT = 4 * MiB;
constexpr size_t WS_PB = 4 * MiB + 65536;
constexpr size_t WS_WINE = 8 * MiB, WS_WINO = 21 * MiB, WS_WOUTE = 33 * MiB, WS_WOUTO = 39 * MiB, WS_WMKV = 43 * MiB, WS_WUP = 51 * MiB  , WS_WC1 = 54 * MiB;
constexpr size_t WS_MEMB = 58 * MiB, WS_MKV = 62 * MiB, WS_KC = 78 * MiB, WS_VC = 79 * MiB, WS_HC = 80 * MiB;
static_assert(WS_WUP + (size_t)2 * 1792 * 384 * 2 <= WS_WC1 && WS_WC1 + (size_t)4 * 256 * 2048 * 2 <= WS_MEMB && WS_HC + (size_t)2 * 8192 * 256 * 2 <= 88 * MiB, "workspace map");
constexpr size_t WS_SSQY16 = 90 * MiB, WS_SSQQ4 = 94 * MiB, WS_SSQKV4 = 95 * MiB;
constexpr size_t WS_A = 96 * MiB;
constexpr size_t WS_B = 288 * MiB;
constexpr size_t WS_C = 704 * MiB;
constexpr size_t WS_END = 928 * MiB;
constexpr int CW_BAR = 4096;
constexpr int CW_Q = 16384;

__device__ __forceinline__ float bf2f(bf16_t v) { return __uint_as_float(((unsigned)v) << 16); }
__device__ __forceinline__ bf16_t f2bf(float f) { unsigned u = __float_as_uint(f); return (bf16_t)((u + 0x7fffu + ((u >> 16) & 1u)) >> 16); }
__device__ __forceinline__ unsigned pk2(float lo, float hi) { typedef __bf16 bf2 __attribute__((ext_vector_type(2))); f32x2 v = {lo, hi}; return __builtin_bit_cast(unsigned, __builtin_convertvector(v, bf2)); }
__device__ __forceinline__ float silu_f(float v) { return v * __builtin_amdgcn_rcpf(1.f + __builtin_amdgcn_exp2f(-LOG2E * v)); }
__device__ __forceinline__ float sigm_f(float v) { return __builtin_amdgcn_rcpf(1.f + __builtin_amdgcn_exp2f(-LOG2E * v)); }
__device__ __forceinline__ int crow(int r, int hi) { return (r & 3) + 8 * (r >> 2) + 4 * hi; }
__device__ __forceinline__ float wave_sum(float v) {
#pragma unroll
    for (int o = 1; o < 64; o <<= 1) v += __shfl_xor(v, o);
    return v;
}
namespace pg8 {
#define PG8_LAS __attribute__((address_space(3)))
typedef unsigned short bf16_t;
typedef short bf16x8 __attribute__((ext_vector_type(8)));
typedef float f32x4 __attribute__((ext_vector_type(4)));
typedef unsigned u32x4 __attribute__((ext_vector_type(4)));
constexpr int BM = 256, BK = 64, HALF = 128, HTB = HALF * BK * 2  , STAGE_BYTES = 8 * HTB, NXCD = 8, WGM = 8;

__host__ __device__ __forceinline__ int lds_byte(int r, int c) { const int st = (r >> 4) * 2 + (c >> 5), rr = r & 15, cc = c & 31, ob = rr * 64 + cc * 2; return st * 1024 + (ob ^ (((ob >> 9) & 1) << 5)); }
__host__ __device__ __forceinline__ void stage_rc(int b, int& R, int& C) { const int st = b / 1024, sb = b % 1024, swz = sb ^ (((sb >> 9) & 1) << 5); R = (st >> 1) * 16 + swz / 64; C = (st & 1) * 32 + (swz % 64) / 2; }
__host__ __device__ __forceinline__ int perm32(int rho) { const int n = rho >> 4, i = rho & 15; return 8 * (i >> 2) + 4 * n + (i & 3); }

struct Unit { int pm, pn; };
struct Gemm { const bf16_t* A; const bf16_t* Bt; int K; int lda2, ldb2, kstepA, amode; };
__device__ __forceinline__ const char* a_tile(const Gemm& g, int pm) { if (g.amode == 0) return (const char*)g.A + (size_t)pm * 256 * g.lda2;
    const int kv = pm >> 7, kq = (pm >> 5) & 3, p32 = pm & 31, bg = p32 >> 1, b = bg >> 1, gg = bg & 1, half = p32 & 1;
    return (const char*)g.A + ((size_t)(b * 8192 + 4096 * half + 8 * kq) * 3072 + gg * 64 + kv * 128) * 2; }
__device__ __forceinline__ const char* b_tile(const Gemm& g, int pm, int pn) { if (g.amode == 0) return (const char*)g.Bt + (size_t)pn * 256 * g.ldb2;
    const int kv = pm >> 7, kq = (pm >> 5) & 3; return (const char*)g.Bt + ((size_t)kv * 256 * 2048 + kq * 512) * 2; }

struct StaticOrder {
    int nM, nN, nwg, G, c;
    __host__ __device__ void init(int nM_, int nN_, int G_, int c_) { nM = nM_; nN = nN_; nwg = nM * nN; G = G_; c = c_; }
    __host__ __device__ bool next(int i, Unit& u) const {
        const long L = (long)i * G + c; if (L >= nwg) return false;
        int wgid = (int)L; { const int q = nwg / NXCD, r = nwg % NXCD, xcd = wgid % NXCD, off = wgid / NXCD; wgid = (xcd < r ? xcd * (q + 1) : r * (q + 1) + (xcd - r) * q) + off; }
        const int nig = WGM * nN, gid = wgid / nig, fm = gid * WGM, gsz = (nM - fm) < WGM ? (nM - fm) : WGM;
        u.pm = fm + ((wgid % nig) % gsz); u.pn = (wgid % nig) / gsz; return true;
    }
    __device__ __forceinline__ void a_ready(const Unit&) const {}
    __device__ __forceinline__ void done(const Unit&) const {}
};

__device__ __forceinline__ unsigned cvt_pk_bf16(float lo, float hi) { unsigned r; asm volatile("v_cvt_pk_bf16_f32 %0, %1, %2" : "=v"(r) : "v"(lo), "v"(hi)); return r; }
template <class Epi, class Sched, bool ALIGN_EPI = false, bool SP2 = false>
__device__ __forceinline__ void gemm_phase(PG8_LAS unsigned char* lds, const Gemm g, const Sched& S, const Epi& E, const int wid) {
    unsigned ones_ = ~0u; asm volatile("" : "+s"(ones_)); const int lane = (int)__builtin_amdgcn_mbcnt_hi(ones_, __builtin_amdgcn_mbcnt_lo(ones_, 0u));
    const int tid = wid * 64 + lane, wr = wid >> 2, wc = wid & 3, fr = lane & 15, fq = lane >> 4;
    const int K = g.K, nt = K / BK;
    unsigned voffA[2], voffB[2];
#pragma unroll
    for (int i = 0; i < 2; ++i) { int R, C; stage_rc(tid * 16 + i * 8192, R, C); const int Rb = Epi::PERM ? ((R & ~31) + perm32(R & 31)) : R;
        voffA[i] = (unsigned)(R * g.lda2 + C * 2); voffB[i] = (unsigned)(Rb * g.ldb2 + C * 2); }
    const size_t kstepA = (size_t)g.kstepA, kstepB = (size_t)(BK * 2);
    const size_t hstepA = (size_t)HALF * g.lda2, hstepB = (size_t)HALF * g.ldb2;

    const unsigned ldsw = (unsigned)wid * 1024u;
    const int aoff = lds_byte(wr * 64 + fr, fq * 8), boff = lds_byte(wc * 32 + fr, fq * 8);
#define PG8_SA(b, h) (((b) * 2 + (h)) * HTB)
#define PG8_SB(b, h) ((4 + (b) * 2 + (h)) * HTB)
#define PG8_STAGE(bufoff, gbase, voff) do { _Pragma("unroll") for (int _i = 0; _i < 2; ++_i) \
        __builtin_amdgcn_global_load_lds((const unsigned*)((const char*)(gbase) + (voff)[_i]), (PG8_LAS unsigned*)(lds + (bufoff) + ldsw + _i * 8192), 16, 0, 0); } while (0)
#define PG8_LDA(dst, b, h) do { _Pragma("unroll") for (int m = 0; m < 4; ++m) _Pragma("unroll") for (int k = 0; k < 2; ++k) dst[m][k] = *(const PG8_LAS bf16x8*)(lds + PG8_SA(b, h) + aoff + m * 2048 + k * 1024); } while (0)
#define PG8_LDB(dst, b, h) do { _Pragma("unroll") for (int n = 0; n < 2; ++n) _Pragma("unroll") for (int k = 0; k < 2; ++k) dst[n][k] = *(const PG8_LAS bf16x8*)(lds + PG8_SB(b, h) + boff + n * 2048 + k * 1024); } while (0)
#define PG8_MMA(ai, bj, At, Bt) do { __builtin_amdgcn_s_setprio(1); _Pragma("unroll") for (int m = 0; m < 4; ++m) _Pragma("unroll") for (int n = 0; n < 2; ++n) _Pragma("unroll") for (int k = 0; k < 2; ++k) \
        acc[ai][bj][m][n] = __builtin_amdgcn_mfma_f32_16x16x32_bf16(Bt[n][k], At[m][k], acc[ai][bj][m][n], 0, 0, 0); __builtin_amdgcn_s_setprio(0); } while (0)
#define PG8_WAIT_V(n) asm volatile("s_waitcnt vmcnt(" #n ")" ::: "memory")
#define PG8_WAIT_L(n) asm volatile("s_waitcnt lgkmcnt(" #n ")" ::: "memory")
#define PG8_BAR __builtin_amdgcn_s_barrier()
#define PG8_SCHED __builtin_amdgcn_sched_barrier(0)
    Unit cur, nxt; int ui = 0;
    if (!S.next(0, cur)) return;
    f32x4 acc[2][2][4][2];
#pragma unroll
    for (int a = 0; a < 2; ++a)
#pragma unroll
        for (int b = 0; b < 2; ++b)
#pragma unroll
            for (int m = 0; m < 4; ++m)
#pragma unroll
                for (int n = 0; n < 2; ++n) acc[a][b][m][n] = (f32x4){0.f, 0.f, 0.f, 0.f};
    bf16x8 At[4][2], B0[2][2], B1[2][2];
    const char* cA = a_tile(g, cur.pm); const char* cB = b_tile(g, cur.pm, cur.pn);
    S.a_ready(cur);
    if constexpr (SP2) {
        PG8_STAGE(PG8_SB(0, 0), cB, voffB); PG8_STAGE(PG8_SB(0, 1), cB + hstepB, voffB); PG8_STAGE(PG8_SA(0, 0), cA, voffA); PG8_STAGE(PG8_SA(0, 1), cA + hstepA, voffA);
        if (wr == 1) PG8_BAR;
        PG8_WAIT_V(2); PG8_BAR;
        PG8_STAGE(PG8_SB(1, 0), cB + kstepB, voffB); PG8_STAGE(PG8_SA(1, 0), cA + kstepA, voffA); PG8_STAGE(PG8_SB(1, 1), cB + hstepB + kstepB, voffB);
        PG8_WAIT_V(6); PG8_BAR;
    } else {
        PG8_STAGE(PG8_SB(0, 0), cB, voffB); PG8_STAGE(PG8_SA(0, 0), cA, voffA); PG8_STAGE(PG8_SB(0, 1), cB + hstepB, voffB); PG8_STAGE(PG8_SA(0, 1), cA + hstepA, voffA);
        if (wr == 1) PG8_BAR;
        PG8_WAIT_V(4); PG8_BAR;
        PG8_STAGE(PG8_SB(1, 0), cB + kstepB, voffB); PG8_STAGE(PG8_SA(1, 0), cA + kstepA, voffA); PG8_STAGE(PG8_SB(1, 1), cB + hstepB + kstepB, voffB);
        PG8_WAIT_V(6); PG8_BAR;
    }
    for (;;) {
        const bool has_next = S.next(ui + 1, nxt);
        const char* nA = has_next ? a_tile(g, nxt.pm) : cA; const char* nB = has_next ? b_tile(g, nxt.pm, nxt.pn) : cB;
        for (int t = 0; t < nt; t += 2) {
            const bool last = (t == nt - 2);
            const char* a1 = cA + (size_t)(t + 1) * kstepA;
            const char* a2 = last ? nA : cA + (size_t)(t + 2) * kstepA; const char* b2 = last ? nB : cB + (size_t)(t + 2) * kstepB;
            const char* a3 = a2 + kstepA; const char* b3 = b2 + kstepB;
            if (last && has_next) S.a_ready(nxt);
            if constexpr (SP2) {
            PG8_LDB(B0, 0, 0); PG8_LDB(B1, 0, 1); PG8_SCHED; PG8_LDA(At, 0, 0); PG8_STAGE(PG8_SA(1, 1), a1 + hstepA, voffA);
            PG8_WAIT_V(8); PG8_WAIT_L(0); PG8_BAR; PG8_MMA(0, 0, At, B0); PG8_MMA(0, 1, At, B1); PG8_BAR; PG8_SCHED;
            PG8_LDA(At, 0, 1); PG8_STAGE(PG8_SB(0, 0), b2, voffB); PG8_STAGE(PG8_SB(0, 1), b2 + hstepB, voffB); PG8_STAGE(PG8_SA(0, 0), a2, voffA);
            PG8_WAIT_V(8); PG8_WAIT_L(0); PG8_BAR; PG8_MMA(1, 0, At, B0); PG8_MMA(1, 1, At, B1); PG8_BAR; PG8_SCHED;
            PG8_LDB(B0, 1, 0); PG8_LDB(B1, 1, 1); PG8_SCHED; PG8_LDA(At, 1, 0); PG8_STAGE(PG8_SA(0, 1), a2 + hstepA, voffA);
            PG8_WAIT_V(8); PG8_WAIT_L(0); PG8_BAR; PG8_MMA(0, 0, At, B0); PG8_MMA(0, 1, At, B1); PG8_BAR; PG8_SCHED;
            PG8_LDA(At, 1, 1); PG8_STAGE(PG8_SB(1, 0), b3, voffB); PG8_STAGE(PG8_SB(1, 1), b3 + hstepB, voffB); PG8_STAGE(PG8_SA(1, 0), a3, voffA);
            PG8_WAIT_V(8); PG8_WAIT_L(0); PG8_BAR; PG8_MMA(1, 0, At, B0); PG8_MMA(1, 1, At, B1); PG8_BAR; PG8_SCHED;
            } else {
            PG8_LDB(B0, 0, 0); PG8_SCHED; PG8_LDA(At, 0, 0); PG8_STAGE(PG8_SA(1, 1), a1 + hstepA, voffA);
            PG8_WAIT_L(8); PG8_BAR; PG8_WAIT_L(0); PG8_MMA(0, 0, At, B0); PG8_BAR; PG8_SCHED;
            PG8_LDB(B1, 0, 1); PG8_STAGE(PG8_SB(0, 0), b2, voffB);
            PG8_BAR; PG8_WAIT_L(0); PG8_MMA(0, 1, At, B1); PG8_BAR;
            PG8_LDA(At, 0, 1); PG8_STAGE(PG8_SA(0, 0), a2, voffA);
            PG8_BAR; PG8_WAIT_L(0); PG8_MMA(1, 0, At, B0); PG8_BAR; PG8_SCHED;
            PG8_STAGE(PG8_SB(0, 1), b2 + hstepB, voffB);
            PG8_WAIT_V(6); PG8_BAR; PG8_MMA(1, 1, At, B1); PG8_BAR;
            PG8_LDB(B0, 1, 0); PG8_SCHED; PG8_LDA(At, 1, 0); PG8_STAGE(PG8_SA(0, 1), a2 + hstepA, voffA);
            PG8_WAIT_L(8); PG8_BAR; PG8_WAIT_L(0); PG8_MMA(0, 0, At, B0); PG8_BAR; PG8_SCHED;
            PG8_LDB(B1, 1, 1); PG8_STAGE(PG8_SB(1, 0), b3, voffB);
            PG8_BAR; PG8_WAIT_L(0); PG8_MMA(0, 1, At, B1); PG8_BAR;
            PG8_LDA(At, 1, 1); PG8_STAGE(PG8_SA(1, 0), a3, voffA);
            PG8_BAR; PG8_WAIT_L(0); PG8_MMA(1, 0, At, B0); PG8_BAR; PG8_SCHED;
            PG8_STAGE(PG8_SB(1, 1), b3 + hstepB, voffB);
            PG8_WAIT_V(6); PG8_BAR; PG8_MMA(1, 1, At, B1); PG8_BAR;
            }
        }
        if constexpr (ALIGN_EPI) { if (wr == 0) PG8_BAR; }
        if constexpr (!Epi::AFTER_DRAIN) { unsigned on2_ = ~0u; asm volatile("" : "+s"(on2_)); const int l2_ = (int)__builtin_amdgcn_mbcnt_hi(on2_, __builtin_amdgcn_mbcnt_lo(on2_, 0u));
            E(acc, cur, wr, wc, l2_ & 15, l2_ >> 4); S.done(cur); }
        if (!has_next) break;
#pragma unroll
        for (int a = 0; a < 2; ++a)
#pragma unroll
            for (int b = 0; b < 2; ++b)
#pragma unroll
                for (int m = 0; m < 4; ++m)
#pragma unroll
                    for (int n = 0; n < 2; ++n) acc[a][b][m][n] = (f32x4){0.f, 0.f, 0.f, 0.f};
        cur = nxt; cA = nA; cB = nB; ++ui;
        if constexpr (ALIGN_EPI) { if (wr == 1) PG8_BAR; }
    }
    PG8_WAIT_V(0);
    if constexpr (!ALIGN_EPI) { if (wr == 0) PG8_BAR; }
    PG8_BAR;
    if constexpr (Epi::AFTER_DRAIN) { E.fused(acc, cur, wr, wc, fr, fq, lds, wid, lane); S.done(cur); }
#undef PG8_SA
#undef PG8_SB
#undef PG8_STAGE
#undef PG8_LDA
#undef PG8_LDB
#undef PG8_MMA
#undef PG8_WAIT_V
#undef PG8_WAIT_L
#undef PG8_BAR
#undef PG8_SCHED
}
}
namespace pg8 {
struct EpiWin {
    static constexpr bool PERM = true, AFTER_DRAIN = false; static constexpr int NST = 16;
    bf16_t* P; const float* ssqx; const float2* rope; float* ssqq; float* ssqkv; int ld, odd;
    __device__ __forceinline__ void operator()(const f32x4 (&acc)[2][2][4][2], const Unit& u, int wr, int wc, int fr, int fq) const {
        const int row0 = u.pm * BM + wr * 64 + fr, cw = u.pn * BM + wc * 32;
        float sx[2][4];
#pragma unroll
        for (int ai = 0; ai < 2; ++ai)
#pragma unroll
            for (int m = 0; m < 4; ++m) sx[ai][m] = ssqx[row0 + ai * HALF + m * 16];
#pragma unroll
        for (int ai = 0; ai < 2; ++ai)
#pragma unroll
            for (int m = 0; m < 4; ++m) {
                const int row = row0 + ai * HALF + m * 16; const float rs = rsqrtf(sx[ai][m] * (1.f / DM) + EPS);
                float sq = 0.f;
#pragma unroll
                for (int bj = 0; bj < 2; ++bj) {
                    const int cg = cw + bj * HALF, c = cg + 8 * fq;
                    f32x4 v0 = acc[ai][bj][m][0] * rs, v1 = acc[ai][bj][m][1] * rs;
                    if (!odd) {
                        if (cg < E_KSWA) sq += (v0[0] * v0[0] + v0[1] * v0[1]) + (v0[2] * v0[2] + v0[3] * v0[3]) + (v1[0] * v1[0] + v1[1] * v1[1]) + (v1[2] * v1[2] + v1[3] * v1[3]);
                        if (cg == E_KPE) { const float2* cs = rope + (size_t)(row & (S - 1)) * 16 + 4 * fq; const float2 c0 = cs[0], c1 = cs[1], c2 = cs[2], c3 = cs[3];
                            const f32x4 a = v0, b = v1;
                            v0[0] = a[0] * c0.x - a[1] * c0.y; v0[1] = a[1] * c0.x + a[0] * c0.y; v0[2] = a[2] * c1.x - a[3] * c1.y; v0[3] = a[3] * c1.x + a[2] * c1.y;
                            v1[0] = b[0] * c2.x - b[1] * c2.y; v1[1] = b[1] * c2.x + b[0] * c2.y; v1[2] = b[2] * c3.x - b[3] * c3.y; v1[3] = b[3] * c3.x + b[2] * c3.y; }
                        else if ((cg >= E_GMLA && cg < E_QSWA) || (cg >= E_GSWA && cg < E_QMEM) || cg >= E_GMEM) {
#pragma unroll
                            for (int i = 0; i < 4; ++i) { v0[i] = silu_f(v0[i]); v1[i] = silu_f(v1[i]); } }
                    } else {
                        if (cg == O_GL) { if (fq < 3) {
#pragma unroll
                            for (int i = 0; i < 4; ++i) { v0[i] = sigm_f(v0[i]); v1[i] = sigm_f(v1[i]); } } }
                        else if ((cg >= O_GNSA && cg < O_QMEM) || cg >= O_GMEM) {
#pragma unroll
                            for (int i = 0; i < 4; ++i) { v0[i] = silu_f(v0[i]); v1[i] = silu_f(v1[i]); } }
                    }
                    u32x4 w; w.x = pk2(v0[0], v0[1]); w.y = pk2(v0[2], v0[3]); w.z = pk2(v1[0], v1[1]); w.w = pk2(v1[2], v1[3]);
                    *(u32x4*)(P + (size_t)row * ld + c) = w;
                }
                if (!odd && u.pn < 2) {
                    sq += __shfl_xor(sq, 16); sq += __shfl_xor(sq, 32);
                    if (fq == 0) (u.pn == 0 ? ssqq : ssqkv)[(size_t)row * 4 + wc] = sq;
                }
            }
    }
};
struct EpiUp {
    static constexpr bool PERM = true, AFTER_DRAIN = false; static constexpr int NST = 0;
    bf16_t* O; const float* ssqq; const float* ssqkv; const float2* rope;
    __device__ __forceinline__ void operator()(const f32x4 (&acc)[2][2][4][2], const Unit& u, int wr, int wc, int fr, int fq) const {
        const int row0 = u.pm * BM + wr * 64 + fr, c0 = u.pn * BM + wc * 32 + 8 * fq; const bool isq = u.pn < 3;
#pragma unroll
        for (int ai = 0; ai < 2; ++ai)
#pragma unroll
            for (int m = 0; m < 4; ++m) {
                const int row = row0 + ai * HALF + m * 16;
                const f32x4 pq4 = *(const f32x4*)((isq ? ssqq : ssqkv) + (size_t)row * 4); const float ssum = (pq4[0] + pq4[1]) + (pq4[2] + pq4[3]);
                const float rs = rsqrtf(ssum * (isq ? (1.f / 256.f) : (1.f / 128.f)) + EPS);
#pragma unroll
                for (int bj = 0; bj < 2; ++bj) {
                    const int c = c0 + bj * HALF; f32x4 v0 = acc[ai][bj][m][0] * rs, v1 = acc[ai][bj][m][1] * rs;
                    if (isq) { const int j = c % 96;
                        if (j >= 64) { const float2* cs = rope + (size_t)(row & (S - 1)) * 16 + ((j - 64) >> 1); const float2 q0 = cs[0], q1 = cs[1], q2 = cs[2], q3 = cs[3];
                            const f32x4 a = v0, b = v1;
                            v0[0] = a[0] * q0.x - a[1] * q0.y; v0[1] = a[1] * q0.x + a[0] * q0.y; v0[2] = a[2] * q1.x - a[3] * q1.y; v0[3] = a[3] * q1.x + a[2] * q1.y;
                            v1[0] = b[0] * q2.x - b[1] * q2.y; v1[1] = b[1] * q2.x + b[0] * q2.y; v1[2] = b[2] * q3.x - b[3] * q3.y; v1[3] = b[3] * q3.x + b[2] * q3.y; } }
                    u32x4 w; w.x = pk2(v0[0], v0[1]); w.y = pk2(v0[2], v0[3]); w.z = pk2(v1[0], v1[1]); w.w = pk2(v1[2], v1[3]);
                    *(u32x4*)(O + (size_t)row * QKVW + c) = w;
                }
                asm volatile("" ::: "memory");
            }
    }
};
struct EpiStore {
    static constexpr bool PERM = true, AFTER_DRAIN = false; static constexpr int NST = 16;
    bf16_t* O; const float* rscale; float* ssq; int ld;
    __device__ __forceinline__ void operator()(const f32x4 (&acc)[2][2][4][2], const Unit& u, int wr, int wc, int fr, int fq) const {
        const int row0 = u.pm * BM + wr * 64 + fr, c0 = u.pn * BM + wc * 32 + 8 * fq;
        float sx[2][4];
#pragma unroll
        for (int ai = 0; ai < 2; ++ai)
#pragma unroll
            for (int m = 0; m < 4; ++m) sx[ai][m] = rscale ? rscale[row0 + ai * HALF + m * 16] : 1.f;
#pragma unroll
        for (int ai = 0; ai < 2; ++ai)
#pragma unroll
            for (int m = 0; m < 4; ++m) {
                const int row = row0 + ai * HALF + m * 16; const float rs = sx[ai][m]; float sq = 0.f;
#pragma unroll
                for (int bj = 0; bj < 2; ++bj) {
                    const f32x4 v0 = acc[ai][bj][m][0] * rs, v1 = acc[ai][bj][m][1] * rs;
                    sq += (v0[0] * v0[0] + v0[1] * v0[1]) + (v0[2] * v0[2] + v0[3] * v0[3]) + (v1[0] * v1[0] + v1[1] * v1[1]) + (v1[2] * v1[2] + v1[3] * v1[3]);
                    u32x4 w; w.x = pk2(v0[0], v0[1]); w.y = pk2(v0[2], v0[3]); w.z = pk2(v1[0], v1[1]); w.w = pk2(v1[2], v1[3]);
                    *(u32x4*)(O + (size_t)row * ld + c0 + bj * HALF) = w;
                }
                if (ssq) { sq += __shfl_xor(sq, 16); sq += __shfl_xor(sq, 32); if (fq == 0) ssq[(size_t)row * 16 + u.pn * 4 + wc] = sq; }
            }
    }
};
struct EpiPart {
    static constexpr bool PERM = true, AFTER_DRAIN = false; static constexpr int NST = 0;
    float* O;
    __device__ __forceinline__ void operator()(const f32x4 (&acc)[2][2][4][2], const Unit& u, int wr, int wc, int fr, int fq) const {
        const int kvq = u.pm >> 5, p32 = u.pm & 31; const int row0 = p32 * BM + wr * 64 + fr, c0 = wc * 32 + 8 * fq; float* base = O + (size_t)kvq * 8192 * 256;
#pragma unroll
        for (int ai = 0; ai < 2; ++ai)
#pragma unroll
            for (int m = 0; m < 4; ++m) { float* rp = base + (size_t)(row0 + ai * HALF + m * 16) * 256 + c0;
#pragma unroll
                for (int bj = 0; bj < 2; ++bj) { *(f32x4*)(rp + bj * HALF) = acc[ai][bj][m][0]; *(f32x4*)(rp + bj * HALF + 4) = acc[ai][bj][m][1]; } }
    }
};
struct EpiC1 {
    static constexpr bool PERM = true, AFTER_DRAIN = false; static constexpr int NST = 0;
    bf16_t* O; const float* pb;
    __device__ __forceinline__ void operator()(const f32x4 (&acc)[2][2][4][2], const Unit& u, int wr, int wc, int fr, int fq) const {
        const int row0 = u.pm * BM + wr * 64 + fr, c0 = wc * 32 + 8 * fq;
#pragma unroll
        for (int ai = 0; ai < 2; ++ai)
#pragma unroll
            for (int m = 0; m < 4; ++m) {
                const int row = row0 + ai * HALF + m * 16;
#pragma unroll
                for (int bj = 0; bj < 2; ++bj) { const int c = c0 + bj * HALF; const f32x4 b0 = *(const f32x4*)(pb + c), b1 = *(const f32x4*)(pb + c + 4);
                    f32x4 v0 = acc[ai][bj][m][0] + b0, v1 = acc[ai][bj][m][1] + b1;
#pragma unroll
                    for (int i = 0; i < 4; ++i) { v0[i] = silu_f(v0[i]); v1[i] = silu_f(v1[i]); }
                    u32x4 w; w.x = pk2(v0[0], v0[1]); w.y = pk2(v0[2], v0[3]); w.z = pk2(v1[0], v1[1]); w.w = pk2(v1[2], v1[3]);
                    *(u32x4*)(O + (size_t)row * 256 + c) = w; }
            }
    }
};
}
#ifndef ATT_PROBE
#define ATT_PROBE 0
#endif
namespace att {
constexpr float SM_THR = 8.f;
constexpr int KSLOT = 17408, VSLOT = 20480, KS0 = 0, VS0 = 3 * KSLOT, KPOS = VS0 + 2 * VSLOT  , IMP = 94208, SELW = IMP + 33024  , SELU = SELW + 1024, LUTO = 128512, ATT_LDS_END = LUTO + 4224;
__device__ __forceinline__ int kslot(int i) { return KS0 + i * KSLOT; }
__device__ __forceinline__ int vslot(int i) { return VS0 + i * VSLOT; }
template <int DQK> struct KPitch { static constexpr int v = DQK * 2 + 16; };
template <int DV> struct VPitch { static constexpr int v = (DV == 64) ? 192 : 320; };
__device__ __forceinline__ s16x4 vtr(const LAS char* p) { typedef short v4s __attribute__((ext_vector_type(4))); return __builtin_bit_cast(s16x4, __builtin_amdgcn_ds_read_tr16_b64_v4i16((LAS v4s*)p)); }
__device__ __forceinline__ float swapmax(float v) { auto rr = __builtin_amdgcn_permlane32_swap(__float_as_uint(v), __float_as_uint(v), false, false); return fmaxf(__uint_as_float(rr[0]), __uint_as_float(rr[1])); }
__device__ __forceinline__ float swapsum(float v) { auto rr = __builtin_amdgcn_permlane32_swap(__float_as_uint(v), __float_as_uint(v), false, false); return __uint_as_float(rr[0]) + __uint_as_float(rr[1]); }

struct Src { const bf16_t* K1; const bf16_t* K2; const bf16_t* V; int kld, kld2, vld; const int* kpos; };
template <int DQK, int DV> struct Stage { u32x4 k[(64 * DQK / 8 + 511) / 512]; u32x4 v[(64 * DV / 8 + 511) / 512]; int kp; };

template <int DQK> __device__ __forceinline__ void kchunk(int tid, int i, int& row, int& ch) {
    if (DQK == 96) { if (i == 0) { row = tid >> 3; ch = tid & 7; } else { row = tid >> 2; ch = 8 + (tid & 3); } }
    else { constexpr int CPRK = DQK / 8; const int c = tid + i * 512; row = c / CPRK; ch = c % CPRK; }
}
template <int DQK, int DV, bool POS>
__device__ __forceinline__ void load_k(Stage<DQK, DV>& st, const Src& s, int kt0, int tid) {
    constexpr int CPRK = DQK / 8, NKC = 64 * CPRK;
    const char* b1 = (const char*)(s.K1 + (size_t)kt0 * s.kld); const char* b2 = (DQK == 96) ? (const char*)(s.K2 + (size_t)kt0 * s.kld2) : b1;
#pragma unroll
    for (int i = 0; i < (NKC + 511) / 512; ++i) { int row, ch; kchunk<DQK>(tid, i, row, ch);
        if (DQK == 96 && i == 1) { if (tid < 256) st.k[i] = *(const u32x4*)(b2 + (unsigned)((row * s.kld2 + (ch - 8) * 8) * 2)); }
        else if (NKC % 512 == 0 || DQK == 96 || tid + i * 512 < NKC) st.k[i] = *(const u32x4*)(b1 + (unsigned)((row * s.kld + ch * 8) * 2)); }
    if (POS) st.kp = (tid < 64) ? *(const int*)((const char*)(s.kpos + kt0) + (unsigned)(tid * 4)) : 0;
}
template <int DQK, int DV>
__device__ __forceinline__ void load_v(Stage<DQK, DV>& st, const Src& s, int kt0, int tid) {
    constexpr int CPRV = DV / 8, NVC = 64 * CPRV;
    const char* bv = (const char*)(s.V + (size_t)kt0 * s.vld);
#pragma unroll
    for (int i = 0; i < NVC / 512; ++i) { const int c = tid + i * 512; const int row = c / CPRV, ch = c % CPRV; st.v[i] = *(const u32x4*)(bv + (unsigned)((row * s.vld + ch * 8) * 2)); }
}
template <int DQK, int DV, bool POS>
__device__ __forceinline__ void store_k(const Stage<DQK, DV>& st, LAS char* lds, int ks, int tid) {
    constexpr int CPRK = DQK / 8, NKC = 64 * CPRK, KP = KPitch<DQK>::v;
    LAS char* kb = lds + kslot(ks);
#pragma unroll
    for (int i = 0; i < (NKC + 511) / 512; ++i) { int row, ch; kchunk<DQK>(tid, i, row, ch);
        if (DQK == 96 && i == 1) { if (tid < 256) *(LAS u32x4*)(kb + row * KP + ch * 16) = st.k[i]; }
        else if (NKC % 512 == 0 || DQK == 96 || tid + i * 512 < NKC) *(LAS u32x4*)(kb + row * KP + ch * 16) = st.k[i]; }
    if (POS) { if (tid < 64) ((LAS int*)(lds + KPOS))[ks * 64 + tid] = st.kp; }
}
template <int DQK, int DV>
__device__ __forceinline__ void store_v(const Stage<DQK, DV>& st, LAS char* lds, int vs, int tid) {
    constexpr int CPRV = DV / 8, NVC = 64 * CPRV, VP = VPitch<DV>::v;
    LAS char* vb = lds + vslot(vs);
#pragma unroll
    for (int i = 0; i < NVC / 512; ++i) { const int c = tid + i * 512; const int row = c / CPRV, ch = c % CPRV; *(LAS u32x4*)(vb + row * VP + ch * 16) = st.v[i]; }
}
template <int DQK, int DV, bool POS>
__device__ __forceinline__ void tile_load(Stage<DQK, DV>& st, const Src& s, int kt0, int tid) { load_k<DQK, DV, POS>(st, s, kt0, tid); load_v<DQK, DV>(st, s, kt0, tid); }
template <int DQK, int DV, bool POS>
__device__ __forceinline__ void tile_store(const Stage<DQK, DV>& st, LAS char* lds, int buf, int tid) { store_k<DQK, DV, POS>(st, lds, buf, tid); store_v<DQK, DV>(st, lds, buf, tid); }

struct Col { int qi; int qlim; int pq; int hcol; };
struct Flags { bool causal, window, bias, selm; };

template <int DQK, int DV, bool DO_PV, bool BIAS, bool WINDOWED>
__device__ __forceinline__ void tile_compute(const LAS char* lds, int buf, int kt0, int mode, bool incl, const Col& col, int W, const bf16x8 (&qf)[DQK / 16], f32x16 (&o)[DV / 32], float& m, float& l,
                                             f32x16& p0, f32x16& p1, int lane) {
    constexpr int KP = KPitch<DQK>::v, VP = VPitch<DV>::v;
    int hi = lane >> 5; asm volatile("" : "+v"(hi));
    const int r32 = lane & 31;
    const LAS char* kb = lds + kslot(buf) + r32 * KP + hi * 16;
    p0 = (f32x16){0}; p1 = (f32x16){0};
#pragma unroll
    for (int st = 0; st < DQK / 16; ++st) {
        const bf16x8 k0 = *(const LAS bf16x8*)(kb + st * 32), k1 = *(const LAS bf16x8*)(kb + 32 * KP + st * 32);
        p0 = __builtin_amdgcn_mfma_f32_32x32x16_bf16(k0, qf[st], p0, 0, 0, 0);
        p1 = __builtin_amdgcn_mfma_f32_32x32x16_bf16(k1, qf[st], p1, 0, 0, 0);
        if ((st & 1) == 1) asm volatile("" ::: "memory");
    }
    float cb = 0.f;
    if (BIAS) {
        const LAS float* lut = (const LAS float*)(lds + LUTO) + col.hcol * 132;
        if (mode == 2) {
            const LAS int* kp = (const LAS int*)(lds + KPOS) + buf * 64 + 4 * hi;
#pragma unroll
            for (int r = 0; r < 16; ++r) { const int ko = (r & 3) + 8 * (r >> 2);
                int d0 = col.pq - kp[ko], d1 = col.pq - kp[ko + 32]; d0 = d0 < 0 ? 0 : (d0 > 128 ? 128 : d0); d1 = d1 < 0 ? 0 : (d1 > 128 ? 128 : d1);
                p0[r] += lut[d0]; p1[r] += lut[d1]; if ((r & 3) == 3) asm volatile("" ::: "memory"); }
        } else cb = lut[128];
    }
    if (mode == 2) {
        const int up = col.qlim - kt0 - 4 * hi; const int lo = WINDOWED ? (col.qi - W - kt0 - 4 * hi) : -1;
#pragma unroll
        for (int r = 0; r < 16; ++r) { const int ko = (r & 3) + 8 * (r >> 2);
            bool v0 = ko <= up, v1 = (ko + 32) <= up;
            if (WINDOWED) { v0 = v0 && (ko > lo); v1 = v1 && ((ko + 32) > lo); }
            p0[r] = v0 ? p0[r] : NEG; p1[r] = v1 ? p1[r] : NEG; }
    }
    float a = fmaxf(fmaxf(p0[0], p0[1]), p1[0]), b = fmaxf(fmaxf(p0[2], p0[3]), p1[1]); a = fmaxf(fmaxf(a, p1[2]), p1[3]);
#pragma unroll
    for (int r = 4; r < 16; r += 4) { a = fmaxf(fmaxf(a, p0[r]), p0[r + 1]); b = fmaxf(fmaxf(b, p0[r + 2]), p0[r + 3]); a = fmaxf(fmaxf(a, p1[r]), p1[r + 1]); b = fmaxf(fmaxf(b, p1[r + 2]), p1[r + 3]); }
    float tmax = swapmax(fmaxf(a, b)) + cb;
    if (!incl) tmax = NEG;
    if (__builtin_amdgcn_ballot_w64(tmax - m > SM_THR) != 0ull) { const float mnew = fmaxf(m, tmax); const float f = __builtin_amdgcn_exp2f(m - mnew); l *= f; m = mnew;
        if (DO_PV) {
#pragma unroll
            for (int bk = 0; bk < DV / 32; ++bk)
#pragma unroll
                for (int r = 0; r < 16; ++r) o[bk][r] *= f; } }
    const float off = (incl && m > -1e29f) ? (cb - m) : NEG;
    float sum = 0.f;
#pragma unroll
    for (int r = 0; r < 16; ++r) { p0[r] = __builtin_amdgcn_exp2f(p0[r] + off); p1[r] = __builtin_amdgcn_exp2f(p1[r] + off); sum += p0[r] + p1[r]; }
    l += sum;
    if (DO_PV) {
        const LAS char* vb = lds + vslot(buf) + (4 * hi + ((lane & 15) >> 2)) * VP + (((lane >> 4) & 1) * 16 + (lane & 3) * 4) * 2;
#pragma unroll
        for (int sub = 0; sub < 2; ++sub)
#pragma unroll
            for (int ks = 0; ks < 2; ++ks) {
                u32x4 pw;
                if (sub == 0) { pw.x = pk2(p0[8 * ks], p0[8 * ks + 1]); pw.y = pk2(p0[8 * ks + 2], p0[8 * ks + 3]); pw.z = pk2(p0[8 * ks + 4], p0[8 * ks + 5]); pw.w = pk2(p0[8 * ks + 6], p0[8 * ks + 7]); }
                else          { pw.x = pk2(p1[8 * ks], p1[8 * ks + 1]); pw.y = pk2(p1[8 * ks + 2], p1[8 * ks + 3]); pw.z = pk2(p1[8 * ks + 4], p1[8 * ks + 5]); pw.w = pk2(p1[8 * ks + 6], p1[8 * ks + 7]); }
                const bf16x8 pb = __builtin_bit_cast(bf16x8, pw);
#pragma unroll
                for (int bk = 0; bk < DV / 32; ++bk) {
                    const LAS char* vp = vb + (32 * sub + 16 * ks) * VP + bk * 64;
                    const s16x4 lo = vtr(vp), hi4 = vtr(vp + 8 * VP);
                    const bf16x8 va = __builtin_shufflevector(lo, hi4, 0, 1, 2, 3, 4, 5, 6, 7);
                    o[bk] = __builtin_amdgcn_mfma_f32_32x32x16_bf16(va, pb, o[bk], 0, 0, 0);
                }
                asm volatile("" ::: "memory");
            }
    }
}

template <int DQK> __device__ __forceinline__ void qk_part(const LAS char* lds, int ks, const bf16x8 (&qf)[DQK / 16], f32x16& s0, f32x16& s1, int lane) {
    constexpr int KP = KPitch<DQK>::v; const LAS char* kb = lds + kslot(ks) + (lane & 31) * KP + (lane >> 5) * 16;
    s0 = (f32x16){0}; s1 = (f32x16){0};
#pragma unroll
    for (int st = 0; st < DQK / 16; ++st) {
        const bf16x8 k0 = *(const LAS bf16x8*)(kb + st * 32), k1 = *(const LAS bf16x8*)(kb + 32 * KP + st * 32);
        s0 = __builtin_amdgcn_mfma_f32_32x32x16_bf16(k0, qf[st], s0, 0, 0, 0);
        s1 = __builtin_amdgcn_mfma_f32_32x32x16_bf16(k1, qf[st], s1, 0, 0, 0);
    }
}
template <int DQK> __device__ __forceinline__ void load_kf(const LAS char* lds, int ks, bf16x8 (&kf)[DQK / 16][2], int lane) {
    constexpr int KP = KPitch<DQK>::v; const LAS char* kb = lds + kslot(ks) + (lane & 31) * KP + (lane >> 5) * 16;
#pragma unroll
    for (int st = 0; st < DQK / 16; ++st) { kf[st][0] = *(const LAS bf16x8*)(kb + st * 32); kf[st][1] = *(const LAS bf16x8*)(kb + 32 * KP + st * 32); }
}
template <int DQK> __device__ __forceinline__ void qk_pipe(const LAS char* lds, int ks, const bf16x8 (&qf)[DQK / 16], f32x16& n0, f32x16& n1, int lane) {
    constexpr int KP = KPitch<DQK>::v, NG = DQK / 8; const LAS char* kb = lds + kslot(ks) + (lane & 31) * KP + (lane >> 5) * 16;
    n0 = (f32x16){0}; n1 = (f32x16){0};
    bf16x8 f0 = *(const LAS bf16x8*)(kb), f1 = *(const LAS bf16x8*)(kb + 32 * KP), f2 = *(const LAS bf16x8*)(kb + 32);
#pragma unroll
    for (int g = 0; g < NG; ++g) {
        bf16x8 f3 = f2;
        if (g + 3 < NG) f3 = *(const LAS bf16x8*)(kb + ((g + 3) & 1) * 32 * KP + ((g + 3) >> 1) * 32);
        if (g & 1) n1 = __builtin_amdgcn_mfma_f32_32x32x16_bf16(f0, qf[g >> 1], n1, 0, 0, 0); else n0 = __builtin_amdgcn_mfma_f32_32x32x16_bf16(f0, qf[g >> 1], n0, 0, 0, 0);
        __builtin_amdgcn_sched_barrier(0);
        f0 = f1; f1 = f2; f2 = f3;
    }
}
template <int DV, bool BIAS, bool WINDOWED, bool DO_PV>
__device__ __forceinline__ float max_part(const LAS char* lds, int ks, int kt0, int mode, bool incl, const Col& col, int W, f32x16 (&o)[DV / 32], float& m, float& l, f32x16& p0, f32x16& p1, int lane) {
    int hi = lane >> 5; asm volatile("" : "+v"(hi));
    float cb = 0.f;
    if (BIAS) {
        const LAS float* lut = (const LAS float*)(lds + LUTO) + col.hcol * 132;
        if (mode == 2) {
            const LAS int* kp = (const LAS int*)(lds + KPOS) + ks * 64 + 4 * hi;
#pragma unroll
            for (int r = 0; r < 16; ++r) { const int ko = (r & 3) + 8 * (r >> 2);
                int d0 = col.pq - kp[ko], d1 = col.pq - kp[ko + 32]; d0 = d0 < 0 ? 0 : (d0 > 128 ? 128 : d0); d1 = d1 < 0 ? 0 : (d1 > 128 ? 128 : d1);
                p0[r] += lut[d0]; p1[r] += lut[d1]; if ((r & 3) == 3) asm volatile("" ::: "memory"); }
        } else cb = lut[128];
    }
    if (mode == 2) {
        const int up = col.qlim - kt0 - 4 * hi; const int lo = WINDOWED ? (col.qi - W - kt0 - 4 * hi) : -1;
#pragma unroll
        for (int r = 0; r < 16; ++r) { const int ko = (r & 3) + 8 * (r >> 2);
            bool v0 = ko <= up, v1 = (ko + 32) <= up;
            if (WINDOWED) { v0 = v0 && (ko > lo); v1 = v1 && ((ko + 32) > lo); }
            p0[r] = v0 ? p0[r] : NEG; p1[r] = v1 ? p1[r] : NEG; }
    }
    float a = fmaxf(fmaxf(p0[0], p0[1]), p1[0]), b = fmaxf(fmaxf(p0[2], p0[3]), p1[1]); a = fmaxf(fmaxf(a, p1[2]), p1[3]);
#pragma unroll
    for (int r = 4; r < 16; r += 4) { a = fmaxf(fmaxf(a, p0[r]), p0[r + 1]); b = fmaxf(fmaxf(b, p0[r + 2]), p0[r + 3]); a = fmaxf(fmaxf(a, p1[r]), p1[r + 1]); b = fmaxf(fmaxf(b, p1[r + 2]), p1[r + 3]); }
    float tmax = swapmax(fmaxf(a, b)) + cb;
    if (!incl) tmax = NEG;
    if (__builtin_amdgcn_ballot_w64(tmax - m > SM_THR) != 0ull) { const float mnew = fmaxf(m, tmax); const float f = __builtin_amdgcn_exp2f(m - mnew); l *= f; m = mnew;
        if (DO_PV) {
#pragma unroll
            for (int bk = 0; bk < DV / 32; ++bk)
#pragma unroll
                for (int r = 0; r < 16; ++r) o[bk][r] *= f; } }
    return (incl && m > -1e29f) ? (cb - m) : NEG;
}
template <int DQK, bool WITHQK>
__device__ __forceinline__ void exp_part(const bf16x8 (&kf)[DQK / 16][2], const bf16x8 (&qf)[DQK / 16], float off, float& l, f32x16& p0, f32x16& p1, f32x16& n0, f32x16& n1, int lane) {
    if (WITHQK) { n0 = (f32x16){0}; n1 = (f32x16){0};
#pragma unroll
        for (int st = 0; st < DQK / 16; ++st) { n0 = __builtin_amdgcn_mfma_f32_32x32x16_bf16(kf[st][0], qf[st], n0, 0, 0, 0); n1 = __builtin_amdgcn_mfma_f32_32x32x16_bf16(kf[st][1], qf[st], n1, 0, 0, 0); }
#if ATT_PROBE == 1
        { f32x16 x0 = (f32x16){0}, x1 = (f32x16){0};
#pragma unroll
          for (int st = 0; st < DQK / 16; ++st) { x0 = __builtin_amdgcn_mfma_f32_32x32x16_bf16(kf[st][0], qf[st], x0, 0, 0, 0); x1 = __builtin_amdgcn_mfma_f32_32x32x16_bf16(kf[st][1], qf[st], x1, 0, 0, 0); }
          asm volatile("" :: "v"(x0), "v"(x1)); }
#endif
    }
#if ATT_PROBE == 7
    { float j0 = p0[0], j1 = p0[1], j2 = p0[2], j3 = p0[3], j4 = p0[4], j5 = p0[5], j6 = p0[6], j7 = p0[7];
#pragma unroll
      for (int i = 0; i < 8; ++i) { j0 = j0 * 1.0001f + 0.5f; j1 = j1 * 1.0001f + 0.5f; j2 = j2 * 1.0001f + 0.5f; j3 = j3 * 1.0001f + 0.5f; j4 = j4 * 1.0001f + 0.5f; j5 = j5 * 1.0001f + 0.5f; j6 = j6 * 1.0001f + 0.5f; j7 = j7 * 1.0001f + 0.5f; }
      asm volatile("" :: "v"(j0), "v"(j1), "v"(j2), "v"(j3), "v"(j4), "v"(j5), "v"(j6), "v"(j7)); }
#endif
#if ATT_PROBE == 8
    { float e0 = __builtin_amdgcn_exp2f(p0[0] + 1.f), e1 = __builtin_amdgcn_exp2f(p0[1] + 1.f), e2 = __builtin_amdgcn_exp2f(p0[2] + 1.f), e3 = __builtin_amdgcn_exp2f(p0[3] + 1.f);
      float e4 = __builtin_amdgcn_exp2f(p0[4] + 1.f), e5 = __builtin_amdgcn_exp2f(p0[5] + 1.f), e6 = __builtin_amdgcn_exp2f(p0[6] + 1.f), e7 = __builtin_amdgcn_exp2f(p0[7] + 1.f);
      float f0 = __builtin_amdgcn_exp2f(p1[0] + 1.f), f1 = __builtin_amdgcn_exp2f(p1[1] + 1.f), f2 = __builtin_amdgcn_exp2f(p1[2] + 1.f), f3 = __builtin_amdgcn_exp2f(p1[3] + 1.f);
      float f4 = __builtin_amdgcn_exp2f(p1[4] + 1.f), f5 = __builtin_amdgcn_exp2f(p1[5] + 1.f), f6 = __builtin_amdgcn_exp2f(p1[6] + 1.f), f7 = __builtin_amdgcn_exp2f(p1[7] + 1.f);
      asm volatile("" :: "v"(e0), "v"(e1), "v"(e2), "v"(e3), "v"(e4), "v"(e5), "v"(e6), "v"(e7), "v"(f0), "v"(f1), "v"(f2), "v"(f3), "v"(f4), "v"(f5), "v"(f6), "v"(f7)); }
#endif
    float sum = 0.f;
#if ATT_PROBE == 2
    { float junk = 0.f;
#pragma unroll
      for (int r = 0; r < 16; ++r) { junk += __builtin_amdgcn_exp2f(p0[r] + off + 1.f) + __builtin_amdgcn_exp2f(p1[r] + off + 1.f); }
      asm volatile("" :: "v"(junk)); }
#endif
#pragma unroll
    for (int r = 0; r < 16; ++r) { p0[r] = __builtin_amdgcn_exp2f(p0[r] + off); p1[r] = __builtin_amdgcn_exp2f(p1[r] + off); sum += p0[r] + p1[r]; }
    l += sum;
}
template <int DQK> __device__ __forceinline__ void exp_part_qk(const bf16x8 (&kf)[DQK / 16][2], const bf16x8 (&qf)[DQK / 16], f32x16& n0, f32x16& n1) {
    n0 = (f32x16){0}; n1 = (f32x16){0};
#pragma unroll
    for (int st = 0; st < DQK / 16; ++st) { n0 = __builtin_amdgcn_mfma_f32_32x32x16_bf16(kf[st][0], qf[st], n0, 0, 0, 0); n1 = __builtin_amdgcn_mfma_f32_32x32x16_bf16(kf[st][1], qf[st], n1, 0, 0, 0); }
}
template <int DV> __device__ __forceinline__ void pv_part(const LAS char* lds, int vs, const f32x16& p0, const f32x16& p1, f32x16 (&o)[DV / 32], int lane) {
    constexpr int VP = VPitch<DV>::v; const int hi = lane >> 5;
    const LAS char* vb = lds + vslot(vs) + (4 * hi + ((lane & 15) >> 2)) * VP + (((lane >> 4) & 1) * 16 + (lane & 3) * 4) * 2;
#pragma unroll
    for (int sub = 0; sub < 2; ++sub)
#pragma unroll
        for (int ks = 0; ks < 2; ++ks) {
            u32x4 pw;
            if (sub == 0) { pw.x = pk2(p0[8 * ks], p0[8 * ks + 1]); pw.y = pk2(p0[8 * ks + 2], p0[8 * ks + 3]); pw.z = pk2(p0[8 * ks + 4], p0[8 * ks + 5]); pw.w = pk2(p0[8 * ks + 6], p0[8 * ks + 7]); }
            else          { pw.x = pk2(p1[8 * ks], p1[8 * ks + 1]); pw.y = pk2(p1[8 * ks + 2], p1[8 * ks + 3]); pw.z = pk2(p1[8 * ks + 4], p1[8 * ks + 5]); pw.w = pk2(p1[8 * ks + 6], p1[8 * ks + 7]); }
            const bf16x8 pb = __builtin_bit_cast(bf16x8, pw);
#pragma unroll
            for (int bk = 0; bk < DV / 32; ++bk) {
                const LAS char* vp = vb + (32 * sub + 16 * ks) * VP + bk * 64;
                const s16x4 lo = vtr(vp), hi4 = vtr(vp + 8 * VP);
                const bf16x8 va = __builtin_shufflevector(lo, hi4, 0, 1, 2, 3, 4, 5, 6, 7);
                o[bk] = __builtin_amdgcn_mfma_f32_32x32x16_bf16(va, pb, o[bk], 0, 0, 0);
            }
        }
}
}
namespace att {
struct Wv { int l0, l1, q0, q1; };
__device__ __forceinline__ float headsum4(float w) {
    const float t = w + __builtin_bit_cast(float, __builtin_amdgcn_update_dpp(0, __builtin_bit_cast(int, w), 0x128  , 0xf, 0xf, false));
    auto rr = __builtin_amdgcn_permlane16_swap(__float_as_uint(t), __float_as_uint(t), false, false);
    return __uint_as_float(rr[0]) + __uint_as_float(rr[1]);
}
template <int CTRL> __device__ __forceinline__ float dppf(float v) { return __builtin_bit_cast(float, __builtin_amdgcn_update_dpp(0, __builtin_bit_cast(int, v), CTRL, 0xf, 0xf, false)); }
template <int CTRL> __device__ __forceinline__ int dppi(int v) { return __builtin_amdgcn_update_dpp(0, v, CTRL, 0xf, 0xf, false); }
__device__ __forceinline__ void imp_add(LAS char* lds, const f32x16& p0, const f32x16& p1, int kt0, float il, int ql, int lane) {
    LAS float* imp = (LAS float*)(lds + IMP); const int r32 = lane & 31, hi = lane >> 5;
#pragma unroll
    for (int sub = 0; sub < 2; ++sub)
#pragma unroll
        for (int g4 = 0; g4 < 4; ++g4) {
            const float a0 = sub ? p1[4 * g4] : p0[4 * g4], a1 = sub ? p1[4 * g4 + 1] : p0[4 * g4 + 1], a2 = sub ? p1[4 * g4 + 2] : p0[4 * g4 + 2], a3 = sub ? p1[4 * g4 + 3] : p0[4 * g4 + 3];
            float w = (a0 + a1 + a2 + 0.5f * a3) * il, w2 = 0.5f * a3 * il;
            w = headsum4(w); w2 = headsum4(w2);
            const int j = (kt0 + 32 * sub + 8 * g4 + 4 * hi) >> 2;
            if ((r32 >> 3) == 0) { atomicAdd((float*)(imp + ql * 129 + j), w); if (j + 1 < 128) atomicAdd((float*)(imp + ql * 129 + j + 1), w2); }
        }
}
template <int DQK, int DV, bool DO_PV, bool BIAS, bool WINDOWED, bool CAUSAL, bool SELM, bool IMPT = false>
__device__ __forceinline__ void run_branch(LAS char* lds, const Src& src, int t_lo, int t_hi, const Wv& wv, const Col& col, int W, int pmq, const int2* pmm,
                                           const unsigned long long sello, const unsigned long long selhi, const bf16x8 (&qf)[DQK / 16], f32x16 (&o)[DV / 32], float& m, float& l, f32x16& pA0, f32x16& pA1, int tid_in, int lane_in, float imp_il = 0.f, int imp_ql = 0) {
    int lane = lane_in; asm volatile("" : "+v"(lane));
    const int tid = (tid_in & ~63) | lane;
    unsigned long long ulo = 0ull, uhi = 0ull;
    if (SELM) { const LAS unsigned* selu = (const LAS unsigned*)(lds + SELU);
        ulo = (unsigned long long)(unsigned)__builtin_amdgcn_readfirstlane((int)selu[0]) | ((unsigned long long)(unsigned)__builtin_amdgcn_readfirstlane((int)selu[1]) << 32);
        uhi = (unsigned long long)(unsigned)__builtin_amdgcn_readfirstlane((int)selu[2]) | ((unsigned long long)(unsigned)__builtin_amdgcn_readfirstlane((int)selu[3]) << 32); }
    auto want = [&](int t) -> bool { return !SELM || ((((t < 64) ? ulo : uhi) >> (t & 63)) & 1ull); };
    auto nxt = [&](int t) -> int { ++t; while (t <= t_hi && !want(t)) ++t; return t; };
    auto classify = [&](int t) -> int { const int kt0 = t * 64; bool skip = false, allv = true;
        if (CAUSAL) { skip = kt0 > wv.l1; allv = (kt0 + 63 <= wv.l0); }
        if (WINDOWED) { skip = skip || (wv.q0 - (kt0 + 63) >= W); allv = allv && (wv.q1 - kt0 < W); }
        bool farb = true; if (BIAS) { farb = (pmq - pmm[t].y >= 128); }
        return (!skip && allv && farb) ? 1 : 2; };
    auto inc = [&](int t) -> bool { if (!SELM) return true; const unsigned long long w = (t < 64) ? sello : selhi; return (w >> (t & 63)) & 1ull; };
    int tc = t_lo - 1; tc = nxt(tc);
    if (tc > t_hi) return;
    int tn = nxt(tc), tnn = (tn <= t_hi) ? nxt(tn) : tn;
    Stage<DQK, DV> st;
    {   Stage<DQK, DV> s2;
        tile_load<DQK, DV, BIAS>(st, src, tc * 64, tid); if (tn <= t_hi) load_k<DQK, DV, BIAS>(s2, src, tn * 64, tid);
        tile_store<DQK, DV, BIAS>(st, lds, 0, tid); if (tn <= t_hi) store_k<DQK, DV, BIAS>(s2, lds, 1, tid); }
    __syncthreads();
    int ik = 0, iv = 0;
    f32x16 pB0, pB1;
    qk_part<DQK>(lds, 0, qf, pA0, pA1, lane);
#define ATT_STEP(c0, c1, n0, n1) { \
        const bool hasNN = tnn <= t_hi; \
        if (ATT_PROBE == 3) { Stage<DQK, DV> sj; if (hasNN) load_k<DQK, DV, BIAS>(sj, src, tnn * 64, tid); load_v<DQK, DV>(sj, src, tn * 64, tid); asm volatile("" :: "v"(sj.k[0]), "v"(sj.v[0])); } \
        if (hasNN) load_k<DQK, DV, BIAS>(st, src, tnn * 64, tid); \
        load_v<DQK, DV>(st, src, tn * 64, tid); \
        const int ikn = (ik == 2) ? 0 : ik + 1, iknn = (ikn == 2) ? 0 : ikn + 1; \
        if (!SELM || __builtin_amdgcn_ballot_w64(inc(tn)) != 0ull) qk_pipe<DQK>(lds, ikn, qf, n0, n1, lane);     \
        const bool incl_ = inc(tc); \
        if (!SELM || __builtin_amdgcn_ballot_w64(incl_) != 0ull) {     \
            const float off = max_part<DV, BIAS, WINDOWED, DO_PV>(lds, ik, tc * 64, classify(tc), incl_, col, W, o, m, l, c0, c1, lane); \
            bf16x8 kfd_[DQK / 16][2]; exp_part<DQK, false>(kfd_, qf, off, l, c0, c1, n0, n1, lane); \
            if (IMPT) imp_add(lds, c0, c1, tc * 64, imp_il, imp_ql, lane); \
            if (DO_PV) pv_part<DV>(lds, iv, c0, c1, o, lane); } \
        if (hasNN) store_k<DQK, DV, BIAS>(st, lds, iknn, tid); \
        store_v<DQK, DV>(st, lds, iv ^ 1, tid); \
        __syncthreads(); if (ATT_PROBE == 4) { __syncthreads(); __syncthreads(); } \
        tc = tn; tn = tnn; tnn = hasNN ? nxt(tnn) : tnn; ik = ikn; iv ^= 1; }
    bool inA = true;
    while (tn <= t_hi) {
        ATT_STEP(pA0, pA1, pB0, pB1)
        if (!(tn <= t_hi)) { inA = false; break; }
        ATT_STEP(pB0, pB1, pA0, pA1)
    }
#undef ATT_STEP
    if (!inA) { pA0 = pB0; pA1 = pB1; }
    {   const bool inclf = inc(tc);
        if (!SELM || __builtin_amdgcn_ballot_w64(inclf) != 0ull) {
            const float off = max_part<DV, BIAS, WINDOWED, DO_PV>(lds, ik, tc * 64, classify(tc), inclf, col, W, o, m, l, pA0, pA1, lane);
            bf16x8 kfd[DQK / 16][2]; exp_part<DQK, false>(kfd, qf, off, l, pA0, pA1, pB0, pB1, lane);
            if (IMPT) imp_add(lds, pA0, pA1, tc * 64, imp_il, imp_ql, lane);
            if (DO_PV) pv_part<DV>(lds, iv, pA0, pA1, o, lane); } }
    __syncthreads();
}
template <int DQK, int DV, bool DO_PV, bool BIAS, bool WINDOWED, bool CAUSAL, bool SELM>
__device__ __forceinline__ void run_branch_np(LAS char* lds, const Src& src, int t_lo, int t_hi, const Wv& wv, const Col& col, int W, int pmq, const int2* pmm,
                                           const unsigned long long sello, const unsigned long long selhi, const bf16x8 (&qf)[DQK / 16], f32x16 (&o)[DV / 32], float& m, float& l, f32x16& p0, f32x16& p1, int tid, int lane) {
    const LAS unsigned* selu = (const LAS unsigned*)(lds + SELU);
    auto want = [&](int t) -> bool { return !SELM || ((selu[t >> 5] >> (t & 31)) & 1u); };
    int t = t_lo; while (t <= t_hi && !want(t)) ++t;
    if (t > t_hi) return;
    Stage<DQK, DV> st;
    tile_load<DQK, DV, BIAS>(st, src, t * 64, tid); tile_store<DQK, DV, BIAS>(st, lds, 0, tid); __syncthreads();
    int buf = 0;
    for (;;) {
        int tn = t + 1; while (tn <= t_hi && !want(tn)) ++tn;
        const bool has = tn <= t_hi;
        if (has) tile_load<DQK, DV, BIAS>(st, src, tn * 64, tid);
        const int kt0 = t * 64;
        int mode;
        {   bool skip = false, allv = true;
            if (CAUSAL) { skip = kt0 > wv.l1; allv = (kt0 + 63 <= wv.l0); }
            if (WINDOWED) { skip = skip || (wv.q0 - (kt0 + 63) >= W); allv = allv && (wv.q1 - kt0 < W); }
            bool farb = true; if (BIAS) { farb = (pmq - pmm[t].y >= 128); }
            mode = skip ? 0 : ((allv && farb) ? 1 : 2); }
        bool incl = true;
        if (SELM) { const unsigned long long w = (t < 64) ? sello : selhi; incl = (w >> (t & 63)) & 1ull; }
        if (mode) tile_compute<DQK, DV, DO_PV, BIAS, WINDOWED>(lds, buf, kt0, mode, incl, col, W, qf, o, m, l, p0, p1, lane);
        if (has) tile_store<DQK, DV, BIAS>(st, lds, buf ^ 1, tid);
        __syncthreads();
        if (!has) break;
        t = tn; buf ^= 1;
    }
}
template <int DV> __device__ __forceinline__ void store_col(const f32x16 (&o)[DV / 32], float inv, const bf16_t* gate, bf16_t* out, int hi) {
    u32x2 gw[DV / 32][4];
#pragma unroll
    for (int bk = 0; bk < DV / 32; ++bk)
#pragma unroll
        for (int g4 = 0; g4 < 4; ++g4) gw[bk][g4] = *(const u32x2*)(gate + 32 * bk + 8 * g4 + 4 * hi);
#pragma unroll
    for (int bk = 0; bk < DV / 32; ++bk)
#pragma unroll
        for (int gp = 0; gp < 2; ++gp) {
            u32x2 w[2];
#pragma unroll
            for (int e = 0; e < 2; ++e) { const int g4 = 2 * gp + e; const u32x2 g = gw[bk][g4];
                const float g0 = __uint_as_float(g.x << 16), g1 = __uint_as_float(g.x & 0xffff0000u), g2 = __uint_as_float(g.y << 16), g3 = __uint_as_float(g.y & 0xffff0000u);
                w[e].x = pk2(o[bk][4 * g4] * inv * g0, o[bk][4 * g4 + 1] * inv * g1); w[e].y = pk2(o[bk][4 * g4 + 2] * inv * g2, o[bk][4 * g4 + 3] * inv * g3); }
            auto sx = __builtin_amdgcn_permlane32_swap(w[0].x, w[1].x, false, false); auto sy = __builtin_amdgcn_permlane32_swap(w[0].y, w[1].y, false, false);
            u32x4 v; v.x = sx[0]; v.y = sy[0]; v.z = sx[1]; v.w = sy[1];
            *(u32x4*)(out + 32 * bk + 8 * (2 * gp + hi)) = v; }
}
struct Ptrs { const bf16_t* PROJ; const bf16_t* QKV; const bf16_t* MKV; const bf16_t* KC; const bf16_t* VC; bf16_t* ATT; const int* pos; const int* cpos; const int2* pmm; const int2* cpmm; const float* sinks; int layer; };

__device__ __forceinline__ void unit_mla(LAS char* lds, const Ptrs& P, int b, int h, int qb, int tid_in, int lane_in, int wid) {
    int lane = lane_in; asm volatile("" : "+v"(lane)); const int tid = (tid_in & ~63) | lane;
    const int r32 = lane & 31, hi = lane >> 5, q0 = qb * 256, wq0 = q0 + 32 * wid, qi = wq0 + r32; const size_t row = (size_t)b * S + qi;
    bf16x8 qf[6]; { const bf16_t* qp = P.QKV + row * QKVW + h * 96 + 8 * hi;
#pragma unroll
        for (int s = 0; s < 6; ++s) qf[s] = *(const bf16x8*)(qp + 16 * s); }
    const Src src{P.QKV + (size_t)b * S * QKVW + 768 + h * 128, P.PROJ + (size_t)b * S * PE + E_KPE, P.QKV + (size_t)b * S * QKVW + 768 + h * 128 + 64, QKVW, PE, QKVW, nullptr};
    const Wv wv{wq0, wq0 + 31, wq0, wq0 + 31}; const Col col{qi, qi, 0, 0};
    f32x16 o[2] = {{0}, {0}}, p0, p1; float m = NEG, l = 0.f;
    run_branch<96, 64, true, false, false, true, false>(lds, src, 0, (q0 + 255) >> 6, wv, col, 0, 0, nullptr, 0ull, 0ull, qf, o, m, l, p0, p1, tid, lane);
    l = swapsum(l);
    store_col<64>(o, 1.f / fmaxf(l, 1e-30f), P.PROJ + row * PE + E_GMLA + h * 64, P.ATT + row * 1536 + h * 64, hi);
}
__device__ __forceinline__ void sm_update(f32x16& p0, f32x16& p1, bool near, int up, float& m, float& l, f32x16 (&o)[2]) {
    if (near) {
#pragma unroll
        for (int r = 0; r < 16; ++r) { const int ko = (r & 3) + 8 * (r >> 2); p0[r] = (ko <= up) ? p0[r] : NEG; p1[r] = (ko + 32 <= up) ? p1[r] : NEG; } }
    float a = fmaxf(fmaxf(p0[0], p0[1]), p1[0]), b = fmaxf(fmaxf(p0[2], p0[3]), p1[1]); a = fmaxf(fmaxf(a, p1[2]), p1[3]);
#pragma unroll
    for (int r = 4; r < 16; r += 4) { a = fmaxf(fmaxf(a, p0[r]), p0[r + 1]); b = fmaxf(fmaxf(b, p0[r + 2]), p0[r + 3]); a = fmaxf(fmaxf(a, p1[r]), p1[r + 1]); b = fmaxf(fmaxf(b, p1[r + 2]), p1[r + 3]); }
    const float tmax = swapmax(fmaxf(a, b));
    if (__builtin_amdgcn_ballot_w64(tmax - m > SM_THR) != 0ull) { const float mnew = fmaxf(m, tmax); const float f = __builtin_amdgcn_exp2f(m - mnew); l *= f; m = mnew;
#pragma unroll
        for (int bk = 0; bk < 2; ++bk)
#pragma unroll
            for (int r = 0; r < 16; ++r) o[bk][r] *= f; }
    const float off = (m > -1e29f) ? -m : NEG; float sum = 0.f;
#pragma unroll
    for (int r = 0; r < 16; ++r) { p0[r] = __builtin_amdgcn_exp2f(p0[r] + off); p1[r] = __builtin_amdgcn_exp2f(p1[r] + off); sum += p0[r] + p1[r]; }
    l += sum;
}
__device__ __forceinline__ void unit_mla2(LAS char* lds, const Ptrs& P, int b, int h, int qb2, int tid_in, int lane_in, int wid) {
    int lane = lane_in; asm volatile("" : "+v"(lane)); const int tid = (tid_in & ~63) | lane;
    constexpr int KP = KPitch<96>::v, VP = VPitch<64>::v;
    const int r32 = lane & 31, hi = lane >> 5, q0 = qb2 * 512, wq0 = q0 + 64 * wid, qiA = wq0 + r32, qiB = qiA + 32; const size_t rowA = (size_t)b * S + qiA;
    bf16x8 qfA[6], qfB[6]; { const bf16_t* qp = P.QKV + rowA * QKVW + h * 96 + 8 * hi;
#pragma unroll
        for (int s = 0; s < 6; ++s) { qfA[s] = *(const bf16x8*)(qp + 16 * s); qfB[s] = *(const bf16x8*)(qp + (size_t)32 * QKVW + 16 * s); } }
    const Src src{P.QKV + (size_t)b * S * QKVW + 768 + h * 128, P.PROJ + (size_t)b * S * PE + E_KPE, P.QKV + (size_t)b * S * QKVW + 768 + h * 128 + 64, QKVW, PE, QKVW, nullptr};
    f32x16 oA[2] = {{0}, {0}}, oB[2] = {{0}, {0}}; float mA = NEG, lA = 0.f, mB = NEG, lB = 0.f;
    const int T = (q0 + 511) >> 6, tw = wq0 >> 6;
    Stage<96, 64> st;
    tile_load<96, 64, false>(st, src, 0, tid); tile_store<96, 64, false>(st, lds, 0, tid); __syncthreads();
    int buf = 0;
    for (int t = 0; t <= T; ++t) {
        const bool has = t < T;
        if (has) tile_load<96, 64, false>(st, src, (t + 1) * 64, tid);
        if (t <= tw) {
            const int kt0 = t * 64; const bool near = (t == tw);
            int hl = lane >> 5; asm volatile("" : "+v"(hl));
            const LAS char* kb = lds + kslot(buf) + r32 * KP + hl * 16;
            f32x16 pA0 = {0}, pA1 = {0}, pB0 = {0}, pB1 = {0};
            __builtin_amdgcn_s_setprio(1);
#pragma unroll
            for (int s = 0; s < 6; ++s) { const bf16x8 k0 = *(const LAS bf16x8*)(kb + s * 32), k1 = *(const LAS bf16x8*)(kb + 32 * KP + s * 32);
                pA0 = __builtin_amdgcn_mfma_f32_32x32x16_bf16(k0, qfA[s], pA0, 0, 0, 0); pB0 = __builtin_amdgcn_mfma_f32_32x32x16_bf16(k0, qfB[s], pB0, 0, 0, 0);
                pA1 = __builtin_amdgcn_mfma_f32_32x32x16_bf16(k1, qfA[s], pA1, 0, 0, 0); pB1 = __builtin_amdgcn_mfma_f32_32x32x16_bf16(k1, qfB[s], pB1, 0, 0, 0); }
            __builtin_amdgcn_s_setprio(0);
            sm_update(pA0, pA1, near, qiA - kt0 - 4 * hl, mA, lA, oA);
            sm_update(pB0, pB1, near, qiB - kt0 - 4 * hl, mB, lB, oB);
            __builtin_amdgcn_s_setprio(1);
            const LAS char* vb = lds + vslot(buf) + (4 * hl + ((lane & 15) >> 2)) * VP + (((lane >> 4) & 1) * 16 + (lane & 3) * 4) * 2;
#pragma unroll
            for (int sub = 0; sub < 2; ++sub)
#pragma unroll
                for (int ks = 0; ks < 2; ++ks) {
                    u32x4 wa, wb;
                    if (sub == 0) { wa.x = pk2(pA0[8 * ks], pA0[8 * ks + 1]); wa.y = pk2(pA0[8 * ks + 2], pA0[8 * ks + 3]); wa.z = pk2(pA0[8 * ks + 4], pA0[8 * ks + 5]); wa.w = pk2(pA0[8 * ks + 6], pA0[8 * ks + 7]);
                                    wb.x = pk2(pB0[8 * ks], pB0[8 * ks + 1]); wb.y = pk2(pB0[8 * ks + 2], pB0[8 * ks + 3]); wb.z = pk2(pB0[8 * ks + 4], pB0[8 * ks + 5]); wb.w = pk2(pB0[8 * ks + 6], pB0[8 * ks + 7]); }
                    else          { wa.x = pk2(pA1[8 * ks], pA1[8 * ks + 1]); wa.y = pk2(pA1[8 * ks + 2], pA1[8 * ks + 3]); wa.z = pk2(pA1[8 * ks + 4], pA1[8 * ks + 5]); wa.w = pk2(pA1[8 * ks + 6], pA1[8 * ks + 7]);
                                    wb.x = pk2(pB1[8 * ks], pB1[8 * ks + 1]); wb.y = pk2(pB1[8 * ks + 2], pB1[8 * ks + 3]); wb.z = pk2(pB1[8 * ks + 4], pB1[8 * ks + 5]); wb.w = pk2(pB1[8 * ks + 6], pB1[8 * ks + 7]); }
                    const bf16x8 pa = __builtin_bit_cast(bf16x8, wa), pb = __builtin_bit_cast(bf16x8, wb);
#pragma unroll
                    for (int bk = 0; bk < 2; ++bk) { const LAS char* vp = vb + (32 * sub + 16 * ks) * VP + bk * 64;
                        const s16x4 lo = vtr(vp), hi4 = vtr(vp + 8 * VP); const bf16x8 va = __builtin_shufflevector(lo, hi4, 0, 1, 2, 3, 4, 5, 6, 7);
                        oA[bk] = __builtin_amdgcn_mfma_f32_32x32x16_bf16(va, pa, oA[bk], 0, 0, 0); oB[bk] = __builtin_amdgcn_mfma_f32_32x32x16_bf16(va, pb, oB[bk], 0, 0, 0); }
                }
            __builtin_amdgcn_s_setprio(0);
        }
        if (has) tile_store<96, 64, false>(st, lds, buf ^ 1, tid);
        __syncthreads();
        buf ^= 1;
    }
    lA = swapsum(lA); lB = swapsum(lB);
    store_col<64>(oA, 1.f / fmaxf(lA, 1e-30f), P.PROJ + rowA * PE + E_GMLA + h * 64, P.ATT + rowA * 1536 + h * 64, hi);
    store_col<64>(oB, 1.f / fmaxf(lB, 1e-30f), P.PROJ + (rowA + 32) * PE + E_GMLA + h * 64, P.ATT + (rowA + 32) * 1536 + h * 64, hi);
}
__device__ __forceinline__ void unit_mem(LAS char* lds, const Ptrs& P, int b, int h, int qb, int ld, int qc, int gc, int ldo, int oc, int tid_in, int lane_in, int wid) {
    int lane = lane_in; asm volatile("" : "+v"(lane)); const int tid = (tid_in & ~63) | lane;
    const int r32 = lane & 31, hi = lane >> 5, qi = qb * 256 + 32 * wid + r32; const size_t row = (size_t)b * S + qi;
    bf16x8 qf[8]; { const bf16_t* qp = P.PROJ + row * ld + qc + h * 128 + 8 * hi;
#pragma unroll
        for (int s = 0; s < 8; ++s) qf[s] = *(const bf16x8*)(qp + 16 * s); }
    const bf16_t* kv = P.MKV + (size_t)b * MEML * 4096 + P.layer * 1024 + h * 128;
    const Src src{kv, nullptr, kv + 512, 4096, 0, 4096, nullptr};
    const Wv wv{1 << 30, 1 << 30, qi, qi}; const Col col{qi, 1 << 30, 0, 0};
    f32x16 o[4] = {{0}, {0}, {0}, {0}}, p0, p1; float m = NEG, l = 0.f;
    run_branch_np<128, 128, true, false, false, false, false>(lds, src, 0, 3, wv, col, 0, 0, nullptr, 0ull, 0ull, qf, o, m, l, p0, p1, tid, lane);
    l = swapsum(l);
    store_col<128>(o, 1.f / l, P.PROJ + row * ld + gc + h * 128, P.ATT + row * ldo + oc + h * 128, hi);
}
__device__ __forceinline__ void unit_swa(LAS char* lds, const Ptrs& P, int b, int g, int qblk, int tid_in, int lane_in, int wid) {
    int lane = lane_in; asm volatile("" : "+v"(lane)); const int tid = (tid_in & ~63) | lane;
    const int r32 = lane & 31, hi = lane >> 5, q0 = qblk * 64, wq0 = q0 + 8 * wid, qi = wq0 + (r32 & 7), hc = 4 * g + (r32 >> 3); const size_t row = (size_t)b * S + qi;
    bf16x8 qf[4]; { const bf16_t* qp = P.PROJ + row * PE + E_QSWA + hc * 64 + 8 * hi;
#pragma unroll
        for (int s = 0; s < 4; ++s) qf[s] = *(const bf16x8*)(qp + 16 * s); }
    const Src src{P.PROJ + (size_t)b * S * PE + E_KSWA + g * 64, nullptr, P.PROJ + (size_t)b * S * PE + E_VSWA + g * 64, PE, 0, PE, P.pos};
    const Wv wv{wq0, wq0 + 7, wq0, wq0 + 7}; const Col col{qi, qi, P.pos[qi], hc};
    f32x16 o[2] = {{0}, {0}}, p0, p1; float m = P.sinks[hc] * LOG2E, l = hi ? 0.f : 1.f;
    run_branch<64, 64, true, true, true, true, false>(lds, src, qblk >= 2 ? qblk - 2 : 0, qblk, wv, col, 128, P.pmm[qblk].x, P.pmm, 0ull, 0ull, qf, o, m, l, p0, p1, tid, lane);
    l = swapsum(l);
    store_col<64>(o, 1.f / fmaxf(l, 1e-30f), P.PROJ + row * PE + E_GSWA + hc * 64, P.ATT + row * 1536 + 512 + hc * 64, hi);
}
__device__ __forceinline__ void unit_nsa(LAS char* lds, const Ptrs& P, int b, int g, int cur, int tid_in, int lane_in, int wid) {
    int lane = lane_in; asm volatile("" : "+v"(lane)); const int tid = (tid_in & ~63) | lane;
    const int r32 = lane & 31, hi = lane >> 5, q0 = cur * 64, ql = 8 * wid + (r32 & 7), qi = q0 + ql, hc = 4 * g + (r32 >> 3); const size_t row = (size_t)b * S + qi;
    bf16x8 qf[4]; { const bf16_t* qp = P.PROJ + row * PO + O_Q + hc * 64 + 8 * hi;
#pragma unroll
        for (int s = 0; s < 4; ++s) qf[s] = *(const bf16x8*)(qp + 16 * s); }
    LAS float* imp = (LAS float*)(lds + IMP); LAS unsigned* selws = (LAS unsigned*)(lds + SELW); LAS unsigned* selu = (LAS unsigned*)(lds + SELU);
    for (int i = tid; i < 64 * 129; i += 512) imp[i] = 0.f;
    if (tid < 4) selu[tid] = 0u;
    const int pq = P.pos[qi], pmq = P.pmm[cur].x, wq0 = q0 + 8 * wid;
    f32x16 o[2], p0, p1; unsigned long long sello = 0ull, selhi = 0ull;
#define NSA_GL (P.PROJ + ((size_t)b * S + qi) * PO + O_GL + hc * 3)
    {   const int cl = (qi >= 31) ? ((qi - 31) >> 4) : -1; const int cl0 = (wq0 >= 31) ? ((wq0 - 31) >> 4) : -1, cl1 = (wq0 + 7 >= 31) ? ((wq0 + 7 - 31) >> 4) : -1;
        const int tmax = ((q0 + 63 - 31) >> 4) >> 6;
        const Src src{P.KC + (size_t)(b * 2 + g) * 512 * 64, nullptr, P.VC + (size_t)(b * 2 + g) * 512 * 64, 64, 0, 64, P.cpos};
        const Wv wv{cl0, cl1, wq0, wq0 + 7}; const Col col{qi, cl, pq, hc};
        float m = NEG, l = 0.f; o[0] = (f32x16){0}; o[1] = (f32x16){0};
        run_branch<64, 64, false, true, false, true, false>(lds, src, 0, tmax, wv, col, 0, pmq, P.cpmm, 0ull, 0ull, qf, o, m, l, p0, p1, tid, lane);
        l = swapsum(l); const float il = 1.f / fmaxf(l, 1e-30f);
        {   float l2 = 0.f;
            run_branch<64, 64, true, true, false, true, false, true>(lds, src, 0, tmax, wv, col, 0, pmq, P.cpmm, 0ull, 0ull, qf, o, m, l2, p0, p1, tid, lane, il, ql); }
#pragma unroll
        for (int bk = 0; bk < 2; ++bk)
#pragma unroll
            for (int r = 0; r < 16; ++r) o[bk][r] *= bf2f(NSA_GL[0]) * il;
    }
    {   int lk = lane; asm volatile("" : "+v"(lk)); const int qsel = 8 * wid + (lk >> 3), s = lk & 7; unsigned mk[4] = {0, 0, 0, 0};
        if (cur <= 15) { mk[0] = (cur == 31) ? 0xffffffffu : ((1u << (cur + 1)) - 1u); }
        else {
            float v[16];
#pragma unroll
            for (int t = 0; t < 16; ++t) { const int j = 16 * s + t; v[t] = (j >= 1 && j <= cur - 2) ? imp[qsel * 129 + j] : -1.f; }
            mk[0] = 1u;
            #pragma unroll
            for (int w = 0; w < 4; ++w) { if ((cur >> 5) == w) mk[w] |= 1u << (cur & 31); if (((cur - 1) >> 5) == w) mk[w] |= 1u << ((cur - 1) & 31); }
            for (int rnd = 0; rnd < 13; ++rnd) {
                float best = v[0]; int bi = 0;
#pragma unroll
                for (int t = 1; t < 16; ++t) if (v[t] > best) { best = v[t]; bi = t; }
                int bj = 16 * s + bi;
                { const float ov = dppf<0xB1>(best); const int oj = dppi<0xB1>(bj); if (ov > best || (ov == best && oj < bj)) { best = ov; bj = oj; } }
                { const float ov = dppf<0x4E>(best); const int oj = dppi<0x4E>(bj); if (ov > best || (ov == best && oj < bj)) { best = ov; bj = oj; } }
                { const float ov = dppf<0x141>(best); const int oj = dppi<0x141>(bj); if (ov > best || (ov == best && oj < bj)) { best = ov; bj = oj; } }
                if (best >= 0.f) {
#pragma unroll
                    for (int t = 0; t < 16; ++t) if (16 * s + t == bj) v[t] = -1.f;
#pragma unroll
                    for (int w = 0; w < 4; ++w) if ((bj >> 5) == w) mk[w] |= 1u << (bj & 31);
                }
            }
        }
        if (s == 0) {
#pragma unroll
            for (int w = 0; w < 4; ++w) { selws[qsel * 4 + w] = mk[w]; atomicOr((unsigned*)(selu + w), mk[w]); } }
    }
    __syncthreads();
    sello = (unsigned long long)selws[ql * 4 + 0] | ((unsigned long long)selws[ql * 4 + 1] << 32); selhi = (unsigned long long)selws[ql * 4 + 2] | ((unsigned long long)selws[ql * 4 + 3] << 32);
#define NSA_STASH ((LAS bf16_t*)(lds + IMP) + wid * 2048 + r32 * 64 + 4 * hi)
#pragma unroll
    for (int bk = 0; bk < 2; ++bk)
#pragma unroll
        for (int g4 = 0; g4 < 4; ++g4) { u32x2 w; w.x = pk2(o[bk][4 * g4], o[bk][4 * g4 + 1]); w.y = pk2(o[bk][4 * g4 + 2], o[bk][4 * g4 + 3]); *(LAS u32x2*)(NSA_STASH + 32 * bk + 8 * g4) = w; }
    {   const Src src{P.PROJ + (size_t)b * S * PO + O_KSLC + g * 64, nullptr, P.PROJ + (size_t)b * S * PO + O_VSLC + g * 64, PO, 0, PO, P.pos};
        const Wv wv{wq0, wq0 + 7, wq0, wq0 + 7}; const Col col{qi, qi, pq, hc};
        float m = NEG, l = 0.f; o[0] = (f32x16){0}; o[1] = (f32x16){0};
        run_branch<64, 64, true, true, false, true, true>(lds, src, 0, cur, wv, col, 0, pmq, P.pmm, sello, selhi, qf, o, m, l, p0, p1, tid, lane);
        l = swapsum(l); const float il = bf2f(NSA_GL[1]) / fmaxf(l, 1e-30f);
#pragma unroll
        for (int bk = 0; bk < 2; ++bk)
#pragma unroll
            for (int g4 = 0; g4 < 4; ++g4) { const u32x2 pv = *(const LAS u32x2*)(NSA_STASH + 32 * bk + 8 * g4);
                u32x2 w; w.x = pk2(__uint_as_float(pv.x << 16) + il * o[bk][4 * g4], __uint_as_float(pv.x & 0xffff0000u) + il * o[bk][4 * g4 + 1]);
                w.y = pk2(__uint_as_float(pv.y << 16) + il * o[bk][4 * g4 + 2], __uint_as_float(pv.y & 0xffff0000u) + il * o[bk][4 * g4 + 3]); *(LAS u32x2*)(NSA_STASH + 32 * bk + 8 * g4) = w; }
    }
    {   const Src src{P.PROJ + (size_t)b * S * PO + O_KWIN + g * 64, nullptr, P.PROJ + (size_t)b * S * PO + O_VWIN + g * 64, PO, 0, PO, P.pos};
        const Wv wv{wq0, wq0 + 7, wq0, wq0 + 7}; const Col col{qi, qi, pq, hc};
        float m = NEG, l = 0.f; o[0] = (f32x16){0}; o[1] = (f32x16){0};
        run_branch<64, 64, true, true, true, true, false>(lds, src, cur >= 8 ? cur - 8 : 0, cur, wv, col, 512, pmq, P.pmm, 0ull, 0ull, qf, o, m, l, p0, p1, tid, lane);
        l = swapsum(l); const float il = bf2f(NSA_GL[2]) / fmaxf(l, 1e-30f);
#pragma unroll
        for (int bk = 0; bk < 2; ++bk)
#pragma unroll
            for (int g4 = 0; g4 < 4; ++g4) { const u32x2 pv = *(const LAS u32x2*)(NSA_STASH + 32 * bk + 8 * g4);
                o[bk][4 * g4] = __uint_as_float(pv.x << 16) + il * o[bk][4 * g4]; o[bk][4 * g4 + 1] = __uint_as_float(pv.x & 0xffff0000u) + il * o[bk][4 * g4 + 1];
                o[bk][4 * g4 + 2] = __uint_as_float(pv.y << 16) + il * o[bk][4 * g4 + 2]; o[bk][4 * g4 + 3] = __uint_as_float(pv.y & 0xffff0000u) + il * o[bk][4 * g4 + 3]; }
    }
    store_col<64>(o, 1.f, P.PROJ + ((size_t)b * S + qi) * PO + O_GNSA + hc * 64, P.ATT + ((size_t)b * S + qi) * 1024 + hc * 64, hi);
#undef NSA_GL
#undef NSA_STASH
}
}
#define XB_TMO      128
#define XB_XCNT(j)  (256  + 64 * (j))
#define XB_XSUB(j)  (1280 + 64 * (j))
#define XB_XGEN(j)  (2304 + 64 * (j))
#define XB_TOP      3328
#define XB_TOPGEN   3392
#define XCD_BAR_WORDS 3456
#define XB_SPIN_CAP (1u << 18)
__device__ __forceinline__ unsigned xb_ld(unsigned* p)              { return __hip_atomic_load(p, __ATOMIC_RELAXED, __HIP_MEMORY_SCOPE_AGENT); }
__device__ __forceinline__ unsigned xb_add(unsigned* p, unsigned v) { return __hip_atomic_fetch_add(p, v, __ATOMIC_RELAXED, __HIP_MEMORY_SCOPE_AGENT); }
__device__ __forceinline__ unsigned xb_xcc_id() { return (unsigned)__builtin_amdgcn_s_getreg((3 << 11) | 20) & 0xFu; }
#define XB_SPIN(cond, bar) do { unsigned _sp = 0; while (cond) { __builtin_amdgcn_s_sleep(1); \
    if ((++_sp & 255u) == 0u) { if (xb_ld(&(bar)[XB_TMO])) break; if (_sp > XB_SPIN_CAP) { atomicAdd(&(bar)[XB_TMO], 1u); break; } } } } while (0)
struct XcdBarrier { unsigned* bar; unsigned x; volatile LAS unsigned* st; };
__device__ __forceinline__ XcdBarrier xcd_barrier_post(unsigned* bar, volatile LAS unsigned* st, bool leader) {
    XcdBarrier b; b.bar = bar; b.x = xb_xcc_id(); b.st = st;
    if (leader) (void)xb_add(&bar[XB_XCNT(b.x)], 1u);
    return b;
}
__device__ __forceinline__ void xcd_barrier_complete(unsigned* bar, unsigned x, unsigned& nloc, unsigned& nx) {
    const unsigned G = gridDim.x * gridDim.y * gridDim.z;
    unsigned sum, cnt, mine, sp = 0u;
    for (;;) {
        sum = 0u; cnt = 0u; mine = 0u;
#pragma unroll
        for (unsigned j = 0; j < 16; ++j) { const unsigned c = xb_ld(&bar[XB_XCNT(j)]); sum += c; cnt += (c > 0u) ? 1u : 0u; mine = (j == x) ? c : mine; }
        if (sum == G) break;
        __builtin_amdgcn_s_sleep(1);
        if ((++sp & 255u) == 0u) { if (xb_ld(&bar[XB_TMO])) break; if (sp > XB_SPIN_CAP) { atomicAdd(&bar[XB_TMO], 1u); break; } }
    }
    nloc = mine > 0u ? mine : 1u; nx = cnt > 0u ? cnt : 1u;
}
__device__ __forceinline__ void xcd_barrier(const XcdBarrier& b, bool leader) {
    asm volatile("s_waitcnt vmcnt(0)" ::: "memory");
    __syncthreads();
    if (leader) {
        unsigned* bar = b.bar;
        __builtin_amdgcn_s_waitcnt(0);
        unsigned nloc = b.st[0], nx = b.st[1];
        if (nloc == 0u) { xcd_barrier_complete(bar, b.x, nloc, nx); b.st[0] = nloc; b.st[1] = nx; }
        const unsigned old = xb_add(&bar[XB_XSUB(b.x)], 1u);
        const unsigned gen = old / nloc;
        if (old + 1u == (gen + 1u) * nloc) {
            __builtin_amdgcn_fence(__ATOMIC_RELEASE, "agent");
            asm volatile("s_waitcnt vmcnt(0)" ::: "memory");
            const unsigned og = xb_add(&bar[XB_TOP], 1u);
            const unsigned tg = og / nx;
            if (og + 1u == (tg + 1u) * nx) xb_add(&bar[XB_TOPGEN], 1u);
            else XB_SPIN(xb_ld(&bar[XB_TOPGEN]) == tg, bar);
            __builtin_amdgcn_fence(__ATOMIC_ACQUIRE, "agent");
            xb_add(&bar[XB_XGEN(b.x)], 1u);
            asm volatile("s_waitcnt vmcnt(0)" ::: "memory");
        } else {
            XB_SPIN(xb_ld(&bar[XB_XGEN(b.x)]) == gen, bar);
            __builtin_amdgcn_fence(__ATOMIC_ACQUIRE, "agent");
            asm volatile("s_waitcnt vmcnt(0)" ::: "memory");
        }
    }
    __syncthreads();
}

constexpr int NWAVES = 8, RING_BYTES = 131072, MISC_OFF = 143360, LDS_BYTES = 147456;
struct Args { const void* in[23]; float* out; unsigned char* ws; int ph_lo, ph_hi, li, pad; };

template <class F> __device__ __forceinline__ void conv_item(F val, int K, bf16_t* Wt, LAS float* scr, int item, int nblk, int lane) {
    const int kb = item / nblk, nb = item % nblk, k0 = 64 * kb, n0 = 32 * nb;
#pragma unroll 8
    for (int i = 0; i < 32; ++i) { const int kk = 2 * i + (lane >> 5); scr[kk * 33 + (lane & 31)] = val(k0 + kk, n0 + (lane & 31)); }
    asm volatile("s_waitcnt lgkmcnt(0)" ::: "memory");
    const int c = lane & 7;
#pragma unroll
    for (int j = 0; j < 4; ++j) { const int n = (lane >> 3) + 8 * j; const LAS float* sp = scr + (8 * c) * 33 + n;
        u32x4 o; o.x = pk2(sp[0], sp[33]); o.y = pk2(sp[2 * 33], sp[3 * 33]); o.z = pk2(sp[4 * 33], sp[5 * 33]); o.w = pk2(sp[6 * 33], sp[7 * 33]);
        *(u32x4*)(Wt + (size_t)(n0 + n) * K + k0 + 8 * c) = o; }
    asm volatile("s_waitcnt lgkmcnt(0)" ::: "memory");
}
__device__ __forceinline__ int map_even(int n, float& sc) {
    sc = 1.f;
    if (n < 256) return n; if (n < 384) return 256 + (n - 256); if (n < 512) return 1440 + (n - 384); if (n < 640) return 1568 + (n - 512);
    if (n < 672) { const int j = n - 640; return 384 + ((j & 1) ? (j >> 1) + 16 : (j >> 1)); }
    if (n < 768) return -1; if (n < 1280) return 416 + (n - 768);
    if (n < 1792) { sc = 0.125f * LOG2E; return 928 + (n - 1280); } if (n < 2304) return 1696 + (n - 1792);
    if (n < 2816) { sc = 0.08838834764831845f * LOG2E; return 2208 + (n - 2304); } return 2720 + (n - 2816);
}
__device__ __forceinline__ int map_odd(int n, float& sc) {
    sc = 1.f;
    if (n < 512) { sc = 0.125f * LOG2E; return n; } if (n < 1304) return n; if (n < 1536) return -1; if (n < 2048) return 1304 + (n - 1536);
    if (n < 2560) { sc = 0.08838834764831845f * LOG2E; return 1816 + (n - 2048); } return 2328 + (n - 2560);
}
constexpr int N_PHASES = 24;
#ifndef MK_SITES
#define MK_SITES 0x1fff
#endif
#define SITE(k) (((MK_SITES) >> (k)) & 1)
#ifndef MK_UNITS
#define MK_UNITS 15
#endif
#ifndef MK_DUP
#define MK_DUP 0
#endif
#define NREP(k) ((((MK_DUP) >> (k)) & 1) ? 2 : 1)
__global__ void __launch_bounds__(NWAVES * 64, 2) mega(Args a) {
    extern __shared__ __attribute__((aligned(16))) unsigned char lds_raw[];
    LAS unsigned char* lds = (LAS unsigned char*)lds_raw;
    volatile LAS unsigned* MISC = (volatile LAS unsigned*)(lds + MISC_OFF);
    const int tid0 = threadIdx.x; const int wid0 = __builtin_amdgcn_readfirstlane(tid0 >> 6);
    const int G = gridDim.x, bx = blockIdx.x, NGW = G * NWAVES;
#define WSB() unsigned long long wz_ = 0ull; asm volatile("" : "+s"(wz_)); unsigned char* ws = a.ws + wz_;     unsigned* ctl = (unsigned*)(ws + WS_CTL); (void)ctl; \
    unsigned ones_ = ~0u; asm volatile("" : "+s"(ones_)); const int lane = (int)__builtin_amdgcn_mbcnt_hi(ones_, __builtin_amdgcn_mbcnt_lo(ones_, 0u)); int wid_ = wid0; asm volatile("" : "+s"(wid_)); const int wid = wid_, tid = wid * 64 + lane, gw = bx * NWAVES + wid; (void)tid; (void)gw
#define PTR_STATS() float* ssqx = (float*)(ws + WS_SSQX); float* ssqq = (float*)(ws + WS_SSQQ4); float* ssqkv = (float*)(ws + WS_SSQKV4); float* ssqy = (float*)(ws + WS_SSQY16); (void)ssqx; (void)ssqq; (void)ssqkv; (void)ssqy
#define PTR_ACT() bf16_t* XB = (bf16_t*)(ws + WS_A); bf16_t* ATT = (bf16_t*)(ws + WS_A); bf16_t* PROJ = (bf16_t*)(ws + WS_B); bf16_t* Y = (bf16_t*)(ws + WS_B); bf16_t* QKV = (bf16_t*)(ws + WS_C); (void)XB; (void)ATT; (void)PROJ; (void)Y; (void)QKV
    float* const out = a.out;
    for (int u = tid0; u < (LDS_BYTES - MISC_OFF) / 4; u += NWAVES * 64) ((LAS unsigned*)(lds + MISC_OFF))[u] = 0u;
    __syncthreads();
    XcdBarrier bar; bar.bar = (unsigned*)(a.ws + WS_CTL) + CW_BAR + a.li * XCD_BAR_WORDS; bar.x = 0; bar.st = nullptr;
    if (!MK_PER_PHASE) bar = xcd_barrier_post((unsigned*)(a.ws + WS_CTL) + CW_BAR + a.li * XCD_BAR_WORDS, MISC + 8, tid0 == 0);
    const int lo = a.ph_lo, hi = a.ph_hi;
#define IN(k) (lo <= (k) && (k) < hi)
#define SEAM(k) do { if ((k) + 1 < hi) xcd_barrier(bar, tid == 0); } while (0)
#define Q_INIT() do { if (tid == 0) { MISC[5] = 0u; MISC[6] = 0u; } } while (0)
#define Q_NEXT(head, NQ, dst, dq) do { __syncthreads(); if (tid == 0) { unsigned q_ = MISC[5], tr_ = MISC[6]; int u_ = -1; const unsigned x_ = xb_xcc_id() & 7u; \
        while (tr_ < 8u) { const unsigned v_ = __hip_atomic_fetch_add((head) + ((x_ + q_) & 7u) * 64, 1u, __ATOMIC_RELAXED, __HIP_MEMORY_SCOPE_AGENT); if (v_ < (unsigned)(NQ)) { u_ = (int)v_; break; } ++q_; ++tr_; } \
        MISC[5] = q_; MISC[6] = tr_; MISC[4] = (unsigned)u_; MISC[7] = (x_ + q_) & 7u; } __syncthreads(); (dst) = (int)MISC[4]; (dq) = (int)MISC[7]; } while (0)
#define STAGE_LUT() do { const float* lut_ = (const float*)(ws + WS_LUT); for (int i_ = tid; i_ < 8 * 132; i_ += NWAVES * 64) ((LAS float*)(lds + att::LUTO))[i_] = lut_[i_]; __syncthreads(); } while (0)

    if (SITE(0) && IN(0)) {
        WSB(); PTR_STATS(); PTR_ACT();
        const float* x = (const float*)a.in[0]; const float* mem = (const float*)a.in[1]; const int* pos = (const int*)a.in[2]; const float* table = (const float*)a.in[3];
        const float* norm_pre = (const float*)a.in[4]; const float* mem_norm = (const float*)a.in[6]; const float* w_mem_kv = (const float*)a.in[7];
        const float* w_in_even = (const float*)a.in[8]; const float* mla_q_norm = (const float*)a.in[9]; const float* mla_kv_norm = (const float*)a.in[10]; const float* mla_w_uq = (const float*)a.in[11];
        const float* mla_w_ukv = (const float*)a.in[12]; const float* w_out_even = (const float*)a.in[14]; const float* w_in_odd = (const float*)a.in[15];
        const float* cmp_pos_k = (const float*)a.in[16]; const float* cmp_pos_v = (const float*)a.in[17]; const float* cmp_w1_k = (const float*)a.in[18]; const float* cmp_w1_v = (const float*)a.in[20]; const float* w_out_odd = (const float*)a.in[22];
        float* rstdm = (float*)(ws + WS_RSTDM); int2* pmm = (int2*)(ws + WS_PMM); int2* cpmm = pmm + 128; int* cpos = (int*)(ws + WS_CPOS);
        float2* rope = (float2*)(ws + WS_ROPE); float* lut = (float*)(ws + WS_LUT); float* pb = (float*)(ws + WS_PB);
        bf16_t* WINE = (bf16_t*)(ws + WS_WINE); bf16_t* WINO = (bf16_t*)(ws + WS_WINO); bf16_t* WOUTE = (bf16_t*)(ws + WS_WOUTE); bf16_t* WOUTO = (bf16_t*)(ws + WS_WOUTO);
        bf16_t* WMKV = (bf16_t*)(ws + WS_WMKV); bf16_t* WUP = (bf16_t*)(ws + WS_WUP); bf16_t* WC1 = (bf16_t*)(ws + WS_WC1); bf16_t* MEMB = (bf16_t*)(ws + WS_MEMB);
        LAS float* scr = (LAS float*)(lds + wid * 16384);
        constexpr int I0 = 1664, I1 = 1536, I2 = 768, I3 = 512, I4 = 512, I5 = 336, I6 = 256;
        constexpr int S1 = 2 * I0, S2 = S1 + 2 * I1, S3 = S2 + 2 * I2, S4 = S3 + 2 * I3, S5 = S4 + 4 * I4, S6 = S5 + 2 * I5, S7 = S6 + 4 * I6;
        for (int it = gw; it < S7; it += NGW) {
            if (it < S1) { const int e = it / I0, r = it % I0; const float* W = w_in_even + (size_t)e * DM * 3232; const float* gn = norm_pre + (2 * e) * DM;
                conv_item([&](int k, int n) -> float { float sc; const int s = map_even(n, sc); return s < 0 ? 0.f : W[(size_t)k * 3232 + s] * sc * gn[k]; }, DM, WINE + (size_t)e * PE * DM, scr, r, PE / 32, lane); }
            else if (it < S2) { const int e = (it - S1) / I1, r = (it - S1) % I1; const float* W = w_in_odd + (size_t)e * DM * 2840; const float* gn = norm_pre + (2 * e + 1) * DM;
                conv_item([&](int k, int n) -> float { float sc; const int s = map_odd(n, sc); return s < 0 ? 0.f : W[(size_t)k * 2840 + s] * sc * gn[k]; }, DM, WINO + (size_t)e * PO * DM, scr, r, PO / 32, lane); }
            else if (it < S3) { const int e = (it - S2) / I2, r = (it - S2) % I2; const float* W = w_out_even + (size_t)e * 1536 * DM;
                conv_item([&](int k, int n) -> float { return W[(size_t)k * DM + n]; }, 1536, WOUTE + (size_t)e * DM * 1536, scr, r, DM / 32, lane); }
            else if (it < S4) { const int e = (it - S3) / I3, r = (it - S3) % I3; const float* W = w_out_odd + (size_t)e * DM * DM;
                conv_item([&](int k, int n) -> float { return W[(size_t)k * DM + n]; }, DM, WOUTO + (size_t)e * DM * DM, scr, r, DM / 32, lane); }
            else if (it < S5) { const int l = (it - S4) / I4, r = (it - S4) % I4; const float* W = w_mem_kv + (size_t)l * DM * DM; const float* gn = mem_norm + l * DM;
                conv_item([&](int k, int n) -> float { return W[(size_t)k * DM + n] * gn[k]; }, DM, WMKV + (size_t)l * DM * DM, scr, r, DM / 32, lane); }
            else if (it < S6) { const int e = (it - S5) / I5, r = (it - S5) % I5; const float* Wq = mla_w_uq + (size_t)e * 256 * 768; const float* Wk = mla_w_ukv + (size_t)e * 128 * 1024;
                const float* gq = mla_q_norm + e * 256; const float* gk = mla_kv_norm + e * 128;
                conv_item([&](int k, int n) -> float {
                    if (n < 768) { if (k >= 256) return 0.f; const int h = n / 96, j = n % 96; const int s = (j < 64) ? n : h * 96 + 64 + (((j - 64) & 1) ? ((j - 64) >> 1) + 16 : ((j - 64) >> 1));
                        return Wq[(size_t)k * 768 + s] * (0.10206207261596575f * LOG2E) * gq[k]; }
                    if (k < 256) return 0.f; return Wk[(size_t)(k - 256) * 1024 + (n - 768)] * gk[k - 256]; }, 384, WUP + (size_t)e * QKVW * 384, scr, r, QKVW / 32, lane); }
            else { const int m4 = (it - S6) / I6, r = (it - S6) % I6; const float* W = ((m4 & 1) ? cmp_w1_v : cmp_w1_k) + (size_t)(m4 >> 1) * 2048 * 256;
                conv_item([&](int k, int n) -> float { return W[(size_t)k * 256 + n]; }, 2048, WC1 + (size_t)m4 * 256 * 2048, scr, r, 256 / 32, lane); }
        }
        for (int row = gw; row < T + NB * MEML; row += NGW) {
            const bool isx = row < T; const int r = isx ? row : row - T; const float* src = (isx ? x : mem) + (size_t)r * DM; bf16_t* dst = (isx ? XB : MEMB) + (size_t)r * DM;
            float s = 0.f;
#pragma unroll
            for (int j = 0; j < 4; ++j) { const f32x4 v = *(const f32x4*)(src + 4 * (lane + 64 * j)); s += (v[0] * v[0] + v[1] * v[1]) + (v[2] * v[2] + v[3] * v[3]);
                u32x2 w; w.x = pk2(v[0], v[1]); w.y = pk2(v[2], v[3]); *(u32x2*)(dst + 4 * (lane + 64 * j)) = w; }
            s = wave_sum(s);
            if (lane == 0) { if (isx) ssqx[r] = s; else rstdm[r] = rsqrtf(s * (1.f / DM) + EPS); }
        }
        for (int idx = bx * (NWAVES * 64) + tid; idx < S * 16; idx += G * NWAVES * 64) {
            { const int s = idx >> 4, i = idx & 15; const float inv = powf(10000.0f, -(float)i / 16.0f); const float ang = (float)pos[s] * inv; float sn, cs; sincosf(ang, &sn, &cs); rope[idx] = make_float2(cs, sn); }
            if (idx < 8 * 132) { const int h = idx / 132, d = idx % 132; int bucket;
                if (d < 16) bucket = d; else { const float lr = logf((float)d / 16.0f) / logf(8.0f); const int lg = 16 + (int)(lr * 16.0f); bucket = lg < 31 ? lg : 31; }
                lut[idx] = table[bucket * 8 + h] * LOG2E; }
            if (idx < 128) { int mn = pos[idx * 64], mx = mn; for (int i = 1; i < 64; ++i) { const int p = pos[idx * 64 + i]; mn = p < mn ? p : mn; mx = p > mx ? p : mx; } pmm[idx] = make_int2(mn, mx); }
            if (idx < 512) { const int tk = 16 * idx + 31; cpos[idx] = pos[tk < S ? tk : S - 1]; }
            if (idx < 8) { int mn = 0x7fffffff, mx = -0x7fffffff; for (int i = 0; i < 64; ++i) { const int tk = 16 * (idx * 64 + i) + 31; const int p = pos[tk < S ? tk : S - 1]; mn = p < mn ? p : mn; mx = p > mx ? p : mx; } cpmm[idx] = make_int2(mn, mx); }
        }
        for (int it = gw; it < 256; it += NGW) { const int kc = it >> 4, m4 = (it >> 2) & 3, n = (it & 3) * 64 + lane;
            const float* pe = ((m4 & 1) ? cmp_pos_v : cmp_pos_k) + (size_t)(m4 >> 1) * 2048 + kc * 128; const float* w = ((m4 & 1) ? cmp_w1_v : cmp_w1_k) + (size_t)(m4 >> 1) * 2048 * 256 + (size_t)kc * 128 * 256 + n;
            float s0 = 0.f, s1 = 0.f, s2 = 0.f, s3 = 0.f;
#pragma unroll 8
            for (int k = 0; k < 128; k += 4) { s0 += pe[k] * w[(size_t)k * 256]; s1 += pe[k + 1] * w[(size_t)(k + 1) * 256]; s2 += pe[k + 2] * w[(size_t)(k + 2) * 256]; s3 += pe[k + 3] * w[(size_t)(k + 3) * 256]; }
            pb[(kc * 4 + m4) * 256 + n] = (s0 + s1) + (s2 + s3); }
        SEAM(0);
    }
    if (SITE(1) && IN(1)) {
        WSB(); bf16_t* MEMB = (bf16_t*)(ws + WS_MEMB); bf16_t* WMKV = (bf16_t*)(ws + WS_WMKV); bf16_t* MKV = (bf16_t*)(ws + WS_MKV); float* rstdm = (float*)(ws + WS_RSTDM);
        pg8::Gemm g{MEMB, WMKV, DM, DM * 2, DM * 2, 128, 0}; pg8::StaticOrder SO; SO.init(NB * MEML / 256, 4096 / 256, G, bx);
        pg8::EpiStore E{MKV, rstdm, nullptr, 4096};
        pg8::gemm_phase<pg8::EpiStore, pg8::StaticOrder, true, true>(lds, g, SO, E, wid);
        SEAM(1);
    }
    for (int pr = 0; pr < 2; ++pr) {
        const int base = 2 + pr * 11;
        if (SITE(2) && IN(base + 0)) {
            WSB(); PTR_STATS(); PTR_ACT(); bf16_t* WINE = (bf16_t*)(ws + WS_WINE); const float2* rope = (const float2*)(ws + WS_ROPE);
            pg8::Gemm g{XB, WINE + (size_t)pr * PE * DM, DM, DM * 2, DM * 2, 128, 0}; pg8::StaticOrder SO; SO.init(T / 256, PE / 256, G, bx);
            pg8::EpiWin E{PROJ, ssqx, rope, ssqq, ssqkv, PE, 0};
            pg8::gemm_phase<pg8::EpiWin, pg8::StaticOrder, true, true>(lds, g, SO, E, wid);
            SEAM(base + 0);
        }
        if (SITE(3) && IN(base + 1)) {
            WSB(); PTR_STATS(); PTR_ACT(); bf16_t* WUP = (bf16_t*)(ws + WS_WUP); const float2* rope = (const float2*)(ws + WS_ROPE);
            pg8::Gemm g{PROJ, WUP + (size_t)pr * QKVW * 384, 384, PE * 2, 384 * 2, 128, 0}; pg8::StaticOrder SO; SO.init(T / 256, QKVW / 256, G, bx);
            pg8::EpiUp E{QKV, ssqq, ssqkv, rope};
            pg8::gemm_phase<pg8::EpiUp, pg8::StaticOrder, true, true>(lds, g, SO, E, wid);
            SEAM(base + 1);
        }
        if (SITE(4) && IN(base + 2)) {
            WSB(); PTR_ACT(); const int* pos = (const int*)a.in[2]; const float* swa_sinks = (const float*)a.in[13]; bf16_t* MKV = (bf16_t*)(ws + WS_MKV); bf16_t* KC = (bf16_t*)(ws + WS_KC); bf16_t* VC = (bf16_t*)(ws + WS_VC);
            const int2* pmm = (const int2*)(ws + WS_PMM); const int2* cpmm = pmm + 128; const int* cpos = (const int*)(ws + WS_CPOS);
            STAGE_LUT();
            const att::Ptrs P{PROJ, QKV, MKV, KC, VC, ATT, pos, cpos, pmm, cpmm, swa_sinks + pr * 8, 2 * pr};
            unsigned* head = ctl + CW_Q + (pr * 2 + 0) * 512 + a.li * 16;
            Q_INIT();
            for (;;) { int u, xq; Q_NEXT(head, 512, u, xq); if (u < 0) break;
                if (u < 128) { const int bh = xq + 8 * (u >> 4); if (MK_UNITS & 1) att::unit_mla2((LAS char*)lds, P, bh >> 3, bh & 7, 15 - (u & 15), tid, lane, wid); }
                else if (u < 256) { const int v = u - 128, bh = xq + 8 * (v >> 5); if (MK_UNITS & 2) att::unit_mem((LAS char*)lds, P, bh >> 2, bh & 3, v & 31, PE, E_QMEM, E_GMEM, 1536, 1024, tid, lane, wid); }
                else { const int v = u - 256, bg = xq + 8 * (v >> 7); if (MK_UNITS & 4) att::unit_swa((LAS char*)lds, P, bg >> 1, bg & 1, 127 - (v & 127), tid, lane, wid); } }
            SEAM(base + 2);
        }
        if (SITE(5) && IN(base + 3)) {
            WSB(); PTR_STATS(); PTR_ACT(); bf16_t* WOUTE = (bf16_t*)(ws + WS_WOUTE);
            pg8::Gemm g{ATT, WOUTE + (size_t)pr * DM * 1536, 1536, 1536 * 2, 1536 * 2, 128, 0}; pg8::StaticOrder SO; SO.init(T / 256, DM / 256, G, bx);
            pg8::EpiStore E{Y, nullptr, ssqy, DM};
            pg8::gemm_phase<pg8::EpiStore, pg8::StaticOrder, true, true>(lds, g, SO, E, wid);
            SEAM(base + 3);
        }
#define RESID(L, XIN, WXB) do { const float* gp_ = norm_post + (L) * DM; const float* xin_ = (XIN); \
            for (int row = gw; row < T; row += NGW) { float sy_; { const f32x4* q_ = (const f32x4*)(ssqy + (size_t)row * 16); const f32x4 a_ = q_[0], b_ = q_[1], c_ = q_[2], d_ = q_[3]; \
                    sy_ = (((a_[0] + a_[1]) + (a_[2] + a_[3])) + ((b_[0] + b_[1]) + (b_[2] + b_[3]))) + (((c_[0] + c_[1]) + (c_[2] + c_[3])) + ((d_[0] + d_[1]) + (d_[2] + d_[3]))); } \
                const float rs = rsqrtf(sy_ * (1.f / DM) + EPS); float s2 = 0.f; \
                _Pragma("unroll") for (int j = 0; j < 4; ++j) { const int c = 4 * (lane + 64 * j); const u32x2 yw = *(const u32x2*)(Y + (size_t)row * DM + c); const f32x4 xv = *(const f32x4*)(xin_ + (size_t)row * DM + c); const f32x4 gv = *(const f32x4*)(gp_ + c); \
                    f32x4 v; v[0] = xv[0] + __uint_as_float(yw.x << 16) * rs * gv[0]; v[1] = xv[1] + __uint_as_float(yw.x & 0xffff0000u) * rs * gv[1]; v[2] = xv[2] + __uint_as_float(yw.y << 16) * rs * gv[2]; v[3] = xv[3] + __uint_as_float(yw.y & 0xffff0000u) * rs * gv[3]; \
                    *(f32x4*)(out + (size_t)row * DM + c) = v; if (WXB) { u32x2 w; w.x = pk2(v[0], v[1]); w.y = pk2(v[2], v[3]); *(u32x2*)(XB + (size_t)row * DM + c) = w; } s2 += (v[0] * v[0] + v[1] * v[1]) + (v[2] * v[2] + v[3] * v[3]); } \
                s2 = wave_sum(s2); if (lane == 0) ssqx[row] = s2; } } while (0)
        if (SITE(6) && IN(base + 4)) { WSB(); PTR_STATS(); PTR_ACT(); const float* norm_post = (const float*)a.in[5]; RESID(2 * pr, (pr == 0) ? (const float*)a.in[0] : (const float*)out, true); SEAM(base + 4); }
        if (SITE(7) && IN(base + 5)) {
            WSB(); PTR_STATS(); PTR_ACT(); bf16_t* WINO = (bf16_t*)(ws + WS_WINO); const float2* rope = (const float2*)(ws + WS_ROPE);
            pg8::Gemm g{XB, WINO + (size_t)pr * PO * DM, DM, DM * 2, DM * 2, 128, 0}; pg8::StaticOrder SO; SO.init(T / 256, PO / 256, G, bx);
            pg8::EpiWin E{PROJ, ssqx, rope, ssqq, ssqkv, PO, 1};
            pg8::gemm_phase<pg8::EpiWin, pg8::StaticOrder, true, true>(lds, g, SO, E, wid);
            SEAM(base + 5);
        }
        if (SITE(8) && IN(base + 6)) { WSB(); PTR_ACT(); bf16_t* WC1 = (bf16_t*)(ws + WS_WC1); float* PART = (float*)(ws + WS_C);
            pg8::Gemm gk{PROJ + O_KCMP, WC1 + (size_t)(pr * 2) * 256 * 2048, 512, 16 * PO * 2, 2048 * 2, PO * 2, 2}; pg8::StaticOrder S1; S1.init(256, 1, G, bx);
            pg8::EpiPart Ek{PART};
            pg8::gemm_phase<pg8::EpiPart, pg8::StaticOrder, true, true>(lds, gk, S1, Ek, wid);
            SEAM(base + 6);
        }
        if (SITE(9) && IN(base + 7)) { WSB(); const float* PART = (const float*)(ws + WS_C); bf16_t* KC = (bf16_t*)(ws + WS_KC); bf16_t* VC = (bf16_t*)(ws + WS_VC); const float* pb = (const float*)(ws + WS_PB) + pr * 512;     const float* cmp_w2_k = (const float*)a.in[19]; const float* cmp_w2_v = (const float*)a.in[21];
            LAS float* w2s = (LAS float*)lds;
            const float* w2k = cmp_w2_k + (size_t)pr * 256 * 64; const float* w2v = cmp_w2_v + (size_t)pr * 256 * 64;
            for (int i = tid; i < 256 * 64; i += NWAVES * 64) { w2s[i] = w2k[i]; w2s[256 * 64 + i] = w2v[i]; }
            __syncthreads();
            f32x4 pbs[2];
#pragma unroll
            for (int kv_ = 0; kv_ < 2; ++kv_) { f32x4 acc_ = (f32x4){0.f, 0.f, 0.f, 0.f};
                for (int kc = 0; kc < 16; ++kc) acc_ += *(const f32x4*)(pb + (kc * 4 + kv_) * 256 + 4 * lane);
                pbs[kv_] = acc_; }
            for (int it = gw; it < 2 * 8192; it += NGW) { const int kv = it >> 13, row = it & 8191; const f32x4 pbsum = kv ? pbs[1] : pbs[0]; const float* pp = PART + ((size_t)kv * 4 * 8192 + row) * 256 + 4 * lane; const LAS float* wp = w2s + kv * 256 * 64 + lane;
                const f32x4 q0 = *(const f32x4*)pp, q1 = *(const f32x4*)(pp + (size_t)8192 * 256), q2 = *(const f32x4*)(pp + (size_t)2 * 8192 * 256), q3 = *(const f32x4*)(pp + (size_t)3 * 8192 * 256), bb = pbsum;
                f32x4 h = ((q0 + q1) + (q2 + q3)) + bb;
#pragma unroll
                for (int i = 0; i < 4; ++i) h[i] = silu_f(h[i]);
                float s = 0.f;
#pragma unroll
                for (int k4 = 0; k4 < 64; ++k4) { const float h0 = __uint_as_float(__builtin_amdgcn_readlane(__float_as_uint(h[0]), k4)), h1 = __uint_as_float(__builtin_amdgcn_readlane(__float_as_uint(h[1]), k4)),
                                                              h2 = __uint_as_float(__builtin_amdgcn_readlane(__float_as_uint(h[2]), k4)), h3 = __uint_as_float(__builtin_amdgcn_readlane(__float_as_uint(h[3]), k4));
                    s += h0 * wp[(4 * k4) * 64] + h1 * wp[(4 * k4 + 1) * 64] + h2 * wp[(4 * k4 + 2) * 64] + h3 * wp[(4 * k4 + 3) * 64]; }
                (kv ? VC : KC)[(size_t)row * 64 + lane] = ((row & 511) == 511) ? (bf16_t)0 : f2bf(s); }
            __syncthreads();
            SEAM(base + 7);
        }
        if (SITE(10) && IN(base + 8)) {
            WSB(); PTR_ACT(); const int* pos = (const int*)a.in[2]; const float* swa_sinks = (const float*)a.in[13]; bf16_t* MKV = (bf16_t*)(ws + WS_MKV); bf16_t* KC = (bf16_t*)(ws + WS_KC); bf16_t* VC = (bf16_t*)(ws + WS_VC);
            const int2* pmm = (const int2*)(ws + WS_PMM); const int2* cpmm = pmm + 128; const int* cpos = (const int*)(ws + WS_CPOS);
            STAGE_LUT();
            const att::Ptrs P{PROJ, QKV, MKV, KC, VC, ATT, pos, cpos, pmm, cpmm, swa_sinks, 2 * pr + 1};
            unsigned* head = ctl + CW_Q + (pr * 2 + 1) * 512 + a.li * 16;
            Q_INIT();
            for (;;) { int u, xq; Q_NEXT(head, 384, u, xq); if (u < 0) break;
                if (u < 256) { const int bg = xq + 8 * (u >> 7); if (MK_UNITS & 8) att::unit_nsa((LAS char*)lds, P, bg >> 1, bg & 1, 127 - (u & 127), tid, lane, wid); }
                else { const int v = u - 256, bh = xq + 8 * (v >> 5); if (MK_UNITS & 2) att::unit_mem((LAS char*)lds, P, bh >> 2, bh & 3, v & 31, PO, O_QMEM, O_GMEM, 1024, 512, tid, lane, wid); } }
            SEAM(base + 8);
        }
        if (SITE(11) && IN(base + 9)) {
            WSB(); PTR_STATS(); PTR_ACT(); bf16_t* WOUTO = (bf16_t*)(ws + WS_WOUTO);
            pg8::Gemm g{ATT, WOUTO + (size_t)pr * DM * DM, DM, DM * 2, DM * 2, 128, 0}; pg8::StaticOrder SO; SO.init(T / 256, DM / 256, G, bx);
            pg8::EpiStore E{Y, nullptr, ssqy, DM};
            pg8::gemm_phase<pg8::EpiStore, pg8::StaticOrder, true, true>(lds, g, SO, E, wid);
            SEAM(base + 9);
        }
        if (SITE(12) && IN(base + 10)) { WSB(); PTR_STATS(); PTR_ACT(); const float* norm_post = (const float*)a.in[5]; RESID(2 * pr + 1, (const float*)out, pr == 0); SEAM(base + 10); }
    }
}

extern "C" void kernel_launch(void* const* d_in, const int* in_sizes, int n_in, void* d_out, int out_size, void* d_ws, size_t ws_size, hipStream_t stream) {
    static int ready = 0;
    if (ready == 0) {
        if (n_in != 23 || ws_size < WS_END) { fprintf(stderr, "kernel_launch: unexpected problem (n_in %d, ws %zu)\n", n_in, ws_size); ready = -1; return; }
        if (hipFuncSetAttribute((const void*)mega, hipFuncAttributeMaxDynamicSharedMemorySize, LDS_BYTES) != hipSuccess) { fprintf(stderr, "kernel_launch: hipFuncSetAttribute failed\n"); ready = -1; return; }
        int nb = 0, dev = 0, ncu = 0;
        if (hipOccupancyMaxActiveBlocksPerMultiprocessor(&nb, (const void*)mega, NWAVES * 64, LDS_BYTES) != hipSuccess) nb = 0;
        if (hipGetDevice(&dev) != hipSuccess || hipDeviceGetAttribute(&ncu, hipDeviceAttributeMultiprocessorCount, dev) != hipSuccess) ncu = 0;
        (void)hipGetLastError();
        ready = ((long)nb * ncu >= 256) ? 1 : 2;
    }
    if (ready < 0) return;
    (void)hipMemsetAsync((char*)d_ws + WS_CTL, 0, CTL_BYTES, stream);
    Args a{};
    for (int i = 0; i < 23; ++i) a.in[i] = d_in[i];
    a.out = (float*)d_out; a.ws = (unsigned char*)d_ws;
    const int grid = 256;
#if MK_PER_PHASE
    for (int p = 0; p < N_PHASES; ++p) { a.ph_lo = p; a.ph_hi = p + 1; hipLaunchKernelGGL(mega, dim3(grid), dim3(NWAVES * 64), LDS_BYTES, stream, a); }
#elif defined(MK_PROBE)
    a.ph_lo = 0; a.ph_hi = MK_PROBE + 1; a.li = 0; hipLaunchKernelGGL(mega, dim3(grid), dim3(NWAVES * 64), LDS_BYTES, stream, a);
    a.ph_lo = MK_PROBE; a.ph_hi = MK_PROBE + 1; a.li = 1; hipLaunchKernelGGL(mega, dim3(grid), dim3(NWAVES * 64), LDS_BYTES, stream, a);
    if (MK_PROBE + 1 < N_PHASES) { a.ph_lo = MK_PROBE + 1; a.ph_hi = N_PHASES; a.li = 2; hipLaunchKernelGGL(mega, dim3(grid), dim3(NWAVES * 64), LDS_BYTES, stream, a); }
#else
    if (ready == 1) { a.ph_lo = 0; a.ph_hi = N_PHASES; hipLaunchKernelGGL(mega, dim3(grid), dim3(NWAVES * 64), LDS_BYTES, stream, a); }
    else for (int p = 0; p < N_PHASES; ++p) { a.ph_lo = p; a.ph_hi = p + 1; hipLaunchKernelGGL(mega, dim3(grid), dim3(NWAVES * 64), LDS_BYTES, stream, a); }
#endif
}
```

```cpp
#include <hip/hip_runtime.h>
#include <stdint.h>
#include <stdio.h>

#ifndef MK_PER_PHASE
#define MK_PER_PHASE 0
#endif
#define LAS __attribute__((address_space(3)))
typedef unsigned short bf16_t;
typedef short bf16x8 __attribute__((ext_vector_type(8)));
typedef short s16x4 __attribute__((ext_vector_type(4)));
typedef float f32x16 __attribute__((ext_vector_type(16)));
typedef float f32x4 __attribute__((ext_vector_type(4)));
typedef float f32x2 __attribute__((ext_vector_type(2)));
typedef unsigned u32x4 __attribute__((ext_vector_type(4)));
typedef unsigned u32x2 __attribute__((ext_vector_type(2)));

constexpr int DM = 1024, NB = 8, S = 8192, T = NB * S, MEML = 256;
constexpr int PE = 3328, PO = 3072, QKVW = 1792;
constexpr float EPS = 1e-6f;
constexpr float LOG2E = 1.4426950408889634f;
constexpr float NEG = -1e30f;
constexpr int E_CQ = 0, E_CKV = 256, E_KSWA = 384, E_VSWA = 512, E_KPE = 640, E_GMLA = 768, E_QSWA = 1280, E_GSWA = 1792, E_QMEM = 2304, E_GMEM = 2816;
constexpr int O_Q = 0, O_KCMP = 512, O_VCMP = 640, O_KSLC = 768, O_VSLC = 896, O_KWIN = 1024, O_VWIN = 1152, O_GL = 1280, O_GNSA = 1536, O_QMEM = 2048, O_GMEM = 2560;

constexpr size_t MiB = 1u << 20;
constexpr size_t WS_CTL = 0, CTL_BYTES = 1 * MiB;
constexpr size_t WS_SSQX = 1 * MiB, WS_SSQQ = WS_SSQX + 256 * 1024, WS_SSQKV = WS_SSQQ + 256 * 1024, WS_SSQY = WS_SSQKV + 256 * 1024;
constexpr size_t WS_RSTDM = 2 * MiB;
constexpr size_t WS_PMM = 2 * MiB + 65536;
constexpr size_t WS_CPOS = 2 * MiB + 131072;
constexpr size_t WS_ROPE = 3 * MiB;
constexpr size_t WS_LUT = 4 * MiB;
constexpr size_t WS_PB = 4 * MiB + 65536;
constexpr size_t WS_WINE = 8 * MiB, WS_WINO = 21 * MiB, WS_WOUTE = 33 * MiB, WS_WOUTO = 39 * MiB, WS_WMKV = 43 * MiB, WS_WUP = 51 * MiB  , WS_WC1 = 54 * MiB;
constexpr size_t WS_MEMB = 58 * MiB, WS_MKV = 62 * MiB, WS_KC = 78 * MiB, WS_VC = 79 * MiB, WS_HC = 80 * MiB;
static_assert(WS_WUP + (size_t)2 * 1792 * 384 * 2 <= WS_WC1 && WS_WC1 + (size_t)4 * 256 * 2048 * 2 <= WS_MEMB && WS_HC + (size_t)2 * 8192 * 256 * 2 <= 88 * MiB, "workspace map");
constexpr size_t WS_SSQY16 = 90 * MiB, WS_SSQQ4 = 94 * MiB, WS_SSQKV4 = 95 * MiB;
constexpr size_t WS_A = 96 * MiB;
constexpr size_t WS_B = 288 * MiB;
constexpr size_t WS_C = 704 * MiB;
constexpr size_t WS_END = 928 * MiB;
constexpr int CW_BAR = 4096;
constexpr int CW_Q = 16384;

__device__ __forceinline__ float bf2f(bf16_t v) { return __uint_as_float(((unsigned)v) << 16); }
__device__ __forceinline__ bf16_t f2bf(float f) { unsigned u = __float_as_uint(f); return (bf16_t)((u + 0x7fffu + ((u >> 16) & 1u)) >> 16); }
__device__ __forceinline__ unsigned pk2(float lo, float hi) { typedef __bf16 bf2 __attribute__((ext_vector_type(2))); f32x2 v = {lo, hi}; return __builtin_bit_cast(unsigned, __builtin_convertvector(v, bf2)); }
__device__ __forceinline__ float silu_f(float v) { return v * __builtin_amdgcn_rcpf(1.f + __builtin_amdgcn_exp2f(-LOG2E * v)); }
__device__ __forceinline__ float sigm_f(float v) { return __builtin_amdgcn_rcpf(1.f + __builtin_amdgcn_exp2f(-LOG2E * v)); }
__device__ __forceinline__ int crow(int r, int hi) { return (r & 3) + 8 * (r >> 2) + 4 * hi; }
__device__ __forceinline__ float wave_sum(float v) {
#pragma unroll
    for (int o = 1; o < 64; o <<= 1) v += __shfl_xor(v, o);
    return v;
}
namespace pg8 {
#define PG8_LAS __attribute__((address_space(3)))
typedef unsigned short bf16_t;
typedef short bf16x8 __attribute__((ext_vector_type(8)));
typedef float f32x4 __attribute__((ext_vector_type(4)));
typedef unsigned u32x4 __attribute__((ext_vector_type(4)));
constexpr int BM = 256, BK = 64, HALF = 128, HTB = HALF * BK * 2  , STAGE_BYTES = 8 * HTB, NXCD = 8, WGM = 8;

__host__ __device__ __forceinline__ int lds_byte(int r, int c) { const int st = (r >> 4) * 2 + (c >> 5), rr = r & 15, cc = c & 31, ob = rr * 64 + cc * 2; return st * 1024 + (ob ^ (((ob >> 9) & 1) << 5)); }
__host__ __device__ __forceinline__ void stage_rc(int b, int& R, int& C) { const int st = b / 1024, sb = b % 1024, swz = sb ^ (((sb >> 9) & 1) << 5); R = (st >> 1) * 16 + swz / 64; C = (st & 1) * 32 + (swz % 64) / 2; }
__host__ __device__ __forceinline__ int perm32(int rho) { const int n = rho >> 4, i = rho & 15; return 8 * (i >> 2) + 4 * n + (i & 3); }

struct Unit { int pm, pn; };
struct Gemm { const bf16_t* A; const bf16_t* Bt; int K; int lda2, ldb2, kstepA, amode; };
__device__ __forceinline__ const char* a_tile(const Gemm& g, int pm) { if (g.amode == 0) return (const char*)g.A + (size_t)pm * 256 * g.lda2;
    const int kv = pm >> 7, kq = (pm >> 5) & 3, p32 = pm & 31, bg = p32 >> 1, b = bg >> 1, gg = bg & 1, half = p32 & 1;
    return (const char*)g.A + ((size_t)(b * 8192 + 4096 * half + 8 * kq) * 3072 + gg * 64 + kv * 128) * 2; }
__device__ __forceinline__ const char* b_tile(const Gemm& g, int pm, int pn) { if (g.amode == 0) return (const char*)g.Bt + (size_t)pn * 256 * g.ldb2;
    const int kv = pm >> 7, kq = (pm >> 5) & 3; return (const char*)g.Bt + ((size_t)kv * 256 * 2048 + kq * 512) * 2; }

struct StaticOrder {
    int nM, nN, nwg, G, c;
    __host__ __device__ void init(int nM_, int nN_, int G_, int c_) { nM = nM_; nN = nN_; nwg = nM * nN; G = G_; c = c_; }
    __host__ __device__ bool next(int i, Unit& u) const {
        const long L = (long)i * G + c; if (L >= nwg) return false;
        int wgid = (int)L; { const int q = nwg / NXCD, r = nwg % NXCD, xcd = wgid % NXCD, off = wgid / NXCD; wgid = (xcd < r ? xcd * (q + 1) : r * (q + 1) + (xcd - r) * q) + off; }
        const int nig = WGM * nN, gid = wgid / nig, fm = gid * WGM, gsz = (nM - fm) < WGM ? (nM - fm) : WGM;
        u.pm = fm + ((wgid % nig) % gsz); u.pn = (wgid % nig) / gsz; return true;
    }
    __device__ __forceinline__ void a_ready(const Unit&) const {}
    __device__ __forceinline__ void done(const Unit&) const {}
};

__device__ __forceinline__ unsigned cvt_pk_bf16(float lo, float hi) { unsigned r; asm volatile("v_cvt_pk_bf16_f32 %0, %1, %2" : "=v"(r) : "v"(lo), "v"(hi)); return r; }
template <class Epi, class Sched, bool ALIGN_EPI = false, bool SP2 = false>
__device__ __forceinline__ void gemm_phase(PG8_LAS unsigned char* lds, const Gemm g, const Sched& S, const Epi& E, const int wid) {
    unsigned ones_ = ~0u; asm volatile("" : "+s"(ones_)); const int lane = (int)__builtin_amdgcn_mbcnt_hi(ones_, __builtin_amdgcn_mbcnt_lo(ones_, 0u));
    const int tid = wid * 64 + lane, wr = wid >> 2, wc = wid & 3, fr = lane & 15, fq = lane >> 4;
    const int K = g.K, nt = K / BK;
    unsigned voffA[2], voffB[2];
#pragma unroll
    for (int i = 0; i < 2; ++i) { int R, C; stage_rc(tid * 16 + i * 8192, R, C); const int Rb = Epi::PERM ? ((R & ~31) + perm32(R & 31)) : R;
        voffA[i] = (unsigned)(R * g.lda2 + C * 2); voffB[i] = (unsigned)(Rb * g.ldb2 + C * 2); }
    const size_t kstepA = (size_t)g.kstepA, kstepB = (size_t)(BK * 2);
    const size_t hstepA = (size_t)HALF * g.lda2, hstepB = (size_t)HALF * g.ldb2;

    const unsigned ldsw = (unsigned)wid * 1024u;
    const int aoff = lds_byte(wr * 64 + fr, fq * 8), boff = lds_byte(wc * 32 + fr, fq * 8);
#define PG8_SA(b, h) (((b) * 2 + (h)) * HTB)
#define PG8_SB(b, h) ((4 + (b) * 2 + (h)) * HTB)
#define PG8_STAGE(bufoff, gbase, voff) do { _Pragma("unroll") for (int _i = 0; _i < 2; ++_i) \
        __builtin_amdgcn_global_load_lds((const unsigned*)((const char*)(gbase) + (voff)[_i]), (PG8_LAS unsigned*)(lds + (bufoff) + ldsw + _i * 8192), 16, 0, 0); } while (0)
#define PG8_LDA(dst, b, h) do { _Pragma("unroll") for (int m = 0; m < 4; ++m) _Pragma("unroll") for (int k = 0; k < 2; ++k) dst[m][k] = *(const PG8_LAS bf16x8*)(lds + PG8_SA(b, h) + aoff + m * 2048 + k * 1024); } while (0)
#define PG8_LDB(dst, b, h) do { _Pragma("unroll") for (int n = 0; n < 2; ++n) _Pragma("unroll") for (int k = 0; k < 2; ++k) dst[n][k] = *(const PG8_LAS bf16x8*)(lds + PG8_SB(b, h) + boff + n * 2048 + k * 1024); } while (0)
#define PG8_MMA(ai, bj, At, Bt) do { __builtin_amdgcn_s_setprio(1); _Pragma("unroll") for (int m = 0; m < 4; ++m) _Pragma("unroll") for (int n = 0; n < 2; ++n) _Pragma("unroll") for (int k = 0; k < 2; ++k) \
        acc[ai][bj][m][n] = __builtin_amdgcn_mfma_f32_16x16x32_bf16(Bt[n][k], At[m][k], acc[ai][bj][m][n], 0, 0, 0); __builtin_amdgcn_s_setprio(0); } while (0)
#define PG8_WAIT_V(n) asm volatile("s_waitcnt vmcnt(" #n ")" ::: "memory")
#define PG8_WAIT_L(n) asm volatile("s_waitcnt lgkmcnt(" #n ")" ::: "memory")
#define PG8_BAR __builtin_amdgcn_s_barrier()
#define PG8_SCHED __builtin_amdgcn_sched_barrier(0)
    Unit cur, nxt; int ui = 0;
    if (!S.next(0, cur)) return;
    f32x4 acc[2][2][4][2];
#pragma unroll
    for (int a = 0; a < 2; ++a)
#pragma unroll
        for (int b = 0; b < 2; ++b)
#pragma unroll
            for (int m = 0; m < 4; ++m)
#pragma unroll
                for (int n = 0; n < 2; ++n) acc[a][b][m][n] = (f32x4){0.f, 0.f, 0.f, 0.f};
    bf16x8 At[4][2], B0[2][2], B1[2][2];
    const char* cA = a_tile(g, cur.pm); const char* cB = b_tile(g, cur.pm, cur.pn);
    S.a_ready(cur);
    if constexpr (SP2) {
        PG8_STAGE(PG8_SB(0, 0), cB, voffB); PG8_STAGE(PG8_SB(0, 1), cB + hstepB, voffB); PG8_STAGE(PG8_SA(0, 0), cA, voffA); PG8_STAGE(PG8_SA(0, 1), cA + hstepA, voffA);
        if (wr == 1) PG8_BAR;
        PG8_WAIT_V(2); PG8_BAR;
        PG8_STAGE(PG8_SB(1, 0), cB + kstepB, voffB); PG8_STAGE(PG8_SA(1, 0), cA + kstepA, voffA); PG8_STAGE(PG8_SB(1, 1), cB + hstepB + kstepB, voffB);
        PG8_WAIT_V(6); PG8_BAR;
    } else {
        PG8_STAGE(PG8_SB(0, 0), cB, voffB); PG8_STAGE(PG8_SA(0, 0), cA, voffA); PG8_STAGE(PG8_SB(0, 1), cB + hstepB, voffB); PG8_STAGE(PG8_SA(0, 1), cA + hstepA, voffA);
        if (wr == 1) PG8_BAR;
        PG8_WAIT_V(4); PG8_BAR;
        PG8_STAGE(PG8_SB(1, 0), cB + kstepB, voffB); PG8_STAGE(PG8_SA(1, 0), cA + kstepA, voffA); PG8_STAGE(PG8_SB(1, 1), cB + hstepB + kstepB, voffB);
        PG8_WAIT_V(6); PG8_BAR;
    }
    for (;;) {
        const bool has_next = S.next(ui + 1, nxt);
        const char* nA = has_next ? a_tile(g, nxt.pm) : cA; const char* nB = has_next ? b_tile(g, nxt.pm, nxt.pn) : cB;
#pragma unroll 1
        for (int t = 0; t < nt; t += 2) {
            const bool last = (t == nt - 2);
            const char* a1 = cA + (size_t)(t + 1) * kstepA;
            const char* a2 = last ? nA : cA + (size_t)(t + 2) * kstepA; const char* b2 = last ? nB : cB + (size_t)(t + 2) * kstepB;
            const char* a3 = a2 + kstepA; const char* b3 = b2 + kstepB;
            if (last && has_next) S.a_ready(nxt);
            if constexpr (SP2) {
            PG8_LDB(B0, 0, 0); PG8_LDB(B1, 0, 1); PG8_SCHED; PG8_LDA(At, 0, 0); PG8_STAGE(PG8_SA(1, 1), a1 + hstepA, voffA);
            PG8_WAIT_V(8); PG8_WAIT_L(0); PG8_BAR; PG8_MMA(0, 0, At, B0); PG8_MMA(0, 1, At, B1); PG8_BAR; PG8_SCHED;
            PG8_LDA(At, 0, 1); PG8_STAGE(PG8_SB(0, 0), b2, voffB); PG8_STAGE(PG8_SB(0, 1), b2 + hstepB, voffB); PG8_STAGE(PG8_SA(0, 0), a2, voffA);
            PG8_WAIT_V(8); PG8_WAIT_L(0); PG8_BAR; PG8_MMA(1, 0, At, B0); PG8_MMA(1, 1, At, B1); PG8_BAR; PG8_SCHED;
            PG8_LDB(B0, 1, 0); PG8_LDB(B1, 1, 1); PG8_SCHED; PG8_LDA(At, 1, 0); PG8_STAGE(PG8_SA(0, 1), a2 + hstepA, voffA);
            PG8_WAIT_V(8); PG8_WAIT_L(0); PG8_BAR; PG8_MMA(0, 0, At, B0); PG8_MMA(0, 1, At, B1); PG8_BAR; PG8_SCHED;
            PG8_LDA(At, 1, 1); PG8_STAGE(PG8_SB(1, 0), b3, voffB); PG8_STAGE(PG8_SB(1, 1), b3 + hstepB, voffB); PG8_STAGE(PG8_SA(1, 0), a3, voffA);
            PG8_WAIT_V(8); PG8_WAIT_L(0); PG8_BAR; PG8_MMA(1, 0, At, B0); PG8_MMA(1, 1, At, B1); PG8_BAR; PG8_SCHED;
            } else {
            PG8_LDB(B0, 0, 0); PG8_SCHED; PG8_LDA(At, 0, 0); PG8_STAGE(PG8_SA(1, 1), a1 + hstepA, voffA);
            PG8_WAIT_L(8); PG8_BAR; PG8_WAIT_L(0); PG8_MMA(0, 0, At, B0); PG8_BAR; PG8_SCHED;
            PG8_LDB(B1, 0, 1); PG8_STAGE(PG8_SB(0, 0), b2, voffB);
            PG8_BAR; PG8_WAIT_L(0); PG8_MMA(0, 1, At, B1); PG8_BAR;
            PG8_LDA(At, 0, 1); PG8_STAGE(PG8_SA(0, 0), a2, voffA);
            PG8_BAR; PG8_WAIT_L(0); PG8_MMA(1, 0, At, B0); PG8_BAR; PG8_SCHED;
            PG8_STAGE(PG8_SB(0, 1), b2 + hstepB, voffB);
            PG8_WAIT_V(6); PG8_BAR; PG8_MMA(1, 1, At, B1); PG8_BAR;
            PG8_LDB(B0, 1, 0); PG8_SCHED; PG8_LDA(At, 1, 0); PG8_STAGE(PG8_SA(0, 1), a2 + hstepA, voffA);
            PG8_WAIT_L(8); PG8_BAR; PG8_WAIT_L(0); PG8_MMA(0, 0, At, B0); PG8_BAR; PG8_SCHED;
            PG8_LDB(B1, 1, 1); PG8_STAGE(PG8_SB(1, 0), b3, voffB);
            PG8_BAR; PG8_WAIT_L(0); PG8_MMA(0, 1, At, B1); PG8_BAR;
            PG8_LDA(At, 1, 1); PG8_STAGE(PG8_SA(1, 0), a3, voffA);
            PG8_BAR; PG8_WAIT_L(0); PG8_MMA(1, 0, At, B0); PG8_BAR; PG8_SCHED;
            PG8_STAGE(PG8_SB(1, 1), b3 + hstepB, voffB);
            PG8_WAIT_V(6); PG8_BAR; PG8_MMA(1, 1, At, B1); PG8_BAR;
            }
        }
        if constexpr (ALIGN_EPI) { if (wr == 0) PG8_BAR; }
        if constexpr (!Epi::AFTER_DRAIN) { unsigned on2_ = ~0u; asm volatile("" : "+s"(on2_)); const int l2_ = (int)__builtin_amdgcn_mbcnt_hi(on2_, __builtin_amdgcn_mbcnt_lo(on2_, 0u));
            E(acc, cur, wr, wc, l2_ & 15, l2_ >> 4); S.done(cur); }
        if (!has_next) break;
#pragma unroll
        for (int a = 0; a < 2; ++a)
#pragma unroll
            for (int b = 0; b < 2; ++b)
#pragma unroll
                for (int m = 0; m < 4; ++m)
#pragma unroll
                    for (int n = 0; n < 2; ++n) acc[a][b][m][n] = (f32x4){0.f, 0.f, 0.f, 0.f};
        cur = nxt; cA = nA; cB = nB; ++ui;
        if constexpr (ALIGN_EPI) { if (wr == 1) PG8_BAR; }
    }
    PG8_WAIT_V(0);
    if constexpr (!ALIGN_EPI) { if (wr == 0) PG8_BAR; }
    PG8_BAR;
    if constexpr (Epi::AFTER_DRAIN) { E.fused(acc, cur, wr, wc, fr, fq, lds, wid, lane); S.done(cur); }
#undef PG8_SA
#undef PG8_SB
#undef PG8_STAGE
#undef PG8_LDA
#undef PG8_LDB
#undef PG8_MMA
#undef PG8_WAIT_V
#undef PG8_WAIT_L
#undef PG8_BAR
#undef PG8_SCHED
}
}
namespace pg8 {
struct EpiWin {
    static constexpr bool PERM = true, AFTER_DRAIN = false; static constexpr int NST = 16;
    bf16_t* P; const float* ssqx; const float2* rope; float* ssqq; float* ssqkv; int ld, odd;
    __device__ __forceinline__ void operator()(const f32x4 (&acc)[2][2][4][2], const Unit& u, int wr, int wc, int fr, int fq) const {
        const int row0 = u.pm * BM + wr * 64 + fr, cw = u.pn * BM + wc * 32;
        float sx[2][4];
#pragma unroll
        for (int ai = 0; ai < 2; ++ai)
#pragma unroll
            for (int m = 0; m < 4; ++m) sx[ai][m] = ssqx[row0 + ai * HALF + m * 16];
#pragma unroll
        for (int ai = 0; ai < 2; ++ai)
#pragma unroll
            for (int m = 0; m < 4; ++m) {
                const int row = row0 + ai * HALF + m * 16; const float rs = rsqrtf(sx[ai][m] * (1.f / DM) + EPS);
                float sq = 0.f;
#pragma unroll
                for (int bj = 0; bj < 2; ++bj) {
                    const int cg = cw + bj * HALF, c = cg + 8 * fq;
                    f32x4 v0 = acc[ai][bj][m][0] * rs, v1 = acc[ai][bj][m][1] * rs;
                    if (!odd) {
                        if (cg < E_KSWA) sq += (v0[0] * v0[0] + v0[1] * v0[1]) + (v0[2] * v0[2] + v0[3] * v0[3]) + (v1[0] * v1[0] + v1[1] * v1[1]) + (v1[2] * v1[2] + v1[3] * v1[3]);
                        if (cg == E_KPE) { const float2* cs = rope + (size_t)(row & (S - 1)) * 16 + 4 * fq; const float2 c0 = cs[0], c1 = cs[1], c2 = cs[2], c3 = cs[3];
                            const f32x4 a = v0, b = v1;
                            v0[0] = a[0] * c0.x - a[1] * c0.y; v0[1] = a[1] * c0.x + a[0] * c0.y; v0[2] = a[2] * c1.x - a[3] * c1.y; v0[3] = a[3] * c1.x + a[2] * c1.y;
                            v1[0] = b[0] * c2.x - b[1] * c2.y; v1[1] = b[1] * c2.x + b[0] * c2.y; v1[2] = b[2] * c3.x - b[3] * c3.y; v1[3] = b[3] * c3.x + b[2] * c3.y; }
                        else if ((cg >= E_GMLA && cg < E_QSWA) || (cg >= E_GSWA && cg < E_QMEM) || cg >= E_GMEM) {
#pragma unroll
                            for (int i = 0; i < 4; ++i) { v0[i] = silu_f(v0[i]); v1[i] = silu_f(v1[i]); } }
                    } else {
                        if (cg == O_GL) { if (fq < 3) {
#pragma unroll
                            for (int i = 0; i < 4; ++i) { v0[i] = sigm_f(v0[i]); v1[i] = sigm_f(v1[i]); } } }
                        else if ((cg >= O_GNSA && cg < O_QMEM) || cg >= O_GMEM) {
#pragma unroll
                            for (int i = 0; i < 4; ++i) { v0[i] = silu_f(v0[i]); v1[i] = silu_f(v1[i]); } }
                    }
                    u32x4 w; w.x = pk2(v0[0], v0[1]); w.y = pk2(v0[2], v0[3]); w.z = pk2(v1[0], v1[1]); w.w = pk2(v1[2], v1[3]);
                    *(u32x4*)(P + (size_t)row * ld + c) = w;
                }
                if (!odd && u.pn < 2) {
                    sq += __shfl_xor(sq, 16); sq += __shfl_xor(sq, 32);
                    if (fq == 0) (u.pn == 0 ? ssqq : ssqkv)[(size_t)row * 4 + wc] = sq;
                }
            }
    }
};
struct EpiUp {
    static constexpr bool PERM = true, AFTER_DRAIN = false; static constexpr int NST = 0;
    bf16_t* O; const float* ssqq; const float* ssqkv; const float2* rope;
    __device__ __forceinline__ void operator()(const f32x4 (&acc)[2][2][4][2], const Unit& u, int wr, int wc, int fr, int fq) const {
        const int row0 = u.pm * BM + wr * 64 + fr, c0 = u.pn * BM + wc * 32 + 8 * fq; const bool isq = u.pn < 3;
        float sx[2][4];
#pragma unroll
        for (int ai = 0; ai < 2; ++ai)
#pragma unroll
            for (int m = 0; m < 4; ++m) { const f32x4 pq4 = *(const f32x4*)((isq ? ssqq : ssqkv) + (size_t)(row0 + ai * HALF + m * 16) * 4); sx[ai][m] = (pq4[0] + pq4[1]) + (pq4[2] + pq4[3]); }
#pragma unroll
        for (int ai = 0; ai < 2; ++ai)
#pragma unroll
            for (int m = 0; m < 4; ++m) {
                const int row = row0 + ai * HALF + m * 16;
                const float ssum = sx[ai][m];
                const float rs = rsqrtf(ssum * (isq ? (1.f / 256.f) : (1.f / 128.f)) + EPS);
#pragma unroll
                for (int bj = 0; bj < 2; ++bj) {
                    const int c = c0 + bj * HALF; f32x4 v0 = acc[ai][bj][m][0] * rs, v1 = acc[ai][bj][m][1] * rs;
                    if (isq) { const int j = c % 96;
                        if (j >= 64) { const float2* cs = rope + (size_t)(row & (S - 1)) * 16 + ((j - 64) >> 1); const float2 q0 = cs[0], q1 = cs[1], q2 = cs[2], q3 = cs[3];
                            const f32x4 a = v0, b = v1;
                            v0[0] = a[0] * q0.x - a[1] * q0.y; v0[1] = a[1] * q0.x + a[0] * q0.y; v0[2] = a[2] * q1.x - a[3] * q1.y; v0[3] = a[3] * q1.x + a[2] * q1.y;
                            v1[0] = b[0] * q2.x - b[1] * q2.y; v1[1] = b[1] * q2.x + b[0] * q2.y; v1[2] = b[2] * q3.x - b[3] * q3.y; v1[3] = b[3] * q3.x + b[2] * q3.y; } }
                    u32x4 w; w.x = pk2(v0[0], v0[1]); w.y = pk2(v0[2], v0[3]); w.z = pk2(v1[0], v1[1]); w.w = pk2(v1[2], v1[3]);
                    *(u32x4*)(O + (size_t)row * QKVW + c) = w;
                }
                asm volatile("" ::: "memory");
            }
    }
};
struct EpiStore {
    static constexpr bool PERM = true, AFTER_DRAIN = false; static constexpr int NST = 16;
    bf16_t* O; const float* rscale; float* ssq; int ld;
    __device__ __forceinline__ void operator()(const f32x4 (&acc)[2][2][4][2], const Unit& u, int wr, int wc, int fr, int fq) const {
        const int row0 = u.pm * BM + wr * 64 + fr, c0 = u.pn * BM + wc * 32 + 8 * fq;
        float sx[2][4];
#pragma unroll
        for (int ai = 0; ai < 2; ++ai)
#pragma unroll
            for (int m = 0; m < 4; ++m) sx[ai][m] = rscale ? rscale[row0 + ai * HALF + m * 16] : 1.f;
#pragma unroll
        for (int ai = 0; ai < 2; ++ai)
#pragma unroll
            for (int m = 0; m < 4; ++m) {
                const int row = row0 + ai * HALF + m * 16; const float rs = sx[ai][m]; float sq = 0.f;
#pragma unroll
                for (int bj = 0; bj < 2; ++bj) {
                    const f32x4 v0 = acc[ai][bj][m][0] * rs, v1 = acc[ai][bj][m][1] * rs;
                    sq += (v0[0] * v0[0] + v0[1] * v0[1]) + (v0[2] * v0[2] + v0[3] * v0[3]) + (v1[0] * v1[0] + v1[1] * v1[1]) + (v1[2] * v1[2] + v1[3] * v1[3]);
                    u32x4 w; w.x = pk2(v0[0], v0[1]); w.y = pk2(v0[2], v0[3]); w.z = pk2(v1[0], v1[1]); w.w = pk2(v1[2], v1[3]);
                    *(u32x4*)(O + (size_t)row * ld + c0 + bj * HALF) = w;
                }
                if (ssq) { sq += __shfl_xor(sq, 16); sq += __shfl_xor(sq, 32); if (fq == 0) ssq[(size_t)row * 16 + u.pn * 4 + wc] = sq; }
            }
    }
};
struct EpiPart {
    static constexpr bool PERM = true, AFTER_DRAIN = false; static constexpr int NST = 0;
    float* O;
    __device__ __forceinline__ void operator()(const f32x4 (&acc)[2][2][4][2], const Unit& u, int wr, int wc, int fr, int fq) const {
        const int kvq = u.pm >> 5, p32 = u.pm & 31; const int row0 = p32 * BM + wr * 64 + fr, c0 = wc * 32 + 8 * fq; float* base = O + (size_t)kvq * 8192 * 256;
#pragma unroll
        for (int ai = 0; ai < 2; ++ai)
#pragma unroll
            for (int m = 0; m < 4; ++m) { float* rp = base + (size_t)(row0 + ai * HALF + m * 16) * 256 + c0;
#pragma unroll
                for (int bj = 0; bj < 2; ++bj) { *(f32x4*)(rp + bj * HALF) = acc[ai][bj][m][0]; *(f32x4*)(rp + bj * HALF + 4) = acc[ai][bj][m][1]; } }
    }
};
struct EpiC1 {
    static constexpr bool PERM = true, AFTER_DRAIN = false; static constexpr int NST = 0;
    bf16_t* O; const float* pb;
    __device__ __forceinline__ void operator()(const f32x4 (&acc)[2][2][4][2], const Unit& u, int wr, int wc, int fr, int fq) const {
        const int row0 = u.pm * BM + wr * 64 + fr, c0 = wc * 32 + 8 * fq;
#pragma unroll
        for (int ai = 0; ai < 2; ++ai)
#pragma unroll
            for (int m = 0; m < 4; ++m) {
                const int row = row0 + ai * HALF + m * 16;
#pragma unroll
                for (int bj = 0; bj < 2; ++bj) { const int c = c0 + bj * HALF; const f32x4 b0 = *(const f32x4*)(pb + c), b1 = *(const f32x4*)(pb + c + 4);
                    f32x4 v0 = acc[ai][bj][m][0] + b0, v1 = acc[ai][bj][m][1] + b1;
#pragma unroll
                    for (int i = 0; i < 4; ++i) { v0[i] = silu_f(v0[i]); v1[i] = silu_f(v1[i]); }
                    u32x4 w; w.x = pk2(v0[0], v0[1]); w.y = pk2(v0[2], v0[3]); w.z = pk2(v1[0], v1[1]); w.w = pk2(v1[2], v1[3]);
                    *(u32x4*)(O + (size_t)row * 256 + c) = w; }
            }
    }
};
}
#ifndef ATT_PROBE
#define ATT_PROBE 0
#endif
namespace att {
constexpr float SM_THR = 8.f;
constexpr int KSLOT = 17408, VSLOT = 20480, KS0 = 0, VS0 = 3 * KSLOT, KPOS = VS0 + 2 * VSLOT  , IMP = 94208, SELW = IMP + 33024  , SELU = SELW + 1024, LUTO = 128512, ATT_LDS_END = LUTO + 4224;
__device__ __forceinline__ int kslot(int i) { return KS0 + i * KSLOT; }
__device__ __forceinline__ int vslot(int i) { return VS0 + i * VSLOT; }
template <int DQK> struct KPitch { static constexpr int v = DQK * 2 + 16; };
template <int DV> struct VPitch { static constexpr int v = (DV == 64) ? 192 : 320; };
__device__ __forceinline__ s16x4 vtr(const LAS char* p) { typedef short v4s __attribute__((ext_vector_type(4))); return __builtin_bit_cast(s16x4, __builtin_amdgcn_ds_read_tr16_b64_v4i16((LAS v4s*)p)); }
__device__ __forceinline__ float swapmax(float v) { auto rr = __builtin_amdgcn_permlane32_swap(__float_as_uint(v), __float_as_uint(v), false, false); return fmaxf(__uint_as_float(rr[0]), __uint_as_float(rr[1])); }
__device__ __forceinline__ float swapsum(float v) { auto rr = __builtin_amdgcn_permlane32_swap(__float_as_uint(v), __float_as_uint(v), false, false); return __uint_as_float(rr[0]) + __uint_as_float(rr[1]); }

struct Src { const bf16_t* K1; const bf16_t* K2; const bf16_t* V; int kld, kld2, vld; const int* kpos; };
template <int DQK, int DV> struct Stage { u32x4 k[(64 * DQK / 8 + 511) / 512]; u32x4 v[(64 * DV / 8 + 511) / 512]; int kp; };

template <int DQK> __device__ __forceinline__ void kchunk(int tid, int i, int& row, int& ch) {
    if (DQK == 96) { if (i == 0) { row = tid >> 3; ch = tid & 7; } else { row = tid >> 2; ch = 8 + (tid & 3); } }
    else { constexpr int CPRK = DQK / 8; const int c = tid + i * 512; row = c / CPRK; ch = c % CPRK; }
}
template <int DQK, int DV, bool POS>
__device__ __forceinline__ void load_k(Stage<DQK, DV>& st, const Src& s, int kt0, int tid) {
    constexpr int CPRK = DQK / 8, NKC = 64 * CPRK;
    const char* b1 = (const char*)(s.K1 + (size_t)kt0 * s.kld); const char* b2 = (DQK == 96) ? (const char*)(s.K2 + (size_t)kt0 * s.kld2) : b1;
#pragma unroll
    for (int i = 0; i < (NKC + 511) / 512; ++i) { int row, ch; kchunk<DQK>(tid, i, row, ch);
        if (DQK == 96 && i == 1) { if (tid < 256) st.k[i] = *(const u32x4*)(b2 + (unsigned)((row * s.kld2 + (ch - 8) * 8) * 2)); }
        else if (NKC % 512 == 0 || DQK == 96 || tid + i * 512 < NKC) st.k[i] = *(const u32x4*)(b1 + (unsigned)((row * s.kld + ch * 8) * 2)); }
    if (POS) st.kp = (tid < 64) ? *(const int*)((const char*)(s.kpos + kt0) + (unsigned)(tid * 4)) : 0;
}
template <int DQK, int DV>
__device__ __forceinline__ void load_v(Stage<DQK, DV>& st, const Src& s, int kt0, int tid) {
    constexpr int CPRV = DV / 8, NVC = 64 * CPRV;
    const char* bv = (const char*)(s.V + (size_t)kt0 * s.vld);
#pragma unroll
    for (int i = 0; i < NVC / 512; ++i) { const int c = tid + i * 512; const int row = c / CPRV, ch = c % CPRV; st.v[i] = *(const u32x4*)(bv + (unsigned)((row * s.vld + ch * 8) * 2)); }
}
template <int DQK, int DV, bool POS>
__device__ __forceinline__ void store_k(const Stage<DQK, DV>& st, LAS char* lds, int ks, int tid) {
    constexpr int CPRK = DQK / 8, NKC = 64 * CPRK, KP = KPitch<DQK>::v;
    LAS char* kb = lds + kslot(ks);
#pragma unroll
    for (int i = 0; i < (NKC + 511) / 512; ++i) { int row, ch; kchunk<DQK>(tid, i, row, ch);
        if (DQK == 96 && i == 1) { if (tid < 256) *(LAS u32x4*)(kb + row * KP + ch * 16) = st.k[i]; }
        else if (NKC % 512 == 0 || DQK == 96 || tid + i * 512 < NKC) *(LAS u32x4*)(kb + row * KP + ch * 16) = st.k[i]; }
    if (POS) { if (tid < 64) ((LAS int*)(lds + KPOS))[ks * 64 + tid] = st.kp; }
}
template <int DQK, int DV>
__device__ __forceinline__ void store_v(const Stage<DQK, DV>& st, LAS char* lds, int vs, int tid) {
    constexpr int CPRV = DV / 8, NVC = 64 * CPRV, VP = VPitch<DV>::v;
    LAS char* vb = lds + vslot(vs);
#pragma unroll
    for (int i = 0; i < NVC / 512; ++i) { const int c = tid + i * 512; const int row = c / CPRV, ch = c % CPRV; *(LAS u32x4*)(vb + row * VP + ch * 16) = st.v[i]; }
}
template <int DQK, int DV, bool POS>
__device__ __forceinline__ void tile_load(Stage<DQK, DV>& st, const Src& s, int kt0, int tid) { load_k<DQK, DV, POS>(st, s, kt0, tid); load_v<DQK, DV>(st, s, kt0, tid); }
template <int DQK, int DV, bool POS>
__device__ __forceinline__ void tile_store(const Stage<DQK, DV>& st, LAS char* lds, int buf, int tid) { store_k<DQK, DV, POS>(st, lds, buf, tid); store_v<DQK, DV>(st, lds, buf, tid); }

struct Col { int qi; int qlim; int pq; int hcol; };
struct Flags { bool causal, window, bias, selm; };

template <int DQK, int DV, bool DO_PV, bool BIAS, bool WINDOWED>
__device__ __forceinline__ void tile_compute(const LAS char* lds, int buf, int kt0, int mode, bool incl, const Col& col, int W, const bf16x8 (&qf)[DQK / 16], f32x16 (&o)[DV / 32], float& m, float& l,
                                             f32x16& p0, f32x16& p1, int lane) {
    constexpr int KP = KPitch<DQK>::v, VP = VPitch<DV>::v;
    int hi = lane >> 5; asm volatile("" : "+v"(hi));
    const int r32 = lane & 31;
    const LAS char* kb = lds + kslot(buf) + r32 * KP + hi * 16;
    p0 = (f32x16){0}; p1 = (f32x16){0};
#pragma unroll
    for (int st = 0; st < DQK / 16; ++st) {
        const bf16x8 k0 = *(const LAS bf16x8*)(kb + st * 32), k1 = *(const LAS bf16x8*)(kb + 32 * KP + st * 32);
        p0 = __builtin_amdgcn_mfma_f32_32x32x16_bf16(k0, qf[st], p0, 0, 0, 0);
        p1 = __builtin_amdgcn_mfma_f32_32x32x16_bf16(k1, qf[st], p1, 0, 0, 0);
        if ((st & 1) == 1) asm volatile("" ::: "memory");
    }
    float cb = 0.f;
    if (BIAS) {
        const LAS float* lut = (const LAS float*)(lds + LUTO) + col.hcol * 132;
        if (mode == 2) {
            const LAS int* kp = (const LAS int*)(lds + KPOS) + buf * 64 + 4 * hi;
#pragma unroll
            for (int r = 0; r < 16; ++r) { const int ko = (r & 3) + 8 * (r >> 2);
                int d0 = col.pq - kp[ko], d1 = col.pq - kp[ko + 32]; d0 = d0 < 0 ? 0 : (d0 > 128 ? 128 : d0); d1 = d1 < 0 ? 0 : (d1 > 128 ? 128 : d1);
                p0[r] += lut[d0]; p1[r] += lut[d1]; if ((r & 3) == 3) asm volatile("" ::: "memory"); }
        } else cb = lut[128];
    }
    if (mode == 2) {
        const int up = col.qlim - kt0 - 4 * hi; const int lo = WINDOWED ? (col.qi - W - kt0 - 4 * hi) : -1;
#pragma unroll
        for (int r = 0; r < 16; ++r) { const int ko = (r & 3) + 8 * (r >> 2);
            bool v0 = ko <= up, v1 = (ko + 32) <= up;
            if (WINDOWED) { v0 = v0 && (ko > lo); v1 = v1 && ((ko + 32) > lo); }
            p0[r] = v0 ? p0[r] : NEG; p1[r] = v1 ? p1[r] : NEG; }
    }
    float a = fmaxf(fmaxf(p0[0], p0[1]), p1[0]), b = fmaxf(fmaxf(p0[2], p0[3]), p1[1]); a = fmaxf(fmaxf(a, p1[2]), p1[3]);
#pragma unroll
    for (int r = 4; r < 16; r += 4) { a = fmaxf(fmaxf(a, p0[r]), p0[r + 1]); b = fmaxf(fmaxf(b, p0[r + 2]), p0[r + 3]); a = fmaxf(fmaxf(a, p1[r]), p1[r + 1]); b = fmaxf(fmaxf(b, p1[r + 2]), p1[r + 3]); }
    float tmax = swapmax(fmaxf(a, b)) + cb;
    if (!incl) tmax = NEG;
    if (__builtin_amdgcn_ballot_w64(tmax - m > SM_THR) != 0ull) { const float mnew = fmaxf(m, tmax); const float f = __builtin_amdgcn_exp2f(m - mnew); l *= f; m = mnew;
        if (DO_PV) {
#pragma unroll
            for (int bk = 0; bk < DV / 32; ++bk)
#pragma unroll
                for (int r = 0; r < 16; ++r) o[bk][r] *= f; } }
    const float off = (incl && m > -1e29f) ? (cb - m) : NEG;
    float sum = 0.f;
#pragma unroll
    for (int r = 0; r < 16; ++r) { p0[r] = __builtin_amdgcn_exp2f(p0[r] + off); p1[r] = __builtin_amdgcn_exp2f(p1[r] + off); sum += p0[r] + p1[r]; }
    l += sum;
    if (DO_PV) {
        const LAS char* vb = lds + vslot(buf) + (4 * hi + ((lane & 15) >> 2)) * VP + (((lane >> 4) & 1) * 16 + (lane & 3) * 4) * 2;
#pragma unroll
        for (int sub = 0; sub < 2; ++sub)
#pragma unroll
            for (int ks = 0; ks < 2; ++ks) {
                u32x4 pw;
                if (sub == 0) { pw.x = pk2(p0[8 * ks], p0[8 * ks + 1]); pw.y = pk2(p0[8 * ks + 2], p0[8 * ks + 3]); pw.z = pk2(p0[8 * ks + 4], p0[8 * ks + 5]); pw.w = pk2(p0[8 * ks + 6], p0[8 * ks + 7]); }
                else          { pw.x = pk2(p1[8 * ks], p1[8 * ks + 1]); pw.y = pk2(p1[8 * ks + 2], p1[8 * ks + 3]); pw.z = pk2(p1[8 * ks + 4], p1[8 * ks + 5]); pw.w = pk2(p1[8 * ks + 6], p1[8 * ks + 7]); }
                const bf16x8 pb = __builtin_bit_cast(bf16x8, pw);
#pragma unroll
                for (int bk = 0; bk < DV / 32; ++bk) {
                    const LAS char* vp = vb + (32 * sub + 16 * ks) * VP + bk * 64;
                    const s16x4 lo = vtr(vp), hi4 = vtr(vp + 8 * VP);
                    const bf16x8 va = __builtin_shufflevector(lo, hi4, 0, 1, 2, 3, 4, 5, 6, 7);
                    o[bk] = __builtin_amdgcn_mfma_f32_32x32x16_bf16(va, pb, o[bk], 0, 0, 0);
                }
                asm volatile("" ::: "memory");
            }
    }
}

template <int DQK> __device__ __forceinline__ void qk_part(const LAS char* lds, int ks, const bf16x8 (&qf)[DQK / 16], f32x16& s0, f32x16& s1, int lane) {
    constexpr int KP = KPitch<DQK>::v; const LAS char* kb = lds + kslot(ks) + (lane & 31) * KP + (lane >> 5) * 16;
    s0 = (f32x16){0}; s1 = (f32x16){0};
#pragma unroll
    for (int st = 0; st < DQK / 16; ++st) {
        const bf16x8 k0 = *(const LAS bf16x8*)(kb + st * 32), k1 = *(const LAS bf16x8*)(kb + 32 * KP + st * 32);
        s0 = __builtin_amdgcn_mfma_f32_32x32x16_bf16(k0, qf[st], s0, 0, 0, 0);
        s1 = __builtin_amdgcn_mfma_f32_32x32x16_bf16(k1, qf[st], s1, 0, 0, 0);
    }
}
template <int DQK> __device__ __forceinline__ void load_kf(const LAS char* lds, int ks, bf16x8 (&kf)[DQK / 16][2], int lane) {
    constexpr int KP = KPitch<DQK>::v; const LAS char* kb = lds + kslot(ks) + (lane & 31) * KP + (lane >> 5) * 16;
#pragma unroll
    for (int st = 0; st < DQK / 16; ++st) { kf[st][0] = *(const LAS bf16x8*)(kb + st * 32); kf[st][1] = *(const LAS bf16x8*)(kb + 32 * KP + st * 32); }
}
template <int DQK> __device__ __forceinline__ void qk_pipe(const LAS char* lds, int ks, const bf16x8 (&qf)[DQK / 16], f32x16& n0, f32x16& n1, int lane) {
    constexpr int KP = KPitch<DQK>::v, NG = DQK / 8; const LAS char* kb = lds + kslot(ks) + (lane & 31) * KP + (lane >> 5) * 16;
    n0 = (f32x16){0}; n1 = (f32x16){0};
    bf16x8 f0 = *(const LAS bf16x8*)(kb), f1 = *(const LAS bf16x8*)(kb + 32 * KP), f2 = *(const LAS bf16x8*)(kb + 32);
#pragma unroll
    for (int g = 0; g < NG; ++g) {
        bf16x8 f3 = f2;
        if (g + 3 < NG) f3 = *(const LAS bf16x8*)(kb + ((g + 3) & 1) * 32 * KP + ((g + 3) >> 1) * 32);
        if (g & 1) n1 = __builtin_amdgcn_mfma_f32_32x32x16_bf16(f0, qf[g >> 1], n1, 0, 0, 0); else n0 = __builtin_amdgcn_mfma_f32_32x32x16_bf16(f0, qf[g >> 1], n0, 0, 0, 0);
        __builtin_amdgcn_sched_barrier(0);
        f0 = f1; f1 = f2; f2 = f3;
    }
}
template <int DV, bool BIAS, bool WINDOWED, bool DO_PV>
__device__ __forceinline__ float max_part(const LAS char* lds, int ks, int kt0, int mode, bool incl, const Col& col, int W, f32x16 (&o)[DV / 32], float& m, float& l, f32x16& p0, f32x16& p1, int lane) {
    int hi = lane >> 5; asm volatile("" : "+v"(hi));
    float cb = 0.f;
    if (BIAS) {
        const LAS float* lut = (const LAS float*)(lds + LUTO) + col.hcol * 132;
        if (mode == 2) {
            const LAS int* kp = (const LAS int*)(lds + KPOS) + ks * 64 + 4 * hi;
#pragma unroll
            for (int r = 0; r < 16; ++r) { const int ko = (r & 3) + 8 * (r >> 2);
                int d0 = col.pq - kp[ko], d1 = col.pq - kp[ko + 32]; d0 = d0 < 0 ? 0 : (d0 > 128 ? 128 : d0); d1 = d1 < 0 ? 0 : (d1 > 128 ? 128 : d1);
                p0[r] += lut[d0]; p1[r] += lut[d1]; if ((r & 3) == 3) asm volatile("" ::: "memory"); }
        } else cb = lut[128];
    }
    if (mode == 2) {
        const int up = col.qlim - kt0 - 4 * hi; const int lo = WINDOWED ? (col.qi - W - kt0 - 4 * hi) : -1;
#pragma unroll
        for (int r = 0; r < 16; ++r) { const int ko = (r & 3) + 8 * (r >> 2);
            bool v0 = ko <= up, v1 = (ko + 32) <= up;
            if (WINDOWED) { v0 = v0 && (ko > lo); v1 = v1 && ((ko + 32) > lo); }
            p0[r] = v0 ? p0[r] : NEG; p1[r] = v1 ? p1[r] : NEG; }
    }
    float a = fmaxf(fmaxf(p0[0], p0[1]), p1[0]), b = fmaxf(fmaxf(p0[2], p0[3]), p1[1]); a = fmaxf(fmaxf(a, p1[2]), p1[3]);
#pragma unroll
    for (int r = 4; r < 16; r += 4) { a = fmaxf(fmaxf(a, p0[r]), p0[r + 1]); b = fmaxf(fmaxf(b, p0[r + 2]), p0[r + 3]); a = fmaxf(fmaxf(a, p1[r]), p1[r + 1]); b = fmaxf(fmaxf(b, p1[r + 2]), p1[r + 3]); }
    float tmax = swapmax(fmaxf(a, b)) + cb;
    if (!incl) tmax = NEG;
    if (__builtin_amdgcn_ballot_w64(tmax - m > SM_THR) != 0ull) { const float mnew = fmaxf(m, tmax); const float f = __builtin_amdgcn_exp2f(m - mnew); l *= f; m = mnew;
        if (DO_PV) {
#pragma unroll
            for (int bk = 0; bk < DV / 32; ++bk)
#pragma unroll
                for (int r = 0; r < 16; ++r) o[bk][r] *= f; } }
    return (incl && m > -1e29f) ? (cb - m) : NEG;
}
template <int DQK, bool WITHQK>
__device__ __forceinline__ void exp_part(const bf16x8 (&kf)[DQK / 16][2], const bf16x8 (&qf)[DQK / 16], float off, float& l, f32x16& p0, f32x16& p1, f32x16& n0, f32x16& n1, int lane) {
    if (WITHQK) { n0 = (f32x16){0}; n1 = (f32x16){0};
#pragma unroll
        for (int st = 0; st < DQK / 16; ++st) { n0 = __builtin_amdgcn_mfma_f32_32x32x16_bf16(kf[st][0], qf[st], n0, 0, 0, 0); n1 = __builtin_amdgcn_mfma_f32_32x32x16_bf16(kf[st][1], qf[st], n1, 0, 0, 0); }
#if ATT_PROBE == 1
        { f32x16 x0 = (f32x16){0}, x1 = (f32x16){0};
#pragma unroll
          for (int st = 0; st < DQK / 16; ++st) { x0 = __builtin_amdgcn_mfma_f32_32x32x16_bf16(kf[st][0], qf[st], x0, 0, 0, 0); x1 = __builtin_amdgcn_mfma_f32_32x32x16_bf16(kf[st][1], qf[st], x1, 0, 0, 0); }
          asm volatile("" :: "v"(x0), "v"(x1)); }
#endif
    }
#if ATT_PROBE == 7
    { float j0 = p0[0], j1 = p0[1], j2 = p0[2], j3 = p0[3], j4 = p0[4], j5 = p0[5], j6 = p0[6], j7 = p0[7];
#pragma unroll
      for (int i = 0; i < 8; ++i) { j0 = j0 * 1.0001f + 0.5f; j1 = j1 * 1.0001f + 0.5f; j2 = j2 * 1.0001f + 0.5f; j3 = j3 * 1.0001f + 0.5f; j4 = j4 * 1.0001f + 0.5f; j5 = j5 * 1.0001f + 0.5f; j6 = j6 * 1.0001f + 0.5f; j7 = j7 * 1.0001f + 0.5f; }
      asm volatile("" :: "v"(j0), "v"(j1), "v"(j2), "v"(j3), "v"(j4), "v"(j5), "v"(j6), "v"(j7)); }
#endif
#if ATT_PROBE == 8
    { float e0 = __builtin_amdgcn_exp2f(p0[0] + 1.f), e1 = __builtin_amdgcn_exp2f(p0[1] + 1.f), e2 = __builtin_amdgcn_exp2f(p0[2] + 1.f), e3 = __builtin_amdgcn_exp2f(p0[3] + 1.f);
      float e4 = __builtin_amdgcn_exp2f(p0[4] + 1.f), e5 = __builtin_amdgcn_exp2f(p0[5] + 1.f), e6 = __builtin_amdgcn_exp2f(p0[6] + 1.f), e7 = __builtin_amdgcn_exp2f(p0[7] + 1.f);
      float f0 = __builtin_amdgcn_exp2f(p1[0] + 1.f), f1 = __builtin_amdgcn_exp2f(p1[1] + 1.f), f2 = __builtin_amdgcn_exp2f(p1[2] + 1.f), f3 = __builtin_amdgcn_exp2f(p1[3] + 1.f);
      float f4 = __builtin_amdgcn_exp2f(p1[4] + 1.f), f5 = __builtin_amdgcn_exp2f(p1[5] + 1.f), f6 = __builtin_amdgcn_exp2f(p1[6] + 1.f), f7 = __builtin_amdgcn_exp2f(p1[7] + 1.f);
      asm volatile("" :: "v"(e0), "v"(e1), "v"(e2), "v"(e3), "v"(e4), "v"(e5), "v"(e6), "v"(e7), "v"(f0), "v"(f1), "v"(f2), "v"(f3), "v"(f4), "v"(f5), "v"(f6), "v"(f7)); }
#endif
    float sum = 0.f;
#if ATT_PROBE == 2
    { float junk = 0.f;
#pragma unroll
      for (int r = 0; r < 16; ++r) { junk += __builtin_amdgcn_exp2f(p0[r] + off + 1.f) + __builtin_amdgcn_exp2f(p1[r] + off + 1.f); }
      asm volatile("" :: "v"(junk)); }
#endif
#pragma unroll
    for (int r = 0; r < 16; ++r) { p0[r] = __builtin_amdgcn_exp2f(p0[r] + off); p1[r] = __builtin_amdgcn_exp2f(p1[r] + off); sum += p0[r] + p1[r]; }
    l += sum;
}
template <int DQK> __device__ __forceinline__ void exp_part_qk(const bf16x8 (&kf)[DQK / 16][2], const bf16x8 (&qf)[DQK / 16], f32x16& n0, f32x16& n1) {
    n0 = (f32x16){0}; n1 = (f32x16){0};
#pragma unroll
    for (int st = 0; st < DQK / 16; ++st) { n0 = __builtin_amdgcn_mfma_f32_32x32x16_bf16(kf[st][0], qf[st], n0, 0, 0, 0); n1 = __builtin_amdgcn_mfma_f32_32x32x16_bf16(kf[st][1], qf[st], n1, 0, 0, 0); }
}
template <int DV> __device__ __forceinline__ void pv_part(const LAS char* lds, int vs, const f32x16& p0, const f32x16& p1, f32x16 (&o)[DV / 32], int lane) {
    constexpr int VP = VPitch<DV>::v; const int hi = lane >> 5;
    const LAS char* vb = lds + vslot(vs) + (4 * hi + ((lane & 15) >> 2)) * VP + (((lane >> 4) & 1) * 16 + (lane & 3) * 4) * 2;
#pragma unroll
    for (int sub = 0; sub < 2; ++sub)
#pragma unroll
        for (int ks = 0; ks < 2; ++ks) {
            u32x4 pw;
            if (sub == 0) { pw.x = pk2(p0[8 * ks], p0[8 * ks + 1]); pw.y = pk2(p0[8 * ks + 2], p0[8 * ks + 3]); pw.z = pk2(p0[8 * ks + 4], p0[8 * ks + 5]); pw.w = pk2(p0[8 * ks + 6], p0[8 * ks + 7]); }
            else          { pw.x = pk2(p1[8 * ks], p1[8 * ks + 1]); pw.y = pk2(p1[8 * ks + 2], p1[8 * ks + 3]); pw.z = pk2(p1[8 * ks + 4], p1[8 * ks + 5]); pw.w = pk2(p1[8 * ks + 6], p1[8 * ks + 7]); }
            const bf16x8 pb = __builtin_bit_cast(bf16x8, pw);
#pragma unroll
            for (int bk = 0; bk < DV / 32; ++bk) {
                const LAS char* vp = vb + (32 * sub + 16 * ks) * VP + bk * 64;
                const s16x4 lo = vtr(vp), hi4 = vtr(vp + 8 * VP);
                const bf16x8 va = __builtin_shufflevector(lo, hi4, 0, 1, 2, 3, 4, 5, 6, 7);
                o[bk] = __builtin_amdgcn_mfma_f32_32x32x16_bf16(va, pb, o[bk], 0, 0, 0);
            }
        }
}
}
namespace att {
struct Wv { int l0, l1, q0, q1; };
__device__ __forceinline__ float headsum4(float w) {
    const float t = w + __builtin_bit_cast(float, __builtin_amdgcn_update_dpp(0, __builtin_bit_cast(int, w), 0x128  , 0xf, 0xf, false));
    auto rr = __builtin_amdgcn_permlane16_swap(__float_as_uint(t), __float_as_uint(t), false, false);
    return __uint_as_float(rr[0]) + __uint_as_float(rr[1]);
}
template <int CTRL> __device__ __forceinline__ float dppf(float v) { return __builtin_bit_cast(float, __builtin_amdgcn_update_dpp(0, __builtin_bit_cast(int, v), CTRL, 0xf, 0xf, false)); }
template <int CTRL> __device__ __forceinline__ int dppi(int v) { return __builtin_amdgcn_update_dpp(0, v, CTRL, 0xf, 0xf, false); }
__device__ __forceinline__ void imp_add(LAS char* lds, const f32x16& p0, const f32x16& p1, int kt0, float il, int ql, int lane) {
    LAS float* imp = (LAS float*)(lds + IMP); const int r32 = lane & 31, hi = lane >> 5;
#pragma unroll
    for (int sub = 0; sub < 2; ++sub)
#pragma unroll
        for (int g4 = 0; g4 < 4; ++g4) {
            const float a0 = sub ? p1[4 * g4] : p0[4 * g4], a1 = sub ? p1[4 * g4 + 1] : p0[4 * g4 + 1], a2 = sub ? p1[4 * g4 + 2] : p0[4 * g4 + 2], a3 = sub ? p1[4 * g4 + 3] : p0[4 * g4 + 3];
            float w = (a0 + a1 + a2 + 0.5f * a3) * il, w2 = 0.5f * a3 * il;
            w = headsum4(w); w2 = headsum4(w2);
            const int j = (kt0 + 32 * sub + 8 * g4 + 4 * hi) >> 2;
            if ((r32 >> 3) == 0) { atomicAdd((float*)(imp + ql * 129 + j), w); if (j + 1 < 128) atomicAdd((float*)(imp + ql * 129 + j + 1), w2); }
        }
}
template <int DQK, int DV, bool DO_PV, bool BIAS, bool WINDOWED, bool CAUSAL, bool SELM, bool IMPT = false>
__device__ __forceinline__ void run_branch(LAS char* lds, const Src& src, int t_lo, int t_hi, const Wv& wv, const Col& col, int W, int pmq, const int2* pmm,
                                           const unsigned long long sello, const unsigned long long selhi, const bf16x8 (&qf)[DQK / 16], f32x16 (&o)[DV / 32], float& m, float& l, f32x16& pA0, f32x16& pA1, int tid_in, int lane_in, float imp_il = 0.f, int imp_ql = 0) {
    int lane = lane_in; asm volatile("" : "+v"(lane));
    const int tid = (tid_in & ~63) | lane;
    unsigned long long ulo = 0ull, uhi = 0ull;
    if (SELM) { const LAS unsigned* selu = (const LAS unsigned*)(lds + SELU);
        ulo = (unsigned long long)(unsigned)__builtin_amdgcn_readfirstlane((int)selu[0]) | ((unsigned long long)(unsigned)__builtin_amdgcn_readfirstlane((int)selu[1]) << 32);
        uhi = (unsigned long long)(unsigned)__builtin_amdgcn_readfirstlane((int)selu[2]) | ((unsigned long long)(unsigned)__builtin_amdgcn_readfirstlane((int)selu[3]) << 32); }
    auto want = [&](int t) -> bool { return !SELM || ((((t < 64) ? ulo : uhi) >> (t & 63)) & 1ull); };
    auto nxt = [&](int t) -> int { ++t; while (t <= t_hi && !want(t)) ++t; return t; };
    auto classify = [&](int t) -> int { const int kt0 = t * 64; bool skip = false, allv = true;
        if (CAUSAL) { skip = kt0 > wv.l1; allv = (kt0 + 63 <= wv.l0); }
        if (WINDOWED) { skip = skip || (wv.q0 - (kt0 + 63) >= W); allv = allv && (wv.q1 - kt0 < W); }
        bool farb = true; if (BIAS) { farb = (pmq - pmm[t].y >= 128); }
        return (!skip && allv && farb) ? 1 : 2; };
    auto inc = [&](int t) -> bool { if (!SELM) return true; const unsigned long long w = (t < 64) ? sello : selhi; return (w >> (t & 63)) & 1ull; };
    int tc = t_lo - 1; tc = nxt(tc);
    if (tc > t_hi) return;
    int tn = nxt(tc), tnn = (tn <= t_hi) ? nxt(tn) : tn;
    Stage<DQK, DV> st;
    {   Stage<DQK, DV> s2;
        tile_load<DQK, DV, BIAS>(st, src, tc * 64, tid); if (tn <= t_hi) load_k<DQK, DV, BIAS>(s2, src, tn * 64, tid);
        tile_store<DQK, DV, BIAS>(st, lds, 0, tid); if (tn <= t_hi) store_k<DQK, DV, BIAS>(s2, lds, 1, tid); }
    __syncthreads();
    int ik = 0, iv = 0;
    f32x16 pB0, pB1;
    qk_part<DQK>(lds, 0, qf, pA0, pA1, lane);
#define ATT_STEP(c0, c1, n0, n1) { \
        const bool hasNN = tnn <= t_hi; \
        if (ATT_PROBE == 3) { Stage<DQK, DV> sj; if (hasNN) load_k<DQK, DV, BIAS>(sj, src, tnn * 64, tid); load_v<DQK, DV>(sj, src, tn * 64, tid); asm volatile("" :: "v"(sj.k[0]), "v"(sj.v[0])); } \
        if (hasNN) load_k<DQK, DV, BIAS>(st, src, tnn * 64, tid); \
        load_v<DQK, DV>(st, src, tn * 64, tid); \
        const int ikn = (ik == 2) ? 0 : ik + 1, iknn = (ikn == 2) ? 0 : ikn + 1; \
        if (!SELM || __builtin_amdgcn_ballot_w64(inc(tn)) != 0ull) qk_pipe<DQK>(lds, ikn, qf, n0, n1, lane);     \
        const bool incl_ = inc(tc); \
        if (!SELM || __builtin_amdgcn_ballot_w64(incl_) != 0ull) {     \
            const float off = max_part<DV, BIAS, WINDOWED, DO_PV>(lds, ik, tc * 64, classify(tc), incl_, col, W, o, m, l, c0, c1, lane); \
            bf16x8 kfd_[DQK / 16][2]; exp_part<DQK, false>(kfd_, qf, off, l, c0, c1, n0, n1, lane); \
            if (IMPT) imp_add(lds, c0, c1, tc * 64, imp_il, imp_ql, lane); \
            if (DO_PV) pv_part<DV>(lds, iv, c0, c1, o, lane); } \
        if (hasNN) store_k<DQK, DV, BIAS>(st, lds, iknn, tid); \
        store_v<DQK, DV>(st, lds, iv ^ 1, tid); \
        __syncthreads(); if (ATT_PROBE == 4) { __syncthreads(); __syncthreads(); } \
        tc = tn; tn = tnn; tnn = hasNN ? nxt(tnn) : tnn; ik = ikn; iv ^= 1; }
    bool inA = true;
    while (tn <= t_hi) {
        ATT_STEP(pA0, pA1, pB0, pB1)
        if (!(tn <= t_hi)) { inA = false; break; }
        ATT_STEP(pB0, pB1, pA0, pA1)
    }
#undef ATT_STEP
    if (!inA) { pA0 = pB0; pA1 = pB1; }
    {   const bool inclf = inc(tc);
        if (!SELM || __builtin_amdgcn_ballot_w64(inclf) != 0ull) {
            const float off = max_part<DV, BIAS, WINDOWED, DO_PV>(lds, ik, tc * 64, classify(tc), inclf, col, W, o, m, l, pA0, pA1, lane);
            bf16x8 kfd[DQK / 16][2]; exp_part<DQK, false>(kfd, qf, off, l, pA0, pA1, pB0, pB1, lane);
            if (IMPT) imp_add(lds, pA0, pA1, tc * 64, imp_il, imp_ql, lane);
            if (DO_PV) pv_part<DV>(lds, iv, pA0, pA1, o, lane); } }
    __syncthreads();
}
template <int DQK, int DV, bool DO_PV, bool BIAS, bool WINDOWED, bool CAUSAL, bool SELM>
__device__ __forceinline__ void run_branch_np(LAS char* lds, const Src& src, int t_lo, int t_hi, const Wv& wv, const Col& col, int W, int pmq, const int2* pmm,
                                           const unsigned long long sello, const unsigned long long selhi, const bf16x8 (&qf)[DQK / 16], f32x16 (&o)[DV / 32], float& m, float& l, f32x16& p0, f32x16& p1, int tid, int lane) {
    const LAS unsigned* selu = (const LAS unsigned*)(lds + SELU);
    auto want = [&](int t) -> bool { return !SELM || ((selu[t >> 5] >> (t & 31)) & 1u); };
    int t = t_lo; while (t <= t_hi && !want(t)) ++t;
    if (t > t_hi) return;
    Stage<DQK, DV> st;
    tile_load<DQK, DV, BIAS>(st, src, t * 64, tid); tile_store<DQK, DV, BIAS>(st, lds, 0, tid); __syncthreads();
    int buf = 0;
    for (;;) {
        int tn = t + 1; while (tn <= t_hi && !want(tn)) ++tn;
        const bool has = tn <= t_hi;
        if (has) tile_load<DQK, DV, BIAS>(st, src, tn * 64, tid);
        const int kt0 = t * 64;
        int mode;
        {   bool skip = false, allv = true;
            if (CAUSAL) { skip = kt0 > wv.l1; allv = (kt0 + 63 <= wv.l0); }
            if (WINDOWED) { skip = skip || (wv.q0 - (kt0 + 63) >= W); allv = allv && (wv.q1 - kt0 < W); }
            bool farb = true; if (BIAS) { farb = (pmq - pmm[t].y >= 128); }
            mode = skip ? 0 : ((allv && farb) ? 1 : 2); }
        bool incl = true;
        if (SELM) { const unsigned long long w = (t < 64) ? sello : selhi; incl = (w >> (t & 63)) & 1ull; }
        if (mode) tile_compute<DQK, DV, DO_PV, BIAS, WINDOWED>(lds, buf, kt0, mode, incl, col, W, qf, o, m, l, p0, p1, lane);
        if (has) tile_store<DQK, DV, BIAS>(st, lds, buf ^ 1, tid);
        __syncthreads();
        if (!has) break;
        t = tn; buf ^= 1;
    }
}
template <int DV> __device__ __forceinline__ void store_col(const f32x16 (&o)[DV / 32], float inv, const bf16_t* gate, bf16_t* out, int hi) {
    u32x2 gw[DV / 32][4];
#pragma unroll
    for (int bk = 0; bk < DV / 32; ++bk)
#pragma unroll
        for (int g4 = 0; g4 < 4; ++g4) gw[bk][g4] = *(const u32x2*)(gate + 32 * bk + 8 * g4 + 4 * hi);
#pragma unroll
    for (int bk = 0; bk < DV / 32; ++bk)
#pragma unroll
        for (int gp = 0; gp < 2; ++gp) {
            u32x2 w[2];
#pragma unroll
            for (int e = 0; e < 2; ++e) { const int g4 = 2 * gp + e; const u32x2 g = gw[bk][g4];
                const float g0 = __uint_as_float(g.x << 16), g1 = __uint_as_float(g.x & 0xffff0000u), g2 = __uint_as_float(g.y << 16), g3 = __uint_as_float(g.y & 0xffff0000u);
                w[e].x = pk2(o[bk][4 * g4] * inv * g0, o[bk][4 * g4 + 1] * inv * g1); w[e].y = pk2(o[bk][4 * g4 + 2] * inv * g2, o[bk][4 * g4 + 3] * inv * g3); }
            auto sx = __builtin_amdgcn_permlane32_swap(w[0].x, w[1].x, false, false); auto sy = __builtin_amdgcn_permlane32_swap(w[0].y, w[1].y, false, false);
            u32x4 v; v.x = sx[0]; v.y = sy[0]; v.z = sx[1]; v.w = sy[1];
            *(u32x4*)(out + 32 * bk + 8 * (2 * gp + hi)) = v; }
}
struct Ptrs { const bf16_t* PROJ; const bf16_t* QKV; const bf16_t* MKV; const bf16_t* KC; const bf16_t* VC; bf16_t* ATT; const int* pos; const int* cpos; const int2* pmm; const int2* cpmm; const float* sinks; int layer; };

__device__ __forceinline__ void unit_mla(LAS char* lds, const Ptrs& P, int b, int h, int qb, int tid_in, int lane_in, int wid) {
    int lane = lane_in; asm volatile("" : "+v"(lane)); const int tid = (tid_in & ~63) | lane;
    const int r32 = lane & 31, hi = lane >> 5, q0 = qb * 256, wq0 = q0 + 32 * wid, qi = wq0 + r32; const size_t row = (size_t)b * S + qi;
    bf16x8 qf[6]; { const bf16_t* qp = P.QKV + row * QKVW + h * 96 + 8 * hi;
#pragma unroll
        for (int s = 0; s < 6; ++s) qf[s] = *(const bf16x8*)(qp + 16 * s); }
    const Src src{P.QKV + (size_t)b * S * QKVW + 768 + h * 128, P.PROJ + (size_t)b * S * PE + E_KPE, P.QKV + (size_t)b * S * QKVW + 768 + h * 128 + 64, QKVW, PE, QKVW, nullptr};
    const Wv wv{wq0, wq0 + 31, wq0, wq0 + 31}; const Col col{qi, qi, 0, 0};
    f32x16 o[2] = {{0}, {0}}, p0, p1; float m = NEG, l = 0.f;
    run_branch<96, 64, true, false, false, true, false>(lds, src, 0, (q0 + 255) >> 6, wv, col, 0, 0, nullptr, 0ull, 0ull, qf, o, m, l, p0, p1, tid, lane);
    l = swapsum(l);
    store_col<64>(o, 1.f / fmaxf(l, 1e-30f), P.PROJ + row * PE + E_GMLA + h * 64, P.ATT + row * 1536 + h * 64, hi);
}
__device__ __forceinline__ void sm_update(f32x16& p0, f32x16& p1, bool near, int up, float& m, float& l, f32x16 (&o)[2]) {
    if (near) {
#pragma unroll
        for (int r = 0; r < 16; ++r) { const int ko = (r & 3) + 8 * (r >> 2); p0[r] = (ko <= up) ? p0[r] : NEG; p1[r] = (ko + 32 <= up) ? p1[r] : NEG; } }
    float a = fmaxf(fmaxf(p0[0], p0[1]), p1[0]), b = fmaxf(fmaxf(p0[2], p0[3]), p1[1]); a = fmaxf(fmaxf(a, p1[2]), p1[3]);
#pragma unroll
    for (int r = 4; r < 16; r += 4) { a = fmaxf(fmaxf(a, p0[r]), p0[r + 1]); b = fmaxf(fmaxf(b, p0[r + 2]), p0[r + 3]); a = fmaxf(fmaxf(a, p1[r]), p1[r + 1]); b = fmaxf(fmaxf(b, p1[r + 2]), p1[r + 3]); }
    const float tmax = swapmax(fmaxf(a, b));
    if (__builtin_amdgcn_ballot_w64(tmax - m > SM_THR) != 0ull) { const float mnew = fmaxf(m, tmax); const float f = __builtin_amdgcn_exp2f(m - mnew); l *= f; m = mnew;
#pragma unroll
        for (int bk = 0; bk < 2; ++bk)
#pragma unroll
            for (int r = 0; r < 16; ++r) o[bk][r] *= f; }
    const float off = (m > -1e29f) ? -m : NEG; float sum = 0.f;
#pragma unroll
    for (int r = 0; r < 16; ++r) { p0[r] = __builtin_amdgcn_exp2f(p0[r] + off); p1[r] = __builtin_amdgcn_exp2f(p1[r] + off); sum += p0[r] + p1[r]; }
    l += sum;
}
__device__ __forceinline__ void unit_mla2(LAS char* lds, const Ptrs& P, int b, int h, int qb2, int tid_in, int lane_in, int wid) {
    int lane = lane_in; asm volatile("" : "+v"(lane)); const int tid = (tid_in & ~63) | lane;
    constexpr int KP = KPitch<96>::v, VP = VPitch<64>::v;
    const int r32 = lane & 31, hi = lane >> 5, q0 = qb2 * 512, wq0 = q0 + 64 * wid, qiA = wq0 + r32, qiB = qiA + 32; const size_t rowA = (size_t)b * S + qiA;
    bf16x8 qfA[6], qfB[6]; { const bf16_t* qp = P.QKV + rowA * QKVW + h * 96 + 8 * hi;
#pragma unroll
        for (int s = 0; s < 6; ++s) { qfA[s] = *(const bf16x8*)(qp + 16 * s); qfB[s] = *(const bf16x8*)(qp + (size_t)32 * QKVW + 16 * s); } }
    const Src src{P.QKV + (size_t)b * S * QKVW + 768 + h * 128, P.PROJ + (size_t)b * S * PE + E_KPE, P.QKV + (size_t)b * S * QKVW + 768 + h * 128 + 64, QKVW, PE, QKVW, nullptr};
    f32x16 oA[2] = {{0}, {0}}, oB[2] = {{0}, {0}}; float mA = NEG, lA = 0.f, mB = NEG, lB = 0.f;
    const int T = (q0 + 511) >> 6, tw = wq0 >> 6;
    Stage<96, 64> st;
    tile_load<96, 64, false>(st, src, 0, tid); tile_store<96, 64, false>(st, lds, 0, tid); __syncthreads();
    int buf = 0;
    for (int t = 0; t <= T; ++t) {
        const bool has = t < T;
        if (has) tile_load<96, 64, false>(st, src, (t + 1) * 64, tid);
        if (t <= tw) {
            const int kt0 = t * 64; const bool near = (t == tw);
            int hl = lane >> 5; asm volatile("" : "+v"(hl));
            const LAS char* kb = lds + kslot(buf) + r32 * KP + hl * 16;
            f32x16 pA0 = {0}, pA1 = {0}, pB0 = {0}, pB1 = {0};
            __builtin_amdgcn_s_setprio(1);
#pragma unroll
            for (int s = 0; s < 6; ++s) { const bf16x8 k0 = *(const LAS bf16x8*)(kb + s * 32), k1 = *(const LAS bf16x8*)(kb + 32 * KP + s * 32);
                pA0 = __builtin_amdgcn_mfma_f32_32x32x16_bf16(k0, qfA[s], pA0, 0, 0, 0); pB0 = __builtin_amdgcn_mfma_f32_32x32x16_bf16(k0, qfB[s], pB0, 0, 0, 0);
                pA1 = __builtin_amdgcn_mfma_f32_32x32x16_bf16(k1, qfA[s], pA1, 0, 0, 0); pB1 = __builtin_amdgcn_mfma_f32_32x32x16_bf16(k1, qfB[s], pB1, 0, 0, 0); }
            __builtin_amdgcn_s_setprio(0);
            sm_update(pA0, pA1, near, qiA - kt0 - 4 * hl, mA, lA, oA);
            sm_update(pB0, pB1, near, qiB - kt0 - 4 * hl, mB, lB, oB);
            __builtin_amdgcn_s_setprio(1);
            const LAS char* vb = lds + vslot(buf) + (4 * hl + ((lane & 15) >> 2)) * VP + (((lane >> 4) & 1) * 16 + (lane & 3) * 4) * 2;
#pragma unroll
            for (int sub = 0; sub < 2; ++sub)
#pragma unroll
                for (int ks = 0; ks < 2; ++ks) {
                    u32x4 wa, wb;
                    if (sub == 0) { wa.x = pk2(pA0[8 * ks], pA0[8 * ks + 1]); wa.y = pk2(pA0[8 * ks + 2], pA0[8 * ks + 3]); wa.z = pk2(pA0[8 * ks + 4], pA0[8 * ks + 5]); wa.w = pk2(pA0[8 * ks + 6], pA0[8 * ks + 7]);
                                    wb.x = pk2(pB0[8 * ks], pB0[8 * ks + 1]); wb.y = pk2(pB0[8 * ks + 2], pB0[8 * ks + 3]); wb.z = pk2(pB0[8 * ks + 4], pB0[8 * ks + 5]); wb.w = pk2(pB0[8 * ks + 6], pB0[8 * ks + 7]); }
                    else          { wa.x = pk2(pA1[8 * ks], pA1[8 * ks + 1]); wa.y = pk2(pA1[8 * ks + 2], pA1[8 * ks + 3]); wa.z = pk2(pA1[8 * ks + 4], pA1[8 * ks + 5]); wa.w = pk2(pA1[8 * ks + 6], pA1[8 * ks + 7]);
                                    wb.x = pk2(pB1[8 * ks], pB1[8 * ks + 1]); wb.y = pk2(pB1[8 * ks + 2], pB1[8 * ks + 3]); wb.z = pk2(pB1[8 * ks + 4], pB1[8 * ks + 5]); wb.w = pk2(pB1[8 * ks + 6], pB1[8 * ks + 7]); }
                    const bf16x8 pa = __builtin_bit_cast(bf16x8, wa), pb = __builtin_bit_cast(bf16x8, wb);
#pragma unroll
                    for (int bk = 0; bk < 2; ++bk) { const LAS char* vp = vb + (32 * sub + 16 * ks) * VP + bk * 64;
                        const s16x4 lo = vtr(vp), hi4 = vtr(vp + 8 * VP); const bf16x8 va = __builtin_shufflevector(lo, hi4, 0, 1, 2, 3, 4, 5, 6, 7);
                        oA[bk] = __builtin_amdgcn_mfma_f32_32x32x16_bf16(va, pa, oA[bk], 0, 0, 0); oB[bk] = __builtin_amdgcn_mfma_f32_32x32x16_bf16(va, pb, oB[bk], 0, 0, 0); }
                }
            __builtin_amdgcn_s_setprio(0);
        }
        if (has) tile_store<96, 64, false>(st, lds, buf ^ 1, tid);
        __syncthreads();
        buf ^= 1;
    }
    lA = swapsum(lA); lB = swapsum(lB);
    store_col<64>(oA, 1.f / fmaxf(lA, 1e-30f), P.PROJ + rowA * PE + E_GMLA + h * 64, P.ATT + rowA * 1536 + h * 64, hi);
    store_col<64>(oB, 1.f / fmaxf(lB, 1e-30f), P.PROJ + (rowA + 32) * PE + E_GMLA + h * 64, P.ATT + (rowA + 32) * 1536 + h * 64, hi);
}
__device__ __forceinline__ void unit_mem(LAS char* lds, const Ptrs& P, int b, int h, int qb, int ld, int qc, int gc, int ldo, int oc, int tid_in, int lane_in, int wid) {
    int lane = lane_in; asm volatile("" : "+v"(lane)); const int tid = (tid_in & ~63) | lane;
    const int r32 = lane & 31, hi = lane >> 5, qi = qb * 256 + 32 * wid + r32; const size_t row = (size_t)b * S + qi;
    bf16x8 qf[8]; { const bf16_t* qp = P.PROJ + row * ld + qc + h * 128 + 8 * hi;
#pragma unroll
        for (int s = 0; s < 8; ++s) qf[s] = *(const bf16x8*)(qp + 16 * s); }
    const bf16_t* kv = P.MKV + (size_t)b * MEML * 4096 + P.layer * 1024 + h * 128;
    const Src src{kv, nullptr, kv + 512, 4096, 0, 4096, nullptr};
    const Wv wv{1 << 30, 1 << 30, qi, qi}; const Col col{qi, 1 << 30, 0, 0};
    f32x16 o[4] = {{0}, {0}, {0}, {0}}, p0, p1; float m = NEG, l = 0.f;
    run_branch_np<128, 128, true, false, false, false, false>(lds, src, 0, 3, wv, col, 0, 0, nullptr, 0ull, 0ull, qf, o, m, l, p0, p1, tid, lane);
    l = swapsum(l);
    store_col<128>(o, 1.f / l, P.PROJ + row * ld + gc + h * 128, P.ATT + row * ldo + oc + h * 128, hi);
}
__device__ __forceinline__ void unit_swa(LAS char* lds, const Ptrs& P, int b, int g, int qblk, int tid_in, int lane_in, int wid) {
    int lane = lane_in; asm volatile("" : "+v"(lane)); const int tid = (tid_in & ~63) | lane;
    const int r32 = lane & 31, hi = lane >> 5, q0 = qblk * 64, wq0 = q0 + 8 * wid, qi = wq0 + (r32 & 7), hc = 4 * g + (r32 >> 3); const size_t row = (size_t)b * S + qi;
    bf16x8 qf[4]; { const bf16_t* qp = P.PROJ + row * PE + E_QSWA + hc * 64 + 8 * hi;
#pragma unroll
        for (int s = 0; s < 4; ++s) qf[s] = *(const bf16x8*)(qp + 16 * s); }
    const Src src{P.PROJ + (size_t)b * S * PE + E_KSWA + g * 64, nullptr, P.PROJ + (size_t)b * S * PE + E_VSWA + g * 64, PE, 0, PE, P.pos};
    const Wv wv{wq0, wq0 + 7, wq0, wq0 + 7}; const Col col{qi, qi, P.pos[qi], hc};
    f32x16 o[2] = {{0}, {0}}, p0, p1; float m = P.sinks[hc] * LOG2E, l = hi ? 0.f : 1.f;
    run_branch<64, 64, true, true, true, true, false>(lds, src, qblk >= 2 ? qblk - 2 : 0, qblk, wv, col, 128, P.pmm[qblk].x, P.pmm, 0ull, 0ull, qf, o, m, l, p0, p1, tid, lane);
    l = swapsum(l);
    store_col<64>(o, 1.f / fmaxf(l, 1e-30f), P.PROJ + row * PE + E_GSWA + hc * 64, P.ATT + row * 1536 + 512 + hc * 64, hi);
}
__device__ __forceinline__ void unit_nsa(LAS char* lds, const Ptrs& P, int b, int g, int cur, int tid_in, int lane_in, int wid) {
    int lane = lane_in; asm volatile("" : "+v"(lane)); const int tid = (tid_in & ~63) | lane;
    const int r32 = lane & 31, hi = lane >> 5, q0 = cur * 64, ql = 8 * wid + (r32 & 7), qi = q0 + ql, hc = 4 * g + (r32 >> 3); const size_t row = (size_t)b * S + qi;
    bf16x8 qf[4]; { const bf16_t* qp = P.PROJ + row * PO + O_Q + hc * 64 + 8 * hi;
#pragma unroll
        for (int s = 0; s < 4; ++s) qf[s] = *(const bf16x8*)(qp + 16 * s); }
    LAS float* imp = (LAS float*)(lds + IMP); LAS unsigned* selws = (LAS unsigned*)(lds + SELW); LAS unsigned* selu = (LAS unsigned*)(lds + SELU);
    for (int i = tid; i < 64 * 129; i += 512) imp[i] = 0.f;
    if (tid < 4) selu[tid] = 0u;
    const int pq = P.pos[qi], pmq = P.pmm[cur].x, wq0 = q0 + 8 * wid;
    f32x16 o[2], p0, p1; unsigned long long sello = 0ull, selhi = 0ull;
#define NSA_GL (P.PROJ + ((size_t)b * S + qi) * PO + O_GL + hc * 3)
    {   const int cl = (qi >= 31) ? ((qi - 31) >> 4) : -1; const int cl0 = (wq0 >= 31) ? ((wq0 - 31) >> 4) : -1, cl1 = (wq0 + 7 >= 31) ? ((wq0 + 7 - 31) >> 4) : -1;
        const int tmax = ((q0 + 63 - 31) >> 4) >> 6;
        const Src src{P.KC + (size_t)(b * 2 + g) * 512 * 64, nullptr, P.VC + (size_t)(b * 2 + g) * 512 * 64, 64, 0, 64, P.cpos};
        const Wv wv{cl0, cl1, wq0, wq0 + 7}; const Col col{qi, cl, pq, hc};
        float m = NEG, l = 0.f; o[0] = (f32x16){0}; o[1] = (f32x16){0};
        run_branch<64, 64, false, true, false, true, false>(lds, src, 0, tmax, wv, col, 0, pmq, P.cpmm, 0ull, 0ull, qf, o, m, l, p0, p1, tid, lane);
        l = swapsum(l); const float il = 1.f / fmaxf(l, 1e-30f);
        {   float l2 = 0.f;
            run_branch<64, 64, true, true, false, true, false, true>(lds, src, 0, tmax, wv, col, 0, pmq, P.cpmm, 0ull, 0ull, qf, o, m, l2, p0, p1, tid, lane, il, ql); }
#pragma unroll
        for (int bk = 0; bk < 2; ++bk)
#pragma unroll
            for (int r = 0; r < 16; ++r) o[bk][r] *= bf2f(NSA_GL[0]) * il;
    }
    {   int lk = lane; asm volatile("" : "+v"(lk)); const int qsel = 8 * wid + (lk >> 3), s = lk & 7; unsigned mk[4] = {0, 0, 0, 0};
        if (cur <= 15) { mk[0] = (cur == 31) ? 0xffffffffu : ((1u << (cur + 1)) - 1u); }
        else {
            float v[16];
#pragma unroll
            for (int t = 0; t < 16; ++t) { const int j = 16 * s + t; v[t] = (j >= 1 && j <= cur - 2) ? imp[qsel * 129 + j] : -1.f; }
            mk[0] = 1u;
            #pragma unroll
            for (int w = 0; w < 4; ++w) { if ((cur >> 5) == w) mk[w] |= 1u << (cur & 31); if (((cur - 1) >> 5) == w) mk[w] |= 1u << ((cur - 1) & 31); }
            for (int rnd = 0; rnd < 13; ++rnd) {
                float best = v[0]; int bi = 0;
#pragma unroll
                for (int t = 1; t < 16; ++t) if (v[t] > best) { best = v[t]; bi = t; }
                int bj = 16 * s + bi;
                { const float ov = dppf<0xB1>(best); const int oj = dppi<0xB1>(bj); if (ov > best || (ov == best && oj < bj)) { best = ov; bj = oj; } }
                { const float ov = dppf<0x4E>(best); const int oj = dppi<0x4E>(bj); if (ov > best || (ov == best && oj < bj)) { best = ov; bj = oj; } }
                { const float ov = dppf<0x141>(best); const int oj = dppi<0x141>(bj); if (ov > best || (ov == best && oj < bj)) { best = ov; bj = oj; } }
                if (best >= 0.f) {
#pragma unroll
                    for (int t = 0; t < 16; ++t) if (16 * s + t == bj) v[t] = -1.f;
#pragma unroll
                    for (int w = 0; w < 4; ++w) if ((bj >> 5) == w) mk[w] |= 1u << (bj & 31);
                }
            }
        }
        if (s == 0) {
#pragma unroll
            for (int w = 0; w < 4; ++w) { selws[qsel * 4 + w] = mk[w]; atomicOr((unsigned*)(selu + w), mk[w]); } }
    }
    __syncthreads();
    sello = (unsigned long long)selws[ql * 4 + 0] | ((unsigned long long)selws[ql * 4 + 1] << 32); selhi = (unsigned long long)selws[ql * 4 + 2] | ((unsigned long long)selws[ql * 4 + 3] << 32);
#define NSA_STASH ((LAS bf16_t*)(lds + IMP) + wid * 2048 + r32 * 64 + 4 * hi)
#pragma unroll
    for (int bk = 0; bk < 2; ++bk)
#pragma unroll
        for (int g4 = 0; g4 < 4; ++g4) { u32x2 w; w.x = pk2(o[bk][4 * g4], o[bk][4 * g4 + 1]); w.y = pk2(o[bk][4 * g4 + 2], o[bk][4 * g4 + 3]); *(LAS u32x2*)(NSA_STASH + 32 * bk + 8 * g4) = w; }
    {   const Src src{P.PROJ + (size_t)b * S * PO + O_KSLC + g * 64, nullptr, P.PROJ + (size_t)b * S * PO + O_VSLC + g * 64, PO, 0, PO, P.pos};
        const Wv wv{wq0, wq0 + 7, wq0, wq0 + 7}; const Col col{qi, qi, pq, hc};
        float m = NEG, l = 0.f; o[0] = (f32x16){0}; o[1] = (f32x16){0};
        run_branch<64, 64, true, true, false, true, true>(lds, src, 0, cur, wv, col, 0, pmq, P.pmm, sello, selhi, qf, o, m, l, p0, p1, tid, lane);
        l = swapsum(l); const float il = bf2f(NSA_GL[1]) / fmaxf(l, 1e-30f);
#pragma unroll
        for (int bk = 0; bk < 2; ++bk)
#pragma unroll
            for (int g4 = 0; g4 < 4; ++g4) { const u32x2 pv = *(const LAS u32x2*)(NSA_STASH + 32 * bk + 8 * g4);
                u32x2 w; w.x = pk2(__uint_as_float(pv.x << 16) + il * o[bk][4 * g4], __uint_as_float(pv.x & 0xffff0000u) + il * o[bk][4 * g4 + 1]);
                w.y = pk2(__uint_as_float(pv.y << 16) + il * o[bk][4 * g4 + 2], __uint_as_float(pv.y & 0xffff0000u) + il * o[bk][4 * g4 + 3]); *(LAS u32x2*)(NSA_STASH + 32 * bk + 8 * g4) = w; }
    }
    {   const Src src{P.PROJ + (size_t)b * S * PO + O_KWIN + g * 64, nullptr, P.PROJ + (size_t)b * S * PO + O_VWIN + g * 64, PO, 0, PO, P.pos};
        const Wv wv{wq0, wq0 + 7, wq0, wq0 + 7}; const Col col{qi, qi, pq, hc};
        float m = NEG, l = 0.f; o[0] = (f32x16){0}; o[1] = (f32x16){0};
        run_branch<64, 64, true, true, true, true, false>(lds, src, cur >= 8 ? cur - 8 : 0, cur, wv, col, 512, pmq, P.pmm, 0ull, 0ull, qf, o, m, l, p0, p1, tid, lane);
        l = swapsum(l); const float il = bf2f(NSA_GL[2]) / fmaxf(l, 1e-30f);
#pragma unroll
        for (int bk = 0; bk < 2; ++bk)
#pragma unroll
            for (int g4 = 0; g4 < 4; ++g4) { const u32x2 pv = *(const LAS u32x2*)(NSA_STASH + 32 * bk + 8 * g4);
                o[bk][4 * g4] = __uint_as_float(pv.x << 16) + il * o[bk][4 * g4]; o[bk][4 * g4 + 1] = __uint_as_float(pv.x & 0xffff0000u) + il * o[bk][4 * g4 + 1];
                o[bk][4 * g4 + 2] = __uint_as_float(pv.y << 16) + il * o[bk][4 * g4 + 2]; o[bk][4 * g4 + 3] = __uint_as_float(pv.y & 0xffff0000u) + il * o[bk][4 * g4 + 3]; }
    }
    store_col<64>(o, 1.f, P.PROJ + ((size_t)b * S + qi) * PO + O_GNSA + hc * 64, P.ATT + ((size_t)b * S + qi) * 1024 + hc * 64, hi);
#undef NSA_GL
#undef NSA_STASH
}
}
#define XB_TMO      128
#define XB_XCNT(j)  (256  + 64 * (j))
#define XB_XSUB(j)  (1280 + 64 * (j))
#define XB_XGEN(j)  (2304 + 64 * (j))
#define XB_TOP      3328
#define XB_TOPGEN   3392
#define XCD_BAR_WORDS 3456
#define XB_SPIN_CAP (1u << 18)
__device__ __forceinline__ unsigned xb_ld(unsigned* p)              { return __hip_atomic_load(p, __ATOMIC_RELAXED, __HIP_MEMORY_SCOPE_AGENT); }
__device__ __forceinline__ unsigned xb_add(unsigned* p, unsigned v) { return __hip_atomic_fetch_add(p, v, __ATOMIC_RELAXED, __HIP_MEMORY_SCOPE_AGENT); }
__device__ __forceinline__ unsigned xb_xcc_id() { return (unsigned)__builtin_amdgcn_s_getreg((3 << 11) | 20) & 0xFu; }
#define XB_SPIN(cond, bar) do { unsigned _sp = 0; while (cond) { __builtin_amdgcn_s_sleep(1); \
    if ((++_sp & 255u) == 0u) { if (xb_ld(&(bar)[XB_TMO])) break; if (_sp > XB_SPIN_CAP) { atomicAdd(&(bar)[XB_TMO], 1u); break; } } } } while (0)
struct XcdBarrier { unsigned* bar; unsigned x; volatile LAS unsigned* st; };
__device__ __forceinline__ XcdBarrier xcd_barrier_post(unsigned* bar, volatile LAS unsigned* st, bool leader) {
    XcdBarrier b; b.bar = bar; b.x = xb_xcc_id(); b.st = st;
    if (leader) (void)xb_add(&bar[XB_XCNT(b.x)], 1u);
    return b;
}
__device__ __forceinline__ void xcd_barrier_complete(unsigned* bar, unsigned x, unsigned& nloc, unsigned& nx) {
    const unsigned G = gridDim.x * gridDim.y * gridDim.z;
    unsigned sum, cnt, mine, sp = 0u;
    for (;;) {
        sum = 0u; cnt = 0u; mine = 0u;
#pragma unroll
        for (unsigned j = 0; j < 16; ++j) { const unsigned c = xb_ld(&bar[XB_XCNT(j)]); sum += c; cnt += (c > 0u) ? 1u : 0u; mine = (j == x) ? c : mine; }
        if (sum == G) break;
        __builtin_amdgcn_s_sleep(1);
        if ((++sp & 255u) == 0u) { if (xb_ld(&bar[XB_TMO])) break; if (sp > XB_SPIN_CAP) { atomicAdd(&bar[XB_TMO], 1u); break; } }
    }
    nloc = mine > 0u ? mine : 1u; nx = cnt > 0u ? cnt : 1u;
}
__device__ __forceinline__ void xcd_barrier(const XcdBarrier& b, bool leader) {
    asm volatile("s_waitcnt vmcnt(0)" ::: "memory");
    __syncthreads();
    if (leader) {
        unsigned* bar = b.bar;
        __builtin_amdgcn_s_waitcnt(0);
        unsigned nloc = b.st[0], nx = b.st[1];
        if (nloc == 0u) { xcd_barrier_complete(bar, b.x, nloc, nx); b.st[0] = nloc; b.st[1] = nx; }
        const unsigned old = xb_add(&bar[XB_XSUB(b.x)], 1u);
        const unsigned gen = old / nloc;
        if (old + 1u == (gen + 1u) * nloc) {
            __builtin_amdgcn_fence(__ATOMIC_RELEASE, "agent");
            asm volatile("s_waitcnt vmcnt(0)" ::: "memory");
            const unsigned og = xb_add(&bar[XB_TOP], 1u);
            const unsigned tg = og / nx;
            if (og + 1u == (tg + 1u) * nx) xb_add(&bar[XB_TOPGEN], 1u);
            else XB_SPIN(xb_ld(&bar[XB_TOPGEN]) == tg, bar);
            __builtin_amdgcn_fence(__ATOMIC_ACQUIRE, "agent");
            xb_add(&bar[XB_XGEN(b.x)], 1u);
            asm volatile("s_waitcnt vmcnt(0)" ::: "memory");
        } else {
            XB_SPIN(xb_ld(&bar[XB_XGEN(b.x)]) == gen, bar);
            __builtin_amdgcn_fence(__ATOMIC_ACQUIRE, "agent");
            asm volatile("s_waitcnt vmcnt(0)" ::: "memory");
        }
    }
    __syncthreads();
}

constexpr int NWAVES = 8, RING_BYTES = 131072, MISC_OFF = 143360, LDS_BYTES = 147456;
struct Args { const void* in[23]; float* out; unsigned char* ws; int ph_lo, ph_hi, li, pad; };

template <class F> __device__ __forceinline__ void conv_item(F val, int K, bf16_t* Wt, LAS float* scr, int item, int nblk, int lane) {
    const int kb = item / nblk, nb = item % nblk, k0 = 64 * kb, n0 = 32 * nb;
#pragma unroll 8
    for (int i = 0; i < 32; ++i) { const int kk = 2 * i + (lane >> 5); scr[kk * 33 + (lane & 31)] = val(k0 + kk, n0 + (lane & 31)); }
    asm volatile("s_waitcnt lgkmcnt(0)" ::: "memory");
    const int c = lane & 7;
#pragma unroll
    for (int j = 0; j < 4; ++j) { const int n = (lane >> 3) + 8 * j; const LAS float* sp = scr + (8 * c) * 33 + n;
        u32x4 o; o.x = pk2(sp[0], sp[33]); o.y = pk2(sp[2 * 33], sp[3 * 33]); o.z = pk2(sp[4 * 33], sp[5 * 33]); o.w = pk2(sp[6 * 33], sp[7 * 33]);
        *(u32x4*)(Wt + (size_t)(n0 + n) * K + k0 + 8 * c) = o; }
    asm volatile("s_waitcnt lgkmcnt(0)" ::: "memory");
}
__device__ __forceinline__ int map_even(int n, float& sc) {
    sc = 1.f;
    if (n < 256) return n; if (n < 384) return 256 + (n - 256); if (n < 512) return 1440 + (n - 384); if (n < 640) return 1568 + (n - 512);
    if (n < 672) { const int j = n - 640; return 384 + ((j & 1) ? (j >> 1) + 16 : (j >> 1)); }
    if (n < 768) return -1; if (n < 1280) return 416 + (n - 768);
    if (n < 1792) { sc = 0.125f * LOG2E; return 928 + (n - 1280); } if (n < 2304) return 1696 + (n - 1792);
    if (n < 2816) { sc = 0.08838834764831845f * LOG2E; return 2208 + (n - 2304); } return 2720 + (n - 2816);
}
__device__ __forceinline__ int map_odd(int n, float& sc) {
    sc = 1.f;
    if (n < 512) { sc = 0.125f * LOG2E; return n; } if (n < 1304) return n; if (n < 1536) return -1; if (n < 2048) return 1304 + (n - 1536);
    if (n < 2560) { sc = 0.08838834764831845f * LOG2E; return 1816 + (n - 2048); } return 2328 + (n - 2560);
}
constexpr int N_PHASES = 24;
#ifndef MK_SITES
#define MK_SITES 0x1fff
#endif
#define SITE(k) (((MK_SITES) >> (k)) & 1)
#ifndef MK_UNITS
#define MK_UNITS 15
#endif
#ifndef MK_DUP
#define MK_DUP 0
#endif
#define NREP(k) ((((MK_DUP) >> (k)) & 1) ? 2 : 1)
__global__ void __launch_bounds__(NWAVES * 64, 2) mega(Args a) {
    extern __shared__ __attribute__((aligned(16))) unsigned char lds_raw[];
    LAS unsigned char* lds = (LAS unsigned char*)lds_raw;
    volatile LAS unsigned* MISC = (volatile LAS unsigned*)(lds + MISC_OFF);
    const int tid0 = threadIdx.x; const int wid0 = __builtin_amdgcn_readfirstlane(tid0 >> 6);
    const int G = gridDim.x, bx = blockIdx.x, NGW = G * NWAVES;
#define WSB() unsigned long long wz_ = 0ull; asm volatile("" : "+s"(wz_)); unsigned char* ws = a.ws + wz_;     unsigned* ctl = (unsigned*)(ws + WS_CTL); (void)ctl; \
    unsigned ones_ = ~0u; asm volatile("" : "+s"(ones_)); const int lane = (int)__builtin_amdgcn_mbcnt_hi(ones_, __builtin_amdgcn_mbcnt_lo(ones_, 0u)); int wid_ = wid0; asm volatile("" : "+s"(wid_)); const int wid = wid_, tid = wid * 64 + lane, gw = bx * NWAVES + wid; (void)tid; (void)gw
#define PTR_STATS() float* ssqx = (float*)(ws + WS_SSQX); float* ssqq = (float*)(ws + WS_SSQQ4); float* ssqkv = (float*)(ws + WS_SSQKV4); float* ssqy = (float*)(ws + WS_SSQY16); (void)ssqx; (void)ssqq; (void)ssqkv; (void)ssqy
#define PTR_ACT() bf16_t* XB = (bf16_t*)(ws + WS_A); bf16_t* ATT = (bf16_t*)(ws + WS_A); bf16_t* PROJ = (bf16_t*)(ws + WS_B); bf16_t* Y = (bf16_t*)(ws + WS_B); bf16_t* QKV = (bf16_t*)(ws + WS_C); (void)XB; (void)ATT; (void)PROJ; (void)Y; (void)QKV
    float* const out = a.out;
    for (int u = tid0; u < (LDS_BYTES - MISC_OFF) / 4; u += NWAVES * 64) ((LAS unsigned*)(lds + MISC_OFF))[u] = 0u;
    __syncthreads();
    XcdBarrier bar; bar.bar = (unsigned*)(a.ws + WS_CTL) + CW_BAR + a.li * XCD_BAR_WORDS; bar.x = 0; bar.st = nullptr;
    if (!MK_PER_PHASE) bar = xcd_barrier_post((unsigned*)(a.ws + WS_CTL) + CW_BAR + a.li * XCD_BAR_WORDS, MISC + 8, tid0 == 0);
    const int lo = a.ph_lo, hi = a.ph_hi;
#define IN(k) (lo <= (k) && (k) < hi)
#define SEAM(k) do { if ((k) + 1 < hi) xcd_barrier(bar, tid == 0); } while (0)
#define Q_INIT() do { if (tid == 0) { MISC[5] = 0u; MISC[6] = 0u; } } while (0)
#define Q_NEXT(head, NQ, dst, dq) do { __syncthreads(); if (tid == 0) { unsigned q_ = MISC[5], tr_ = MISC[6]; int u_ = -1; const unsigned x_ = xb_xcc_id() & 7u; \
        while (tr_ < 8u) { const unsigned v_ = __hip_atomic_fetch_add((head) + ((x_ + q_) & 7u) * 64, 1u, __ATOMIC_RELAXED, __HIP_MEMORY_SCOPE_AGENT); if (v_ < (unsigned)(NQ)) { u_ = (int)v_; break; } ++q_; ++tr_; } \
        MISC[5] = q_; MISC[6] = tr_; MISC[4] = (unsigned)u_; MISC[7] = (x_ + q_) & 7u; } __syncthreads(); (dst) = (int)MISC[4]; (dq) = (int)MISC[7]; } while (0)
#define STAGE_LUT() do { const float* lut_ = (const float*)(ws + WS_LUT); for (int i_ = tid; i_ < 8 * 132; i_ += NWAVES * 64) ((LAS float*)(lds + att::LUTO))[i_] = lut_[i_]; __syncthreads(); } while (0)

    if (SITE(0) && IN(0)) {
        WSB(); PTR_STATS(); PTR_ACT();
        const float* x = (const float*)a.in[0]; const float* mem = (const float*)a.in[1]; const int* pos = (const int*)a.in[2]; const float* table = (const float*)a.in[3];
        const float* norm_pre = (const float*)a.in[4]; const float* mem_norm = (const float*)a.in[6]; const float* w_mem_kv = (const float*)a.in[7];
        const float* w_in_even = (const float*)a.in[8]; const float* mla_q_norm = (const float*)a.in[9]; const float* mla_kv_norm = (const float*)a.in[10]; const float* mla_w_uq = (const float*)a.in[11];
        const float* mla_w_ukv = (const float*)a.in[12]; const float* w_out_even = (const float*)a.in[14]; const float* w_in_odd = (const float*)a.in[15];
        const float* cmp_pos_k = (const float*)a.in[16]; const float* cmp_pos_v = (const float*)a.in[17]; const float* cmp_w1_k = (const float*)a.in[18]; const float* cmp_w1_v = (const float*)a.in[20]; const float* w_out_odd = (const float*)a.in[22];
        float* rstdm = (float*)(ws + WS_RSTDM); int2* pmm = (int2*)(ws + WS_PMM); int2* cpmm = pmm + 128; int* cpos = (int*)(ws + WS_CPOS);
        float2* rope = (float2*)(ws + WS_ROPE); float* lut = (float*)(ws + WS_LUT); float* pb = (float*)(ws + WS_PB);
        bf16_t* WINE = (bf16_t*)(ws + WS_WINE); bf16_t* WINO = (bf16_t*)(ws + WS_WINO); bf16_t* WOUTE = (bf16_t*)(ws + WS_WOUTE); bf16_t* WOUTO = (bf16_t*)(ws + WS_WOUTO);
        bf16_t* WMKV = (bf16_t*)(ws + WS_WMKV); bf16_t* WUP = (bf16_t*)(ws + WS_WUP); bf16_t* WC1 = (bf16_t*)(ws + WS_WC1); bf16_t* MEMB = (bf16_t*)(ws + WS_MEMB);
        LAS float* scr = (LAS float*)(lds + wid * 16384);
        constexpr int I0 = 1664, I1 = 1536, I2 = 768, I3 = 512, I4 = 512, I5 = 336, I6 = 256;
        constexpr int S1 = 2 * I0, S2 = S1 + 2 * I1, S3 = S2 + 2 * I2, S4 = S3 + 2 * I3, S5 = S4 + 4 * I4, S6 = S5 + 2 * I5, S7 = S6 + 4 * I6;
        for (int it = gw; it < S7; it += NGW) {
            if (it < S1) { const int e = it / I0, r = it % I0; const float* W = w_in_even + (size_t)e * DM * 3232; const float* gn = norm_pre + (2 * e) * DM;
                conv_item([&](int k, int n) -> float { float sc; const int s = map_even(n, sc); return s < 0 ? 0.f : W[(size_t)k * 3232 + s] * sc * gn[k]; }, DM, WINE + (size_t)e * PE * DM, scr, r, PE / 32, lane); }
            else if (it < S2) { const int e = (it - S1) / I1, r = (it - S1) % I1; const float* W = w_in_odd + (size_t)e * DM * 2840; const float* gn = norm_pre + (2 * e + 1) * DM;
                conv_item([&](int k, int n) -> float { float sc; const int s = map_odd(n, sc); return s < 0 ? 0.f : W[(size_t)k * 2840 + s] * sc * gn[k]; }, DM, WINO + (size_t)e * PO * DM, scr, r, PO / 32, lane); }
            else if (it < S3) { const int e = (it - S2) / I2, r = (it - S2) % I2; const float* W = w_out_even + (size_t)e * 1536 * DM;
                conv_item([&](int k, int n) -> float { return W[(size_t)k * DM + n]; }, 1536, WOUTE + (size_t)e * DM * 1536, scr, r, DM / 32, lane); }
            else if (it < S4) { const int e = (it - S3) / I3, r = (it - S3) % I3; const float* W = w_out_odd + (size_t)e * DM * DM;
                conv_item([&](int k, int n) -> float { return W[(size_t)k * DM + n]; }, DM, WOUTO + (size_t)e * DM * DM, scr, r, DM / 32, lane); }
            else if (it < S5) { const int l = (it - S4) / I4, r = (it - S4) % I4; const float* W = w_mem_kv + (size_t)l * DM * DM; const float* gn = mem_norm + l * DM;
                conv_item([&](int k, int n) -> float { return W[(size_t)k * DM + n] * gn[k]; }, DM, WMKV + (size_t)l * DM * DM, scr, r, DM / 32, lane); }
            else if (it < S6) { const int e = (it - S5) / I5, r = (it - S5) % I5; const float* Wq = mla_w_uq + (size_t)e * 256 * 768; const float* Wk = mla_w_ukv + (size_t)e * 128 * 1024;
                const float* gq = mla_q_norm + e * 256; const float* gk = mla_kv_norm + e * 128;
                conv_item([&](int k, int n) -> float {
                    if (n < 768) { if (k >= 256) return 0.f; const int h = n / 96, j = n % 96; const int s = (j < 64) ? n : h * 96 + 64 + (((j - 64) & 1) ? ((j - 64) >> 1) + 16 : ((j - 64) >> 1));
                        return Wq[(size_t)k * 768 + s] * (0.10206207261596575f * LOG2E) * gq[k]; }
                    if (k < 256) return 0.f; return Wk[(size_t)(k - 256) * 1024 + (n - 768)] * gk[k - 256]; }, 384, WUP + (size_t)e * QKVW * 384, scr, r, QKVW / 32, lane); }
            else { const int m4 = (it - S6) / I6, r = (it - S6) % I6; const float* W = ((m4 & 1) ? cmp_w1_v : cmp_w1_k) + (size_t)(m4 >> 1) * 2048 * 256;
                conv_item([&](int k, int n) -> float { return W[(size_t)k * 256 + n]; }, 2048, WC1 + (size_t)m4 * 256 * 2048, scr, r, 256 / 32, lane); }
        }
        for (int row = gw; row < T + NB * MEML; row += NGW) {
            const bool isx = row < T; const int r = isx ? row : row - T; const float* src = (isx ? x : mem) + (size_t)r * DM; bf16_t* dst = (isx ? XB : MEMB) + (size_t)r * DM;
            float s = 0.f;
#pragma unroll
            for (int j = 0; j < 4; ++j) { const f32x4 v = *(const f32x4*)(src + 4 * (lane + 64 * j)); s += (v[0] * v[0] + v[1] * v[1]) + (v[2] * v[2] + v[3] * v[3]);
                u32x2 w; w.x = pk2(v[0], v[1]); w.y = pk2(v[2], v[3]); *(u32x2*)(dst + 4 * (lane + 64 * j)) = w; }
            s = wave_sum(s);
            if (lane == 0) { if (isx) ssqx[r] = s; else rstdm[r] = rsqrtf(s * (1.f / DM) + EPS); }
        }
        for (int idx = bx * (NWAVES * 64) + tid; idx < S * 16; idx += G * NWAVES * 64) {
            { const int s = idx >> 4, i = idx & 15; const float inv = powf(10000.0f, -(float)i / 16.0f); const float ang = (float)pos[s] * inv; float sn, cs; sincosf(ang, &sn, &cs); rope[idx] = make_float2(cs, sn); }
            if (idx < 8 * 132) { const int h = idx / 132, d = idx % 132; int bucket;
                if (d < 16) bucket = d; else { const float lr = logf((float)d / 16.0f) / logf(8.0f); const int lg = 16 + (int)(lr * 16.0f); bucket = lg < 31 ? lg : 31; }
                lut[idx] = table[bucket * 8 + h] * LOG2E; }
            if (idx < 128) { int mn = pos[idx * 64], mx = mn; for (int i = 1; i < 64; ++i) { const int p = pos[idx * 64 + i]; mn = p < mn ? p : mn; mx = p > mx ? p : mx; } pmm[idx] = make_int2(mn, mx); }
            if (idx < 512) { const int tk = 16 * idx + 31; cpos[idx] = pos[tk < S ? tk : S - 1]; }
            if (idx < 8) { int mn = 0x7fffffff, mx = -0x7fffffff; for (int i = 0; i < 64; ++i) { const int tk = 16 * (idx * 64 + i) + 31; const int p = pos[tk < S ? tk : S - 1]; mn = p < mn ? p : mn; mx = p > mx ? p : mx; } cpmm[idx] = make_int2(mn, mx); }
        }
        for (int it = gw; it < 256; it += NGW) { const int kc = it >> 4, m4 = (it >> 2) & 3, n = (it & 3) * 64 + lane;
            const float* pe = ((m4 & 1) ? cmp_pos_v : cmp_pos_k) + (size_t)(m4 >> 1) * 2048 + kc * 128; const float* w = ((m4 & 1) ? cmp_w1_v : cmp_w1_k) + (size_t)(m4 >> 1) * 2048 * 256 + (size_t)kc * 128 * 256 + n;
            float s0 = 0.f, s1 = 0.f, s2 = 0.f, s3 = 0.f;
#pragma unroll 8
            for (int k = 0; k < 128; k += 4) { s0 += pe[k] * w[(size_t)k * 256]; s1 += pe[k + 1] * w[(size_t)(k + 1) * 256]; s2 += pe[k + 2] * w[(size_t)(k + 2) * 256]; s3 += pe[k + 3] * w[(size_t)(k + 3) * 256]; }
            pb[(kc * 4 + m4) * 256 + n] = (s0 + s1) + (s2 + s3); }
        SEAM(0);
    }
    if (SITE(1) && IN(1)) {
        WSB(); bf16_t* MEMB = (bf16_t*)(ws + WS_MEMB); bf16_t* WMKV = (bf16_t*)(ws + WS_WMKV); bf16_t* MKV = (bf16_t*)(ws + WS_MKV); float* rstdm = (float*)(ws + WS_RSTDM);
        pg8::Gemm g{MEMB, WMKV, DM, DM * 2, DM * 2, 128, 0}; pg8::StaticOrder SO; SO.init(NB * MEML / 256, 4096 / 256, G, bx);
        pg8::EpiStore E{MKV, rstdm, nullptr, 4096};
        pg8::gemm_phase<pg8::EpiStore, pg8::StaticOrder, true, true>(lds, g, SO, E, wid);
        SEAM(1);
    }
    for (int pr = 0; pr < 2; ++pr) {
        const int base = 2 + pr * 11;
        if (SITE(2) && IN(base + 0)) {
            WSB(); PTR_STATS(); PTR_ACT(); bf16_t* WINE = (bf16_t*)(ws + WS_WINE); const float2* rope = (const float2*)(ws + WS_ROPE);
            pg8::Gemm g{XB, WINE + (size_t)pr * PE * DM, DM, DM * 2, DM * 2, 128, 0}; pg8::StaticOrder SO; SO.init(T / 256, PE / 256, G, bx);
            pg8::EpiWin E{PROJ, ssqx, rope, ssqq, ssqkv, PE, 0};
            pg8::gemm_phase<pg8::EpiWin, pg8::StaticOrder, true, true>(lds, g, SO, E, wid);
            SEAM(base + 0);
        }
        if (SITE(3) && IN(base + 1)) {
            WSB(); PTR_STATS(); PTR_ACT(); bf16_t* WUP = (bf16_t*)(ws + WS_WUP); const float2* rope = (const float2*)(ws + WS_ROPE);
            pg8::Gemm g{PROJ, WUP + (size_t)pr * QKVW * 384, 384, PE * 2, 384 * 2, 128, 0}; pg8::StaticOrder SO; SO.init(T / 256, QKVW / 256, G, bx);
            pg8::EpiUp E{QKV, ssqq, ssqkv, rope};
            pg8::gemm_phase<pg8::EpiUp, pg8::StaticOrder, true, true>(lds, g, SO, E, wid);
            SEAM(base + 1);
        }
        if (SITE(4) && IN(base + 2)) {
            WSB(); PTR_ACT(); const int* pos = (const int*)a.in[2]; const float* swa_sinks = (const float*)a.in[13]; bf16_t* MKV = (bf16_t*)(ws + WS_MKV); bf16_t* KC = (bf16_t*)(ws + WS_KC); bf16_t* VC = (bf16_t*)(ws + WS_VC);
            const int2* pmm = (const int2*)(ws + WS_PMM); const int2* cpmm = pmm + 128; const int* cpos = (const int*)(ws + WS_CPOS);
            STAGE_LUT();
            const att::Ptrs P{PROJ, QKV, MKV, KC, VC, ATT, pos, cpos, pmm, cpmm, swa_sinks + pr * 8, 2 * pr};
            unsigned* head = ctl + CW_Q + (pr * 2 + 0) * 512 + a.li * 16;
            Q_INIT();
            for (;;) { int u, xq; Q_NEXT(head, 512, u, xq); if (u < 0) break;
                if (u < 128) { const int bh = xq + 8 * (u >> 4); if (MK_UNITS & 1) att::unit_mla2((LAS char*)lds, P, bh >> 3, bh & 7, 15 - (u & 15), tid, lane, wid); }
                else if (u < 256) { const int v = u - 128, bh = xq + 8 * (v >> 5); if (MK_UNITS & 2) att::unit_mem((LAS char*)lds, P, bh >> 2, bh & 3, v & 31, PE, E_QMEM, E_GMEM, 1536, 1024, tid, lane, wid); }
                else { const int v = u - 256, bg = xq + 8 * (v >> 7); if (MK_UNITS & 4) att::unit_swa((LAS char*)lds, P, bg >> 1, bg & 1, 127 - (v & 127), tid, lane, wid); } }
            SEAM(base + 2);
        }
        if (SITE(5) && IN(base + 3)) {
            WSB(); PTR_STATS(); PTR_ACT(); bf16_t* WOUTE = (bf16_t*)(ws + WS_WOUTE);
            pg8::Gemm g{ATT, WOUTE + (size_t)pr * DM * 1536, 1536, 1536 * 2, 1536 * 2, 128, 0}; pg8::StaticOrder SO; SO.init(T / 256, DM / 256, G, bx);
            pg8::EpiStore E{Y, nullptr, ssqy, DM};
            pg8::gemm_phase<pg8::EpiStore, pg8::StaticOrder, true, true>(lds, g, SO, E, wid);
            SEAM(base + 3);
        }
#define RESID(L, XIN, WXB) do { const float* gp_ = norm_post + (L) * DM; const float* xin_ = (XIN); \
            for (int row = gw; row < T; row += NGW) { float sy_; { const f32x4* q_ = (const f32x4*)(ssqy + (size_t)row * 16); const f32x4 a_ = q_[0], b_ = q_[1], c_ = q_[2], d_ = q_[3]; \
                    sy_ = (((a_[0] + a_[1]) + (a_[2] + a_[3])) + ((b_[0] + b_[1]) + (b_[2] + b_[3]))) + (((c_[0] + c_[1]) + (c_[2] + c_[3])) + ((d_[0] + d_[1]) + (d_[2] + d_[3]))); } \
                const float rs = rsqrtf(sy_ * (1.f / DM) + EPS); float s2 = 0.f; \
                _Pragma("unroll") for (int j = 0; j < 4; ++j) { const int c = 4 * (lane + 64 * j); const u32x2 yw = *(const u32x2*)(Y + (size_t)row * DM + c); const f32x4 xv = *(const f32x4*)(xin_ + (size_t)row * DM + c); const f32x4 gv = *(const f32x4*)(gp_ + c); \
                    f32x4 v; v[0] = xv[0] + __uint_as_float(yw.x << 16) * rs * gv[0]; v[1] = xv[1] + __uint_as_float(yw.x & 0xffff0000u) * rs * gv[1]; v[2] = xv[2] + __uint_as_float(yw.y << 16) * rs * gv[2]; v[3] = xv[3] + __uint_as_float(yw.y & 0xffff0000u) * rs * gv[3]; \
                    *(f32x4*)(out + (size_t)row * DM + c) = v; if (WXB) { u32x2 w; w.x = pk2(v[0], v[1]); w.y = pk2(v[2], v[3]); *(u32x2*)(XB + (size_t)row * DM + c) = w; } s2 += (v[0] * v[0] + v[1] * v[1]) + (v[2] * v[2] + v[3] * v[3]); } \
                s2 = wave_sum(s2); if (lane == 0) ssqx[row] = s2; } } while (0)
        if (SITE(6) && IN(base + 4)) { WSB(); PTR_STATS(); PTR_ACT(); const float* norm_post = (const float*)a.in[5]; RESID(2 * pr, (pr == 0) ? (const float*)a.in[0] : (const float*)out, true); SEAM(base + 4); }
        if (SITE(7) && IN(base + 5)) {
            WSB(); PTR_STATS(); PTR_ACT(); bf16_t* WINO = (bf16_t*)(ws + WS_WINO); const float2* rope = (const float2*)(ws + WS_ROPE);
            pg8::Gemm g{XB, WINO + (size_t)pr * PO * DM, DM, DM * 2, DM * 2, 128, 0}; pg8::StaticOrder SO; SO.init(T / 256, PO / 256, G, bx);
            pg8::EpiWin E{PROJ, ssqx, rope, ssqq, ssqkv, PO, 1};
            pg8::gemm_phase<pg8::EpiWin, pg8::StaticOrder, true, true>(lds, g, SO, E, wid);
            SEAM(base + 5);
        }
        if (SITE(8) && IN(base + 6)) { WSB(); PTR_ACT(); bf16_t* WC1 = (bf16_t*)(ws + WS_WC1); float* PART = (float*)(ws + WS_C);
            pg8::Gemm gk{PROJ + O_KCMP, WC1 + (size_t)(pr * 2) * 256 * 2048, 512, 16 * PO * 2, 2048 * 2, PO * 2, 2}; pg8::StaticOrder S1; S1.init(256, 1, G, bx);
            pg8::EpiPart Ek{PART};
            pg8::gemm_phase<pg8::EpiPart, pg8::StaticOrder, true, true>(lds, gk, S1, Ek, wid);
            SEAM(base + 6);
        }
        if (SITE(9) && IN(base + 7)) { WSB(); const float* PART = (const float*)(ws + WS_C); bf16_t* KC = (bf16_t*)(ws + WS_KC); bf16_t* VC = (bf16_t*)(ws + WS_VC); const float* pb = (const float*)(ws + WS_PB) + pr * 512;     const float* cmp_w2_k = (const float*)a.in[19]; const float* cmp_w2_v = (const float*)a.in[21];
            LAS float* w2s = (LAS float*)lds;
            const float* w2k = cmp_w2_k + (size_t)pr * 256 * 64; const float* w2v = cmp_w2_v + (size_t)pr * 256 * 64;
            for (int i = tid; i < 256 * 64; i += NWAVES * 64) { w2s[i] = w2k[i]; w2s[256 * 64 + i] = w2v[i]; }
            __syncthreads();
            f32x4 pbs[2];
#pragma unroll
            for (int kv_ = 0; kv_ < 2; ++kv_) { f32x4 acc_ = (f32x4){0.f, 0.f, 0.f, 0.f};
                for (int kc = 0; kc < 16; ++kc) acc_ += *(const f32x4*)(pb + (kc * 4 + kv_) * 256 + 4 * lane);
                pbs[kv_] = acc_; }
            for (int it = gw; it < 2 * 8192; it += NGW) { const int kv = it >> 13, row = it & 8191; const f32x4 pbsum = kv ? pbs[1] : pbs[0]; const float* pp = PART + ((size_t)kv * 4 * 8192 + row) * 256 + 4 * lane; const LAS float* wp = w2s + kv * 256 * 64 + lane;
                const f32x4 q0 = *(const f32x4*)pp, q1 = *(const f32x4*)(pp + (size_t)8192 * 256), q2 = *(const f32x4*)(pp + (size_t)2 * 8192 * 256), q3 = *(const f32x4*)(pp + (size_t)3 * 8192 * 256), bb = pbsum;
                f32x4 h = ((q0 + q1) + (q2 + q3)) + bb;
#pragma unroll
                for (int i = 0; i < 4; ++i) h[i] = silu_f(h[i]);
                float s = 0.f;
#pragma unroll
                for (int k4 = 0; k4 < 64; ++k4) { const float h0 = __uint_as_float(__builtin_amdgcn_readlane(__float_as_uint(h[0]), k4)), h1 = __uint_as_float(__builtin_amdgcn_readlane(__float_as_uint(h[1]), k4)),
                                                              h2 = __uint_as_float(__builtin_amdgcn_readlane(__float_as_uint(h[2]), k4)), h3 = __uint_as_float(__builtin_amdgcn_readlane(__float_as_uint(h[3]), k4));
                    s += h0 * wp[(4 * k4) * 64] + h1 * wp[(4 * k4 + 1) * 64] + h2 * wp[(4 * k4 + 2) * 64] + h3 * wp[(4 * k4 + 3) * 64]; }
                (kv ? VC : KC)[(size_t)row * 64 + lane] = ((row & 511) == 511) ? (bf16_t)0 : f2bf(s); }
            __syncthreads();
            SEAM(base + 7);
        }
        if (SITE(10) && IN(base + 8)) {
            WSB(); PTR_ACT(); const int* pos = (const int*)a.in[2]; const float* swa_sinks = (const float*)a.in[13]; bf16_t* MKV = (bf16_t*)(ws + WS_MKV); bf16_t* KC = (bf16_t*)(ws + WS_KC); bf16_t* VC = (bf16_t*)(ws + WS_VC);
            const int2* pmm = (const int2*)(ws + WS_PMM); const int2* cpmm = pmm + 128; const int* cpos = (const int*)(ws + WS_CPOS);
            STAGE_LUT();
            const att::Ptrs P{PROJ, QKV, MKV, KC, VC, ATT, pos, cpos, pmm, cpmm, swa_sinks, 2 * pr + 1};
            unsigned* head = ctl + CW_Q + (pr * 2 + 1) * 512 + a.li * 16;
            Q_INIT();
            for (;;) { int u, xq; Q_NEXT(head, 384, u, xq); if (u < 0) break;
                if (u < 256) { const int bg = xq + 8 * (u >> 7); if (MK_UNITS & 8) att::unit_nsa((LAS char*)lds, P, bg >> 1, bg & 1, 127 - (u & 127), tid, lane, wid); }
                else { const int v = u - 256, bh = xq + 8 * (v >> 5); if (MK_UNITS & 2) att::unit_mem((LAS char*)lds, P, bh >> 2, bh & 3, v & 31, PO, O_QMEM, O_GMEM, 1024, 512, tid, lane, wid); } }
            SEAM(base + 8);
        }
        if (SITE(11) && IN(base + 9)) {
            WSB(); PTR_STATS(); PTR_ACT(); bf16_t* WOUTO = (bf16_t*)(ws + WS_WOUTO);
            pg8::Gemm g{ATT, WOUTO + (size_t)pr * DM * DM, DM, DM * 2, DM * 2, 128, 0}; pg8::StaticOrder SO; SO.init(T / 256, DM / 256, G, bx);
            pg8::EpiStore E{Y, nullptr, ssqy, DM};
            pg8::gemm_phase<pg8::EpiStore, pg8::StaticOrder, true, true>(lds, g, SO, E, wid);
            SEAM(base + 9);
        }
        if (SITE(12) && IN(base + 10)) { WSB(); PTR_STATS(); PTR_ACT(); const float* norm_post = (const float*)a.in[5]; RESID(2 * pr + 1, (const float*)out, pr == 0); SEAM(base + 10); }
    }
}

extern "C" void kernel_launch(void* const* d_in, const int* in_sizes, int n_in, void* d_out, int out_size, void* d_ws, size_t ws_size, hipStream_t stream) {
    static int ready = 0;
    if (ready == 0) {
        if (n_in != 23 || ws_size < WS_END) { fprintf(stderr, "kernel_launch: unexpected problem (n_in %d, ws %zu)\n", n_in, ws_size); ready = -1; return; }
        if (hipFuncSetAttribute((const void*)mega, hipFuncAttributeMaxDynamicSharedMemorySize, LDS_BYTES) != hipSuccess) { fprintf(stderr, "kernel_launch: hipFuncSetAttribute failed\n"); ready = -1; return; }
        int nb = 0, dev = 0, ncu = 0;
        if (hipOccupancyMaxActiveBlocksPerMultiprocessor(&nb, (const void*)mega, NWAVES * 64, LDS_BYTES) != hipSuccess) nb = 0;
        if (hipGetDevice(&dev) != hipSuccess || hipDeviceGetAttribute(&ncu, hipDeviceAttributeMultiprocessorCount, dev) != hipSuccess) ncu = 0;
        (void)hipGetLastError();
        ready = ((long)nb * ncu >= 256) ? 1 : 2;
    }
    if (ready < 0) return;
    (void)hipMemsetAsync((char*)d_ws + WS_CTL, 0, CTL_BYTES, stream);
    Args a{};
    for (int i = 0; i < 23; ++i) a.in[i] = d_in[i];
    a.out = (float*)d_out; a.ws = (unsigned char*)d_ws;
    const int grid = 256;
#if MK_PER_PHASE
    for (int p = 0; p < N_PHASES; ++p) { a.ph_lo = p; a.ph_hi = p + 1; hipLaunchKernelGGL(mega, dim3(grid), dim3(NWAVES * 64), LDS_BYTES, stream, a); }
#elif defined(MK_PROBE)
    a.ph_lo = 0; a.ph_hi = MK_PROBE + 1; a.li = 0; hipLaunchKernelGGL(mega, dim3(grid), dim3(NWAVES * 64), LDS_BYTES, stream, a);
    a.ph_lo = MK_PROBE; a.ph_hi = MK_PROBE + 1; a.li = 1; hipLaunchKernelGGL(mega, dim3(grid), dim3(NWAVES * 64), LDS_BYTES, stream, a);
    if (MK_PROBE + 1 < N_PHASES) { a.ph_lo = MK_PROBE + 1; a.ph_hi = N_PHASES; a.li = 2; hipLaunchKernelGGL(mega, dim3(grid), dim3(NWAVES * 64), LDS_BYTES, stream, a); }
#else
    if (ready == 1) { a.ph_lo = 0; a.ph_hi = N_PHASES; hipLaunchKernelGGL(mega, dim3(grid), dim3(NWAVES * 64), LDS_BYTES, stream, a); }
    else for (int p = 0; p < N_PHASES; ++p) { a.ph_lo = p; a.ph_hi = p + 1; hipLaunchKernelGGL(mega, dim3(grid), dim3(NWAVES * 64), LDS_BYTES, stream, a); }
#endif
}
```

```cpp
#include <hip/hip_runtime.h>
#include <stdint.h>
#include <stdio.h>

#ifndef MK_PER_PHASE
#define MK_PER_PHASE 0
#endif
#define LAS __attribute__((address_space(3)))
typedef unsigned short bf16_t;
typedef short bf16x8 __attribute__((ext_vector_type(8)));
typedef short s16x4 __attribute__((ext_vector_type(4)));
typedef float f32x16 __attribute__((ext_vector_type(16)));
typedef float f32x4 __attribute__((ext_vector_type(4)));
typedef float f32x2 __attribute__((ext_vector_type(2)));
typedef unsigned u32x4 __attribute__((ext_vector_type(4)));
typedef unsigned u32x2 __attribute__((ext_vector_type(2)));

constexpr int DM = 1024, NB = 8, S = 8192, T = NB * S, MEML = 256;
constexpr int PE = 3328, PO = 3072, QKVW = 1792;
constexpr float EPS = 1e-6f;
constexpr float LOG2E = 1.4426950408889634f;
constexpr float NEG = -1e30f;
constexpr int E_CQ = 0, E_CKV = 256, E_KSWA = 384, E_VSWA = 512, E_KPE = 640, E_GMLA = 768, E_QSWA = 1280, E_GSWA = 1792, E_QMEM = 2304, E_GMEM = 2816;
constexpr int O_Q = 0, O_KCMP = 512, O_VCMP = 640, O_KSLC = 768, O_VSLC = 896, O_KWIN = 1024, O_VWIN = 1152, O_GL = 1280, O_GNSA = 1536, O_QMEM = 2048, O_GMEM = 2560;

constexpr size_t MiB = 1u << 20;
constexpr size_t WS_CTL = 0, CTL_BYTES = 1 * MiB;
constexpr size_t WS_SSQX = 1 * MiB, WS_SSQQ = WS_SSQX + 256 * 1024, WS_SSQKV = WS_SSQQ + 256 * 1024, WS_SSQY = WS_SSQKV + 256 * 1024;
constexpr size_t WS_RSTDM = 2 * MiB;
constexpr size_t WS_PMM = 2 * MiB + 65536;
constexpr size_t WS_CPOS = 2 * MiB + 131072;
constexpr size_t WS_ROPE = 3 * MiB;
constexpr size_t WS_LUT = 4 * MiB;
constexpr size_t WS_PB = 4 * MiB + 65536;
constexpr size_t WS_WINE = 8 * MiB, WS_WINO = 21 * MiB, WS_WOUTE = 33 * MiB, WS_WOUTO = 39 * MiB, WS_WMKV = 43 * MiB, WS_WUP = 51 * MiB  , WS_WC1 = 54 * MiB;
constexpr size_t WS_MEMB = 58 * MiB, WS_MKV = 62 * MiB, WS_KC = 78 * MiB, WS_VC = 79 * MiB, WS_HC = 80 * MiB;
static_assert(WS_WUP + (size_t)2 * 1792 * 384 * 2 <= WS_WC1 && WS_WC1 + (size_t)4 * 256 * 2048 * 2 <= WS_MEMB && WS_HC + (size_t)2 * 8192 * 256 * 2 <= 88 * MiB, "workspace map");
constexpr size_t WS_SSQY16 = 90 * MiB, WS_SSQQ4 = 94 * MiB, WS_SSQKV4 = 95 * MiB;
constexpr size_t WS_A = 96 * MiB;
constexpr size_t WS_B = 288 * MiB;
constexpr size_t WS_C = 704 * MiB;
constexpr size_t WS_XR = WS_C + 64 * MiB;
constexpr size_t WS_END = 928 * MiB;
constexpr int CW_BAR = 4096;
constexpr int CW_Q = 16384;

__device__ __forceinline__ float bf2f(bf16_t v) { return __uint_as_float(((unsigned)v) << 16); }
__device__ __forceinline__ bf16_t f2bf(float f) { unsigned u = __float_as_uint(f); return (bf16_t)((u + 0x7fffu + ((u >> 16) & 1u)) >> 16); }
__device__ __forceinline__ unsigned pk2(float lo, float hi) { typedef __bf16 bf2 __attribute__((ext_vector_type(2))); f32x2 v = {lo, hi}; return __builtin_bit_cast(unsigned, __builtin_convertvector(v, bf2)); }
__device__ __forceinline__ float silu_f(float v) { return v * __builtin_amdgcn_rcpf(1.f + __builtin_amdgcn_exp2f(-LOG2E * v)); }
__device__ __forceinline__ float sigm_f(float v) { return __builtin_amdgcn_rcpf(1.f + __builtin_amdgcn_exp2f(-LOG2E * v)); }
__device__ __forceinline__ int crow(int r, int hi) { return (r & 3) + 8 * (r >> 2) + 4 * hi; }
__device__ __forceinline__ float wave_sum(float v) {
    v += __builtin_bit_cast(float, __builtin_amdgcn_update_dpp(0, __builtin_bit_cast(int, v), 0xB1  , 0xf, 0xf, false));
    v += __builtin_bit_cast(float, __builtin_amdgcn_update_dpp(0, __builtin_bit_cast(int, v), 0x4E  , 0xf, 0xf, false));
    v += __builtin_bit_cast(float, __builtin_amdgcn_update_dpp(0, __builtin_bit_cast(int, v), 0x141  , 0xf, 0xf, false));
    v += __builtin_bit_cast(float, __builtin_amdgcn_update_dpp(0, __builtin_bit_cast(int, v), 0x140  , 0xf, 0xf, false));
    { auto a = __builtin_amdgcn_permlane16_swap(__float_as_uint(v), __float_as_uint(v), false, false); v = __uint_as_float(a[0]) + __uint_as_float(a[1]); }
    { auto a = __builtin_amdgcn_permlane32_swap(__float_as_uint(v), __float_as_uint(v), false, false); v = __uint_as_float(a[0]) + __uint_as_float(a[1]); }
    return v;
}
namespace pg8 {
#define PG8_LAS __attribute__((address_space(3)))
typedef unsigned short bf16_t;
typedef short bf16x8 __attribute__((ext_vector_type(8)));
typedef float f32x4 __attribute__((ext_vector_type(4)));
typedef unsigned u32x4 __attribute__((ext_vector_type(4)));
constexpr int BM = 256, BK = 64, HALF = 128, HTB = HALF * BK * 2  , STAGE_BYTES = 8 * HTB, NXCD = 8, WGM = 8;

__host__ __device__ __forceinline__ int lds_byte(int r, int c) { const int st = (r >> 4) * 2 + (c >> 5), rr = r & 15, cc = c & 31, ob = rr * 64 + cc * 2; return st * 1024 + (ob ^ (((ob >> 9) & 1) << 5)); }
__host__ __device__ __forceinline__ void stage_rc(int b, int& R, int& C) { const int st = b / 1024, sb = b % 1024, swz = sb ^ (((sb >> 9) & 1) << 5); R = (st >> 1) * 16 + swz / 64; C = (st & 1) * 32 + (swz % 64) / 2; }
__host__ __device__ __forceinline__ int perm32(int rho) { const int n = rho >> 4, i = rho & 15; return 8 * (i >> 2) + 4 * n + (i & 3); }

struct Unit { int pm, pn; };
struct Gemm { const bf16_t* A; const bf16_t* Bt; int K; int lda2, ldb2, kstepA, amode; };
__device__ __forceinline__ const char* a_tile(const Gemm& g, int pm, int pn) { if (g.amode == 0) return (const char*)g.A + (size_t)pm * 256 * g.lda2;
    if (g.amode == 3) return (const char*)g.A + (size_t)pm * 256 * g.lda2 + (pn >= 3 ? 512 : 0);
    const int kv = pm >> 7, kq = (pm >> 5) & 3, p32 = pm & 31, bg = p32 >> 1, b = bg >> 1, gg = bg & 1, half = p32 & 1;
    return (const char*)g.A + ((size_t)(b * 8192 + 4096 * half + 8 * kq) * 3072 + gg * 64 + kv * 128) * 2; }
__device__ __forceinline__ const char* b_tile(const Gemm& g, int pm, int pn) { if (g.amode == 0 || g.amode == 3) return (const char*)g.Bt + (size_t)pn * 256 * g.ldb2;
    const int kv = pm >> 7, kq = (pm >> 5) & 3; return (const char*)g.Bt + ((size_t)kv * 256 * 2048 + kq * 512) * 2; }

struct StaticOrder {
    int nM, nN, nwg, G, c;
    __host__ __device__ void init(int nM_, int nN_, int G_, int c_) { nM = nM_; nN = nN_; nwg = nM * nN; G = G_; c = c_; }
    __host__ __device__ bool next(int i, Unit& u) const {
        const long L = (long)i * G + c; if (L >= nwg) return false;
        int wgid = (int)L; { const int q = nwg / NXCD, r = nwg % NXCD, xcd = wgid % NXCD, off = wgid / NXCD; wgid = (xcd < r ? xcd * (q + 1) : r * (q + 1) + (xcd - r) * q) + off; }
        const int nig = WGM * nN, gid = wgid / nig, fm = gid * WGM, gsz = (nM - fm) < WGM ? (nM - fm) : WGM;
        u.pm = fm + ((wgid % nig) % gsz); u.pn = (wgid % nig) / gsz; return true;
    }
    __device__ __forceinline__ void a_ready(const Unit&) const {}
    __device__ __forceinline__ void done(const Unit&) const {}
};

__device__ __forceinline__ unsigned cvt_pk_bf16(float lo, float hi) { unsigned r; asm volatile("v_cvt_pk_bf16_f32 %0, %1, %2" : "=v"(r) : "v"(lo), "v"(hi)); return r; }
__device__ __forceinline__ int padmask(int pad, int pn, int wc) { if (pad == 1 && pn == 5) return wc == 0 ? 1 : 0; if (pad == 2 && pn == 2) return wc == 0 ? 3 : 1; return 3; }
template <class Epi, class Sched, bool ALIGN_EPI = false, bool SP2 = false, int PAD = 0>
__device__ __forceinline__ void gemm_phase(PG8_LAS unsigned char* lds, const Gemm g, const Sched& S, const Epi& E, const int wid) {
    unsigned ones_ = ~0u; asm volatile("" : "+s"(ones_)); const int lane = (int)__builtin_amdgcn_mbcnt_hi(ones_, __builtin_amdgcn_mbcnt_lo(ones_, 0u));
    const int tid = wid * 64 + lane, wr = wid >> 2, wc = wid & 3, fr = lane & 15, fq = lane >> 4;
    const int K = g.K, nt = K / BK;
    unsigned voffA[2], voffB[2];
#pragma unroll
    for (int i = 0; i < 2; ++i) { int R, C; stage_rc(tid * 16 + i * 8192, R, C); const int Rb = Epi::PERM ? ((R & ~31) + perm32(R & 31)) : R;
        voffA[i] = (unsigned)(R * g.lda2 + C * 2); voffB[i] = (unsigned)(Rb * g.ldb2 + C * 2); }
    const size_t kstepA = (size_t)g.kstepA, kstepB = (size_t)(BK * 2);
    const size_t hstepA = (size_t)HALF * g.lda2, hstepB = (size_t)HALF * g.ldb2;

    const unsigned ldsw = (unsigned)wid * 1024u;
    const int aoff = lds_byte(wr * 64 + fr, fq * 8), boff = lds_byte(wc * 32 + fr, fq * 8);
#define PG8_SA(b, h) (((b) * 2 + (h)) * HTB)
#define PG8_SB(b, h) ((4 + (b) * 2 + (h)) * HTB)
#define PG8_STAGE(bufoff, gbase, voff) do { _Pragma("unroll") for (int _i = 0; _i < 2; ++_i) \
        __builtin_amdgcn_global_load_lds((const unsigned*)((const char*)(gbase) + (voff)[_i]), (PG8_LAS unsigned*)(lds + (bufoff) + ldsw + _i * 8192), 16, 0, 0); } while (0)
#define PG8_LDA(dst, b, h) do { _Pragma("unroll") for (int m = 0; m < 4; ++m) _Pragma("unroll") for (int k = 0; k < 2; ++k) dst[m][k] = *(const PG8_LAS bf16x8*)(lds + PG8_SA(b, h) + aoff + m * 2048 + k * 1024); } while (0)
#define PG8_LDB(dst, b, h) do { _Pragma("unroll") for (int n = 0; n < 2; ++n) _Pragma("unroll") for (int k = 0; k < 2; ++k) dst[n][k] = *(const PG8_LAS bf16x8*)(lds + PG8_SB(b, h) + boff + n * 2048 + k * 1024); } while (0)
#define PG8_MMA(ai, bj, At, Bt) do { __builtin_amdgcn_s_setprio(1); _Pragma("unroll") for (int m = 0; m < 4; ++m) _Pragma("unroll") for (int n = 0; n < 2; ++n) _Pragma("unroll") for (int k = 0; k < 2; ++k) \
        acc[ai][bj][m][n] = __builtin_amdgcn_mfma_f32_16x16x32_bf16(Bt[n][k], At[m][k], acc[ai][bj][m][n], 0, 0, 0); __builtin_amdgcn_s_setprio(0); } while (0)
#define PG8_WAIT_V(n) asm volatile("s_waitcnt vmcnt(" #n ")" ::: "memory")
#define PG8_WAIT_L(n) asm volatile("s_waitcnt lgkmcnt(" #n ")" ::: "memory")
#define PG8_BAR __builtin_amdgcn_s_barrier()
#define PG8_SCHED __builtin_amdgcn_sched_barrier(0)
    Unit cur, nxt; int ui = 0;
    if (!S.next(0, cur)) return;
    f32x4 acc[2][2][4][2];
#pragma unroll
    for (int a = 0; a < 2; ++a)
#pragma unroll
        for (int b = 0; b < 2; ++b)
#pragma unroll
            for (int m = 0; m < 4; ++m)
#pragma unroll
                for (int n = 0; n < 2; ++n) acc[a][b][m][n] = (f32x4){0.f, 0.f, 0.f, 0.f};
    bf16x8 At[4][2], B0[2][2], B1[2][2];
    const char* cA = a_tile(g, cur.pm, cur.pn); const char* cB = b_tile(g, cur.pm, cur.pn);
    S.a_ready(cur);
    if constexpr (SP2) {
        PG8_STAGE(PG8_SB(0, 0), cB, voffB); PG8_STAGE(PG8_SB(0, 1), cB + hstepB, voffB); PG8_STAGE(PG8_SA(0, 0), cA, voffA); PG8_STAGE(PG8_SA(0, 1), cA + hstepA, voffA);
        if (wr == 1) PG8_BAR;
        PG8_WAIT_V(2); PG8_BAR;
        PG8_STAGE(PG8_SB(1, 0), cB + kstepB, voffB); PG8_STAGE(PG8_SA(1, 0), cA + kstepA, voffA); PG8_STAGE(PG8_SB(1, 1), cB + hstepB + kstepB, voffB);
        PG8_WAIT_V(6); PG8_BAR;
    } else {
        PG8_STAGE(PG8_SB(0, 0), cB, voffB); PG8_STAGE(PG8_SA(0, 0), cA, voffA); PG8_STAGE(PG8_SB(0, 1), cB + hstepB, voffB); PG8_STAGE(PG8_SA(0, 1), cA + hstepA, voffA);
        if (wr == 1) PG8_BAR;
        PG8_WAIT_V(4); PG8_BAR;
        PG8_STAGE(PG8_SB(1, 0), cB + kstepB, voffB); PG8_STAGE(PG8_SA(1, 0), cA + kstepA, voffA); PG8_STAGE(PG8_SB(1, 1), cB + hstepB + kstepB, voffB);
        PG8_WAIT_V(6); PG8_BAR;
    }
    for (;;) {
        const bool has_next = S.next(ui + 1, nxt);
        const char* nA = has_next ? a_tile(g, nxt.pm, nxt.pn) : cA; const char* nB = has_next ? b_tile(g, nxt.pm, nxt.pn) : cB;
#pragma unroll 1
        for (int t = 0; t < nt; t += 2) {
            const bool last = (t == nt - 2);
            const char* a1 = cA + (size_t)(t + 1) * kstepA;
            const char* a2 = last ? nA : cA + (size_t)(t + 2) * kstepA; const char* b2 = last ? nB : cB + (size_t)(t + 2) * kstepB;
            const char* a3 = a2 + kstepA; const char* b3 = b2 + kstepB;
            if (last && has_next) S.a_ready(nxt);
            if constexpr (SP2) {
            PG8_LDB(B0, 0, 0); PG8_LDB(B1, 0, 1); PG8_SCHED; PG8_LDA(At, 0, 0); PG8_STAGE(PG8_SA(1, 1), a1 + hstepA, voffA);
            PG8_WAIT_V(8); PG8_WAIT_L(0); PG8_BAR; if (PAD == 0 || (padmask(PAD, cur.pn, wc) & 1)) PG8_MMA(0, 0, At, B0); if (PAD == 0 || (padmask(PAD, cur.pn, wc) & 2)) PG8_MMA(0, 1, At, B1); PG8_BAR; PG8_SCHED;
            PG8_LDA(At, 0, 1); PG8_STAGE(PG8_SB(0, 0), b2, voffB); PG8_STAGE(PG8_SB(0, 1), b2 + hstepB, voffB); PG8_STAGE(PG8_SA(0, 0), a2, voffA);
            PG8_WAIT_V(8); PG8_WAIT_L(0); PG8_BAR; if (PAD == 0 || (padmask(PAD, cur.pn, wc) & 1)) PG8_MMA(1, 0, At, B0); if (PAD == 0 || (padmask(PAD, cur.pn, wc) & 2)) PG8_MMA(1, 1, At, B1); PG8_BAR; PG8_SCHED;
            PG8_LDB(B0, 1, 0); PG8_LDB(B1, 1, 1); PG8_SCHED; PG8_LDA(At, 1, 0); PG8_STAGE(PG8_SA(0, 1), a2 + hstepA, voffA);
            PG8_WAIT_V(8); PG8_WAIT_L(0); PG8_BAR; if (PAD == 0 || (padmask(PAD, cur.pn, wc) & 1)) PG8_MMA(0, 0, At, B0); if (PAD == 0 || (padmask(PAD, cur.pn, wc) & 2)) PG8_MMA(0, 1, At, B1); PG8_BAR; PG8_SCHED;
            PG8_LDA(At, 1, 1); PG8_STAGE(PG8_SB(1, 0), b3, voffB); PG8_STAGE(PG8_SB(1, 1), b3 + hstepB, voffB); PG8_STAGE(PG8_SA(1, 0), a3, voffA);
            PG8_WAIT_V(8); PG8_WAIT_L(0); PG8_BAR; if (PAD == 0 || (padmask(PAD, cur.pn, wc) & 1)) PG8_MMA(1, 0, At, B0); if (PAD == 0 || (padmask(PAD, cur.pn, wc) & 2)) PG8_MMA(1, 1, At, B1); PG8_BAR; PG8_SCHED;
            } else {
            PG8_LDB(B0, 0, 0); PG8_SCHED; PG8_LDA(At, 0, 0); PG8_STAGE(PG8_SA(1, 1), a1 + hstepA, voffA);
            PG8_WAIT_L(8); PG8_BAR; PG8_WAIT_L(0); PG8_MMA(0, 0, At, B0); PG8_BAR; PG8_SCHED;
            PG8_LDB(B1, 0, 1); PG8_STAGE(PG8_SB(0, 0), b2, voffB);
            PG8_BAR; PG8_WAIT_L(0); PG8_MMA(0, 1, At, B1); PG8_BAR;
            PG8_LDA(At, 0, 1); PG8_STAGE(PG8_SA(0, 0), a2, voffA);
            PG8_BAR; PG8_WAIT_L(0); PG8_MMA(1, 0, At, B0); PG8_BAR; PG8_SCHED;
            PG8_STAGE(PG8_SB(0, 1), b2 + hstepB, voffB);
            PG8_WAIT_V(6); PG8_BAR; PG8_MMA(1, 1, At, B1); PG8_BAR;
            PG8_LDB(B0, 1, 0); PG8_SCHED; PG8_LDA(At, 1, 0); PG8_STAGE(PG8_SA(0, 1), a2 + hstepA, voffA);
            PG8_WAIT_L(8); PG8_BAR; PG8_WAIT_L(0); PG8_MMA(0, 0, At, B0); PG8_BAR; PG8_SCHED;
            PG8_LDB(B1, 1, 1); PG8_STAGE(PG8_SB(1, 0), b3, voffB);
            PG8_BAR; PG8_WAIT_L(0); PG8_MMA(0, 1, At, B1); PG8_BAR;
            PG8_LDA(At, 1, 1); PG8_STAGE(PG8_SA(1, 0), a3, voffA);
            PG8_BAR; PG8_WAIT_L(0); PG8_MMA(1, 0, At, B0); PG8_BAR; PG8_SCHED;
            PG8_STAGE(PG8_SB(1, 1), b3 + hstepB, voffB);
            PG8_WAIT_V(6); PG8_BAR; PG8_MMA(1, 1, At, B1); PG8_BAR;
            }
        }
        if constexpr (ALIGN_EPI) { if (wr == 0) PG8_BAR; }
        if constexpr (!Epi::AFTER_DRAIN) { unsigned on2_ = ~0u; asm volatile("" : "+s"(on2_)); const int l2_ = (int)__builtin_amdgcn_mbcnt_hi(on2_, __builtin_amdgcn_mbcnt_lo(on2_, 0u));
            E(acc, cur, wr, wc, l2_ & 15, l2_ >> 4); S.done(cur); }
        if (!has_next) break;
#pragma unroll
        for (int a = 0; a < 2; ++a)
#pragma unroll
            for (int b = 0; b < 2; ++b)
#pragma unroll
                for (int m = 0; m < 4; ++m)
#pragma unroll
                    for (int n = 0; n < 2; ++n) acc[a][b][m][n] = (f32x4){0.f, 0.f, 0.f, 0.f};
        cur = nxt; cA = nA; cB = nB; ++ui;
        if constexpr (ALIGN_EPI) { if (wr == 1) PG8_BAR; }
    }
    PG8_WAIT_V(0);
    if constexpr (!ALIGN_EPI) { if (wr == 0) PG8_BAR; }
    PG8_BAR;
    if constexpr (Epi::AFTER_DRAIN) { E.fused(acc, cur, wr, wc, fr, fq, lds, wid, lane); S.done(cur); }
#undef PG8_SA
#undef PG8_SB
#undef PG8_STAGE
#undef PG8_LDA
#undef PG8_LDB
#undef PG8_MMA
#undef PG8_WAIT_V
#undef PG8_WAIT_L
#undef PG8_BAR
#undef PG8_SCHED
}
}
namespace pg8 {
__device__ __forceinline__ float quadsum(float v) {
    auto a = __builtin_amdgcn_permlane16_swap(__float_as_uint(v), __float_as_uint(v), false, false); const float t = __uint_as_float(a[0]) + __uint_as_float(a[1]);
    auto b = __builtin_amdgcn_permlane32_swap(__float_as_uint(t), __float_as_uint(t), false, false); return __uint_as_float(b[0]) + __uint_as_float(b[1]);
}
struct EpiWin {
    static constexpr bool PERM = true, AFTER_DRAIN = false; static constexpr int NST = 16;
    bf16_t* P; const float* ssqx; const float2* rope; float* ssqq; float* ssqkv; int ld, odd;
    __device__ __forceinline__ void operator()(const f32x4 (&acc)[2][2][4][2], const Unit& u, int wr, int wc, int fr, int fq) const {
        const int row0 = u.pm * BM + wr * 64 + fr, cw = u.pn * BM + wc * 32;
        float sx[2][4];
#pragma unroll
        for (int ai = 0; ai < 2; ++ai)
#pragma unroll
            for (int m = 0; m < 4; ++m) sx[ai][m] = ssqx[row0 + ai * HALF + m * 16];
#pragma unroll
        for (int ai = 0; ai < 2; ++ai)
#pragma unroll
            for (int m = 0; m < 4; ++m) {
                const int row = row0 + ai * HALF + m * 16; const float rs = rsqrtf(sx[ai][m] * (1.f / DM) + EPS);
                float sq = 0.f;
#pragma unroll
                for (int bj = 0; bj < 2; ++bj) {
                    const int cg = cw + bj * HALF, c = cg + 8 * fq;
                    f32x4 v0 = acc[ai][bj][m][0] * rs, v1 = acc[ai][bj][m][1] * rs;
                    if (!odd) {
                        if (cg < E_KSWA) sq += (v0[0] * v0[0] + v0[1] * v0[1]) + (v0[2] * v0[2] + v0[3] * v0[3]) + (v1[0] * v1[0] + v1[1] * v1[1]) + (v1[2] * v1[2] + v1[3] * v1[3]);
                        if (cg == E_KPE) { const float2* cs = rope + (size_t)(row & (S - 1)) * 16 + 4 * fq; const float2 c0 = cs[0], c1 = cs[1], c2 = cs[2], c3 = cs[3];
                            const f32x4 a = v0, b = v1;
                            v0[0] = a[0] * c0.x - a[1] * c0.y; v0[1] = a[1] * c0.x + a[0] * c0.y; v0[2] = a[2] * c1.x - a[3] * c1.y; v0[3] = a[3] * c1.x + a[2] * c1.y;
                            v1[0] = b[0] * c2.x - b[1] * c2.y; v1[1] = b[1] * c2.x + b[0] * c2.y; v1[2] = b[2] * c3.x - b[3] * c3.y; v1[3] = b[3] * c3.x + b[2] * c3.y; }
                        else if ((cg >= E_GMLA && cg < E_QSWA) || (cg >= E_GSWA && cg < E_QMEM) || cg >= E_GMEM) {
#pragma unroll
                            for (int i = 0; i < 4; ++i) { v0[i] = silu_f(v0[i]); v1[i] = silu_f(v1[i]); } }
                    } else {
                        if (cg == O_GL) { if (fq < 3) {
#pragma unroll
                            for (int i = 0; i < 4; ++i) { v0[i] = sigm_f(v0[i]); v1[i] = sigm_f(v1[i]); } } }
                        else if ((cg >= O_GNSA && cg < O_QMEM) || cg >= O_GMEM) {
#pragma unroll
                            for (int i = 0; i < 4; ++i) { v0[i] = silu_f(v0[i]); v1[i] = silu_f(v1[i]); } }
                    }
                    u32x4 w; w.x = pk2(v0[0], v0[1]); w.y = pk2(v0[2], v0[3]); w.z = pk2(v1[0], v1[1]); w.w = pk2(v1[2], v1[3]);
                    *(u32x4*)(P + (size_t)row * ld + c) = w;
                }
                if (!odd && u.pn < 2) {
                    sq = quadsum(sq);
                    if (fq == 0) (u.pn == 0 ? ssqq : ssqkv)[(size_t)row * 4 + wc] = sq;
                }
            }
    }
};
struct EpiUp {
    static constexpr bool PERM = true, AFTER_DRAIN = false; static constexpr int NST = 0;
    bf16_t* O; const float* ssqq; const float* ssqkv; const float2* rope;
    __device__ __forceinline__ void operator()(const f32x4 (&acc)[2][2][4][2], const Unit& u, int wr, int wc, int fr, int fq) const {
        const int row0 = u.pm * BM + wr * 64 + fr, c0 = u.pn * BM + wc * 32 + 8 * fq; const bool isq = u.pn < 3;
        float sx[2][4];
#pragma unroll
        for (int ai = 0; ai < 2; ++ai)
#pragma unroll
            for (int m = 0; m < 4; ++m) { const f32x4 pq4 = *(const f32x4*)((isq ? ssqq : ssqkv) + (size_t)(row0 + ai * HALF + m * 16) * 4); sx[ai][m] = (pq4[0] + pq4[1]) + (pq4[2] + pq4[3]); }
#pragma unroll
        for (int ai = 0; ai < 2; ++ai)
#pragma unroll
            for (int m = 0; m < 4; ++m) {
                const int row = row0 + ai * HALF + m * 16;
                const float ssum = sx[ai][m];
                const float rs = rsqrtf(ssum * (isq ? (1.f / 256.f) : (1.f / 128.f)) + EPS);
#pragma unroll
                for (int bj = 0; bj < 2; ++bj) {
                    const int c = c0 + bj * HALF; f32x4 v0 = acc[ai][bj][m][0] * rs, v1 = acc[ai][bj][m][1] * rs;
                    if (isq) { const int j = c % 96;
                        if (j >= 64) { const float2* cs = rope + (size_t)(row & (S - 1)) * 16 + ((j - 64) >> 1); const float2 q0 = cs[0], q1 = cs[1], q2 = cs[2], q3 = cs[3];
                            const f32x4 a = v0, b = v1;
                            v0[0] = a[0] * q0.x - a[1] * q0.y; v0[1] = a[1] * q0.x + a[0] * q0.y; v0[2] = a[2] * q1.x - a[3] * q1.y; v0[3] = a[3] * q1.x + a[2] * q1.y;
                            v1[0] = b[0] * q2.x - b[1] * q2.y; v1[1] = b[1] * q2.x + b[0] * q2.y; v1[2] = b[2] * q3.x - b[3] * q3.y; v1[3] = b[3] * q3.x + b[2] * q3.y; } }
                    u32x4 w; w.x = pk2(v0[0], v0[1]); w.y = pk2(v0[2], v0[3]); w.z = pk2(v1[0], v1[1]); w.w = pk2(v1[2], v1[3]);
                    *(u32x4*)(O + (size_t)row * QKVW + c) = w;
                }
                asm volatile("" ::: "memory");
            }
    }
};
struct EpiStore {
    static constexpr bool PERM = true, AFTER_DRAIN = false; static constexpr int NST = 16;
    bf16_t* O; const float* rscale; float* ssq; int ld;
    __device__ __forceinline__ void operator()(const f32x4 (&acc)[2][2][4][2], const Unit& u, int wr, int wc, int fr, int fq) const {
        const int row0 = u.pm * BM + wr * 64 + fr, c0 = u.pn * BM + wc * 32 + 8 * fq;
        float sx[2][4];
#pragma unroll
        for (int ai = 0; ai < 2; ++ai)
#pragma unroll
            for (int m = 0; m < 4; ++m) sx[ai][m] = rscale ? rscale[row0 + ai * HALF + m * 16] : 1.f;
#pragma unroll
        for (int ai = 0; ai < 2; ++ai)
#pragma unroll
            for (int m = 0; m < 4; ++m) {
                const int row = row0 + ai * HALF + m * 16; const float rs = sx[ai][m]; float sq = 0.f;
#pragma unroll
                for (int bj = 0; bj < 2; ++bj) {
                    const f32x4 v0 = acc[ai][bj][m][0] * rs, v1 = acc[ai][bj][m][1] * rs;
                    sq += (v0[0] * v0[0] + v0[1] * v0[1]) + (v0[2] * v0[2] + v0[3] * v0[3]) + (v1[0] * v1[0] + v1[1] * v1[1]) + (v1[2] * v1[2] + v1[3] * v1[3]);
                    u32x4 w; w.x = pk2(v0[0], v0[1]); w.y = pk2(v0[2], v0[3]); w.z = pk2(v1[0], v1[1]); w.w = pk2(v1[2], v1[3]);
                    *(u32x4*)(O + (size_t)row * ld + c0 + bj * HALF) = w;
                }
                if (ssq) { sq = quadsum(sq); if (fq == 0) ssq[(size_t)row * 16 + u.pn * 4 + wc] = sq; }
            }
    }
};
struct EpiPart {
    static constexpr bool PERM = true, AFTER_DRAIN = false; static constexpr int NST = 0;
    bf16_t* O;
    __device__ __forceinline__ void operator()(const f32x4 (&acc)[2][2][4][2], const Unit& u, int wr, int wc, int fr, int fq) const {
        const int kvq = u.pm >> 5, p32 = u.pm & 31; const int row0 = p32 * BM + wr * 64 + fr, c0 = wc * 32 + 8 * fq; bf16_t* base = O + (size_t)kvq * 8192 * 256;
#pragma unroll
        for (int ai = 0; ai < 2; ++ai)
#pragma unroll
            for (int m = 0; m < 4; ++m) { bf16_t* rp = base + (size_t)(row0 + ai * HALF + m * 16) * 256 + c0;
#pragma unroll
                for (int bj = 0; bj < 2; ++bj) { const f32x4 v0 = acc[ai][bj][m][0], v1 = acc[ai][bj][m][1]; u32x4 w; w.x = pk2(v0[0], v0[1]); w.y = pk2(v0[2], v0[3]); w.z = pk2(v1[0], v1[1]); w.w = pk2(v1[2], v1[3]); *(u32x4*)(rp + bj * HALF) = w; } }
    }
};
struct EpiC1 {
    static constexpr bool PERM = true, AFTER_DRAIN = false; static constexpr int NST = 0;
    bf16_t* O; const float* pb;
    __device__ __forceinline__ void operator()(const f32x4 (&acc)[2][2][4][2], const Unit& u, int wr, int wc, int fr, int fq) const {
        const int row0 = u.pm * BM + wr * 64 + fr, c0 = wc * 32 + 8 * fq;
#pragma unroll
        for (int ai = 0; ai < 2; ++ai)
#pragma unroll
            for (int m = 0; m < 4; ++m) {
                const int row = row0 + ai * HALF + m * 16;
#pragma unroll
                for (int bj = 0; bj < 2; ++bj) { const int c = c0 + bj * HALF; const f32x4 b0 = *(const f32x4*)(pb + c), b1 = *(const f32x4*)(pb + c + 4);
                    f32x4 v0 = acc[ai][bj][m][0] + b0, v1 = acc[ai][bj][m][1] + b1;
#pragma unroll
                    for (int i = 0; i < 4; ++i) { v0[i] = silu_f(v0[i]); v1[i] = silu_f(v1[i]); }
                    u32x4 w; w.x = pk2(v0[0], v0[1]); w.y = pk2(v0[2], v0[3]); w.z = pk2(v1[0], v1[1]); w.w = pk2(v1[2], v1[3]);
                    *(u32x4*)(O + (size_t)row * 256 + c) = w; }
            }
    }
};
}
#ifndef ATT_PROBE
#define ATT_PROBE 0
#endif
namespace att {
constexpr float SM_THR = 8.f;
constexpr int KSLOT = 17408, VSLOT = 20480, KS0 = 0, VS0 = 3 * KSLOT, KPOS = VS0 + 2 * VSLOT  , IMP = 94208, SELW = IMP + 33024  , SELU = SELW + 1024, LUTO = 128512, ATT_LDS_END = LUTO + 4224;
__device__ __forceinline__ int kslot(int i) { return KS0 + i * KSLOT; }
__device__ __forceinline__ int vslot(int i) { return VS0 + i * VSLOT; }
template <int DQK> struct KPitch { static constexpr int v = DQK * 2 + 16; };
template <int DV> struct VPitch { static constexpr int v = (DV == 64) ? 192 : 320; };
__device__ __forceinline__ s16x4 vtr(const LAS char* p) { typedef short v4s __attribute__((ext_vector_type(4))); return __builtin_bit_cast(s16x4, __builtin_amdgcn_ds_read_tr16_b64_v4i16((LAS v4s*)p)); }
__device__ __forceinline__ float swapmax(float v) { auto rr = __builtin_amdgcn_permlane32_swap(__float_as_uint(v), __float_as_uint(v), false, false); return fmaxf(__uint_as_float(rr[0]), __uint_as_float(rr[1])); }
__device__ __forceinline__ float swapsum(float v) { auto rr = __builtin_amdgcn_permlane32_swap(__float_as_uint(v), __float_as_uint(v), false, false); return __uint_as_float(rr[0]) + __uint_as_float(rr[1]); }

struct Src { const bf16_t* K1; const bf16_t* K2; const bf16_t* V; int kld, kld2, vld; const int* kpos; };
template <int DQK, int DV> struct Stage { u32x4 k[(64 * DQK / 8 + 511) / 512]; u32x4 v[(64 * DV / 8 + 511) / 512]; int kp; };

template <int DQK> __device__ __forceinline__ void kchunk(int tid, int i, int& row, int& ch) {
    if (DQK == 96) { if (i == 0) { row = tid >> 3; ch = tid & 7; } else { row = tid >> 2; ch = 8 + (tid & 3); } }
    else { constexpr int CPRK = DQK / 8; const int c = tid + i * 512; row = c / CPRK; ch = c % CPRK; }
}
template <int DQK, int DV, bool POS>
__device__ __forceinline__ void load_k(Stage<DQK, DV>& st, const Src& s, int kt0, int tid) {
    constexpr int CPRK = DQK / 8, NKC = 64 * CPRK;
    const char* b1 = (const char*)(s.K1 + (size_t)kt0 * s.kld); const char* b2 = (DQK == 96) ? (const char*)(s.K2 + (size_t)kt0 * s.kld2) : b1;
#pragma unroll
    for (int i = 0; i < (NKC + 511) / 512; ++i) { int row, ch; kchunk<DQK>(tid, i, row, ch);
        if (DQK == 96 && i == 1) { if (tid < 256) st.k[i] = *(const u32x4*)(b2 + (unsigned)((row * s.kld2 + (ch - 8) * 8) * 2)); }
        else if (NKC % 512 == 0 || DQK == 96 || tid + i * 512 < NKC) st.k[i] = *(const u32x4*)(b1 + (unsigned)((row * s.kld + ch * 8) * 2)); }
    if (POS) st.kp = (tid < 64) ? *(const int*)((const char*)(s.kpos + kt0) + (unsigned)(tid * 4)) : 0;
}
template <int DQK, int DV>
__device__ __forceinline__ void load_v(Stage<DQK, DV>& st, const Src& s, int kt0, int tid) {
    constexpr int CPRV = DV / 8, NVC = 64 * CPRV;
    const char* bv = (const char*)(s.V + (size_t)kt0 * s.vld);
#pragma unroll
    for (int i = 0; i < NVC / 512; ++i) { const int c = tid + i * 512; const int row = c / CPRV, ch = c % CPRV; st.v[i] = *(const u32x4*)(bv + (unsigned)((row * s.vld + ch * 8) * 2)); }
}
template <int DQK, int DV, bool POS>
__device__ __forceinline__ void store_k(const Stage<DQK, DV>& st, LAS char* lds, int ks, int tid) {
    constexpr int CPRK = DQK / 8, NKC = 64 * CPRK, KP = KPitch<DQK>::v;
    LAS char* kb = lds + kslot(ks);
#pragma unroll
    for (int i = 0; i < (NKC + 511) / 512; ++i) { int row, ch; kchunk<DQK>(tid, i, row, ch);
        if (DQK == 96 && i == 1) { if (tid < 256) *(LAS u32x4*)(kb + row * KP + ch * 16) = st.k[i]; }
        else if (NKC % 512 == 0 || DQK == 96 || tid + i * 512 < NKC) *(LAS u32x4*)(kb + row * KP + ch * 16) = st.k[i]; }
    if (POS) { if (tid < 64) ((LAS int*)(lds + KPOS))[ks * 64 + tid] = st.kp; }
}
template <int DQK, int DV>
__device__ __forceinline__ void store_v(const Stage<DQK, DV>& st, LAS char* lds, int vs, int tid) {
    constexpr int CPRV = DV / 8, NVC = 64 * CPRV, VP = VPitch<DV>::v;
    LAS char* vb = lds + vslot(vs);
#pragma unroll
    for (int i = 0; i < NVC / 512; ++i) { const int c = tid + i * 512; const int row = c / CPRV, ch = c % CPRV; *(LAS u32x4*)(vb + row * VP + ch * 16) = st.v[i]; }
}
template <int DQK, int DV, bool POS>
__device__ __forceinline__ void tile_load(Stage<DQK, DV>& st, const Src& s, int kt0, int tid) { load_k<DQK, DV, POS>(st, s, kt0, tid); load_v<DQK, DV>(st, s, kt0, tid); }
template <int DQK, int DV, bool POS>
__device__ __forceinline__ void tile_store(const Stage<DQK, DV>& st, LAS char* lds, int buf, int tid) { store_k<DQK, DV, POS>(st, lds, buf, tid); store_v<DQK, DV>(st, lds, buf, tid); }

struct Col { int qi; int qlim; int pq; int hcol; };
struct Flags { bool causal, window, bias, selm; };

template <int DQK, int DV, bool DO_PV, bool BIAS, bool WINDOWED>
__device__ __forceinline__ void tile_compute(const LAS char* lds, int buf, int kt0, int mode, bool incl, const Col& col, int W, const bf16x8 (&qf)[DQK / 16], f32x16 (&o)[DV / 32], float& m, float& l,
                                             f32x16& p0, f32x16& p1, int lane) {
    constexpr int KP = KPitch<DQK>::v, VP = VPitch<DV>::v;
    int hi = lane >> 5; asm volatile("" : "+v"(hi));
    const int r32 = lane & 31;
    const LAS char* kb = lds + kslot(buf) + r32 * KP + hi * 16;
    p0 = (f32x16){0}; p1 = (f32x16){0};
#pragma unroll
    for (int st = 0; st < DQK / 16; ++st) {
        const bf16x8 k0 = *(const LAS bf16x8*)(kb + st * 32), k1 = *(const LAS bf16x8*)(kb + 32 * KP + st * 32);
        p0 = __builtin_amdgcn_mfma_f32_32x32x16_bf16(k0, qf[st], p0, 0, 0, 0);
        p1 = __builtin_amdgcn_mfma_f32_32x32x16_bf16(k1, qf[st], p1, 0, 0, 0);
        if ((st & 1) == 1) asm volatile("" ::: "memory");
    }
    float cb = 0.f;
    if (BIAS) {
        const LAS float* lut = (const LAS float*)(lds + LUTO) + col.hcol * 132;
        if (mode == 2) {
            const LAS int* kp = (const LAS int*)(lds + KPOS) + buf * 64 + 4 * hi;
#pragma unroll
            for (int r = 0; r < 16; ++r) { const int ko = (r & 3) + 8 * (r >> 2);
                int d0 = col.pq - kp[ko], d1 = col.pq - kp[ko + 32]; d0 = d0 < 0 ? 0 : (d0 > 128 ? 128 : d0); d1 = d1 < 0 ? 0 : (d1 > 128 ? 128 : d1);
                p0[r] += lut[d0]; p1[r] += lut[d1]; if ((r & 3) == 3) asm volatile("" ::: "memory"); }
        } else cb = lut[128];
    }
    if (mode == 2) {
        const int up = col.qlim - kt0 - 4 * hi; const int lo = WINDOWED ? (col.qi - W - kt0 - 4 * hi) : -1;
#pragma unroll
        for (int r = 0; r < 16; ++r) { const int ko = (r & 3) + 8 * (r >> 2);
            bool v0 = ko <= up, v1 = (ko + 32) <= up;
            if (WINDOWED) { v0 = v0 && (ko > lo); v1 = v1 && ((ko + 32) > lo); }
            p0[r] = v0 ? p0[r] : NEG; p1[r] = v1 ? p1[r] : NEG; }
    }
    float a = fmaxf(fmaxf(p0[0], p0[1]), p1[0]), b = fmaxf(fmaxf(p0[2], p0[3]), p1[1]); a = fmaxf(fmaxf(a, p1[2]), p1[3]);
#pragma unroll
    for (int r = 4; r < 16; r += 4) { a = fmaxf(fmaxf(a, p0[r]), p0[r + 1]); b = fmaxf(fmaxf(b, p0[r + 2]), p0[r + 3]); a = fmaxf(fmaxf(a, p1[r]), p1[r + 1]); b = fmaxf(fmaxf(b, p1[r + 2]), p1[r + 3]); }
    float tmax = swapmax(fmaxf(a, b)) + cb;
    if (!incl) tmax = NEG;
    if (__builtin_amdgcn_ballot_w64(tmax - m > SM_THR) != 0ull) { const float mnew = fmaxf(m, tmax); const float f = __builtin_amdgcn_exp2f(m - mnew); l *= f; m = mnew;
        if (DO_PV) {
#pragma unroll
            for (int bk = 0; bk < DV / 32; ++bk)
#pragma unroll
                for (int r = 0; r < 16; ++r) o[bk][r] *= f; } }
    const float off = (incl && m > -1e29f) ? (cb - m) : NEG;
    float sum = 0.f;
#pragma unroll
    for (int r = 0; r < 16; ++r) { p0[r] = __builtin_amdgcn_exp2f(p0[r] + off); p1[r] = __builtin_amdgcn_exp2f(p1[r] + off); sum += p0[r] + p1[r]; }
    l += sum;
    if (DO_PV) {
        const LAS char* vb = lds + vslot(buf) + (4 * hi + ((lane & 15) >> 2)) * VP + (((lane >> 4) & 1) * 16 + (lane & 3) * 4) * 2;
#pragma unroll
        for (int sub = 0; sub < 2; ++sub)
#pragma unroll
            for (int ks = 0; ks < 2; ++ks) {
                u32x4 pw;
                if (sub == 0) { pw.x = pk2(p0[8 * ks], p0[8 * ks + 1]); pw.y = pk2(p0[8 * ks + 2], p0[8 * ks + 3]); pw.z = pk2(p0[8 * ks + 4], p0[8 * ks + 5]); pw.w = pk2(p0[8 * ks + 6], p0[8 * ks + 7]); }
                else          { pw.x = pk2(p1[8 * ks], p1[8 * ks + 1]); pw.y = pk2(p1[8 * ks + 2], p1[8 * ks + 3]); pw.z = pk2(p1[8 * ks + 4], p1[8 * ks + 5]); pw.w = pk2(p1[8 * ks + 6], p1[8 * ks + 7]); }
                const bf16x8 pb = __builtin_bit_cast(bf16x8, pw);
#pragma unroll
                for (int bk = 0; bk < DV / 32; ++bk) {
                    const LAS char* vp = vb + (32 * sub + 16 * ks) * VP + bk * 64;
                    const s16x4 lo = vtr(vp), hi4 = vtr(vp + 8 * VP);
                    const bf16x8 va = __builtin_shufflevector(lo, hi4, 0, 1, 2, 3, 4, 5, 6, 7);
                    o[bk] = __builtin_amdgcn_mfma_f32_32x32x16_bf16(va, pb, o[bk], 0, 0, 0);
                }
                asm volatile("" ::: "memory");
            }
    }
}

template <int DQK> __device__ __forceinline__ void qk_part(const LAS char* lds, int ks, const bf16x8 (&qf)[DQK / 16], f32x16& s0, f32x16& s1, int lane) {
    constexpr int KP = KPitch<DQK>::v; const LAS char* kb = lds + kslot(ks) + (lane & 31) * KP + (lane >> 5) * 16;
    s0 = (f32x16){0}; s1 = (f32x16){0};
#pragma unroll
    for (int st = 0; st < DQK / 16; ++st) {
        const bf16x8 k0 = *(const LAS bf16x8*)(kb + st * 32), k1 = *(const LAS bf16x8*)(kb + 32 * KP + st * 32);
        s0 = __builtin_amdgcn_mfma_f32_32x32x16_bf16(k0, qf[st], s0, 0, 0, 0);
        s1 = __builtin_amdgcn_mfma_f32_32x32x16_bf16(k1, qf[st], s1, 0, 0, 0);
    }
}
template <int DQK> __device__ __forceinline__ void load_kf(const LAS char* lds, int ks, bf16x8 (&kf)[DQK / 16][2], int lane) {
    constexpr int KP = KPitch<DQK>::v; const LAS char* kb = lds + kslot(ks) + (lane & 31) * KP + (lane >> 5) * 16;
#pragma unroll
    for (int st = 0; st < DQK / 16; ++st) { kf[st][0] = *(const LAS bf16x8*)(kb + st * 32); kf[st][1] = *(const LAS bf16x8*)(kb + 32 * KP + st * 32); }
}
template <int DQK> __device__ __forceinline__ void qk_pipe(const LAS char* lds, int ks, const bf16x8 (&qf)[DQK / 16], f32x16& n0, f32x16& n1, int lane) {
    constexpr int KP = KPitch<DQK>::v, NG = DQK / 8; const LAS char* kb = lds + kslot(ks) + (lane & 31) * KP + (lane >> 5) * 16;
    n0 = (f32x16){0}; n1 = (f32x16){0};
    bf16x8 f0 = *(const LAS bf16x8*)(kb), f1 = *(const LAS bf16x8*)(kb + 32 * KP), f2 = *(const LAS bf16x8*)(kb + 32);
#pragma unroll
    for (int g = 0; g < NG; ++g) {
        bf16x8 f3 = f2;
        if (g + 3 < NG) f3 = *(const LAS bf16x8*)(kb + ((g + 3) & 1) * 32 * KP + ((g + 3) >> 1) * 32);
        if (g & 1) n1 = __builtin_amdgcn_mfma_f32_32x32x16_bf16(f0, qf[g >> 1], n1, 0, 0, 0); else n0 = __builtin_amdgcn_mfma_f32_32x32x16_bf16(f0, qf[g >> 1], n0, 0, 0, 0);
        __builtin_amdgcn_sched_barrier(0);
        f0 = f1; f1 = f2; f2 = f3;
    }
}
template <int DV, bool BIAS, bool WINDOWED, bool DO_PV>
__device__ __forceinline__ float max_part(const LAS char* lds, int ks, int kt0, int mode, bool incl, const Col& col, int W, f32x16 (&o)[DV / 32], float& m, float& l, f32x16& p0, f32x16& p1, int lane) {
    int hi = lane >> 5; asm volatile("" : "+v"(hi));
    float cb = 0.f;
    if (BIAS) {
        const LAS float* lut = (const LAS float*)(lds + LUTO) + col.hcol * 132;
        if (mode == 2) {
            const LAS int* kp = (const LAS int*)(lds + KPOS) + ks * 64 + 4 * hi;
#pragma unroll
            for (int r = 0; r < 16; ++r) { const int ko = (r & 3) + 8 * (r >> 2);
                int d0 = col.pq - kp[ko], d1 = col.pq - kp[ko + 32]; d0 = d0 < 0 ? 0 : (d0 > 128 ? 128 : d0); d1 = d1 < 0 ? 0 : (d1 > 128 ? 128 : d1);
                p0[r] += lut[d0]; p1[r] += lut[d1]; if ((r & 3) == 3) asm volatile("" ::: "memory"); }
        } else cb = lut[128];
    }
    if (mode == 2) {
        const int up = col.qlim - kt0 - 4 * hi; const int lo = WINDOWED ? (col.qi - W - kt0 - 4 * hi) : -1;
#pragma unroll
        for (int r = 0; r < 16; ++r) { const int ko = (r & 3) + 8 * (r >> 2);
            bool v0 = ko <= up, v1 = (ko + 32) <= up;
            if (WINDOWED) { v0 = v0 && (ko > lo); v1 = v1 && ((ko + 32) > lo); }
            p0[r] = v0 ? p0[r] : NEG; p1[r] = v1 ? p1[r] : NEG; }
    }
    float a = fmaxf(fmaxf(p0[0], p0[1]), p1[0]), b = fmaxf(fmaxf(p0[2], p0[3]), p1[1]); a = fmaxf(fmaxf(a, p1[2]), p1[3]);
#pragma unroll
    for (int r = 4; r < 16; r += 4) { a = fmaxf(fmaxf(a, p0[r]), p0[r + 1]); b = fmaxf(fmaxf(b, p0[r + 2]), p0[r + 3]); a = fmaxf(fmaxf(a, p1[r]), p1[r + 1]); b = fmaxf(fmaxf(b, p1[r + 2]), p1[r + 3]); }
    float tmax = swapmax(fmaxf(a, b)) + cb;
    if (!incl) tmax = NEG;
    if (__builtin_amdgcn_ballot_w64(tmax - m > SM_THR) != 0ull) { const float mnew = fmaxf(m, tmax); const float f = __builtin_amdgcn_exp2f(m - mnew); l *= f; m = mnew;
        if (DO_PV) {
#pragma unroll
            for (int bk = 0; bk < DV / 32; ++bk)
#pragma unroll
                for (int r = 0; r < 16; ++r) o[bk][r] *= f; } }
    return (incl && m > -1e29f) ? (cb - m) : NEG;
}
template <int DQK, bool WITHQK>
__device__ __forceinline__ void exp_part(const bf16x8 (&kf)[DQK / 16][2], const bf16x8 (&qf)[DQK / 16], float off, float& l, f32x16& p0, f32x16& p1, f32x16& n0, f32x16& n1, int lane) {
    if (WITHQK) { n0 = (f32x16){0}; n1 = (f32x16){0};
#pragma unroll
        for (int st = 0; st < DQK / 16; ++st) { n0 = __builtin_amdgcn_mfma_f32_32x32x16_bf16(kf[st][0], qf[st], n0, 0, 0, 0); n1 = __builtin_amdgcn_mfma_f32_32x32x16_bf16(kf[st][1], qf[st], n1, 0, 0, 0); }
#if ATT_PROBE == 1
        { f32x16 x0 = (f32x16){0}, x1 = (f32x16){0};
#pragma unroll
          for (int st = 0; st < DQK / 16; ++st) { x0 = __builtin_amdgcn_mfma_f32_32x32x16_bf16(kf[st][0], qf[st], x0, 0, 0, 0); x1 = __builtin_amdgcn_mfma_f32_32x32x16_bf16(kf[st][1], qf[st], x1, 0, 0, 0); }
          asm volatile("" :: "v"(x0), "v"(x1)); }
#endif
    }
#if ATT_PROBE == 7
    { float j0 = p0[0], j1 = p0[1], j2 = p0[2], j3 = p0[3], j4 = p0[4], j5 = p0[5], j6 = p0[6], j7 = p0[7];
#pragma unroll
      for (int i = 0; i < 8; ++i) { j0 = j0 * 1.0001f + 0.5f; j1 = j1 * 1.0001f + 0.5f; j2 = j2 * 1.0001f + 0.5f; j3 = j3 * 1.0001f + 0.5f; j4 = j4 * 1.0001f + 0.5f; j5 = j5 * 1.0001f + 0.5f; j6 = j6 * 1.0001f + 0.5f; j7 = j7 * 1.0001f + 0.5f; }
      asm volatile("" :: "v"(j0), "v"(j1), "v"(j2), "v"(j3), "v"(j4), "v"(j5), "v"(j6), "v"(j7)); }
#endif
#if ATT_PROBE == 8
    { float e0 = __builtin_amdgcn_exp2f(p0[0] + 1.f), e1 = __builtin_amdgcn_exp2f(p0[1] + 1.f), e2 = __builtin_amdgcn_exp2f(p0[2] + 1.f), e3 = __builtin_amdgcn_exp2f(p0[3] + 1.f);
      float e4 = __builtin_amdgcn_exp2f(p0[4] + 1.f), e5 = __builtin_amdgcn_exp2f(p0[5] + 1.f), e6 = __builtin_amdgcn_exp2f(p0[6] + 1.f), e7 = __builtin_amdgcn_exp2f(p0[7] + 1.f);
      float f0 = __builtin_amdgcn_exp2f(p1[0] + 1.f), f1 = __builtin_amdgcn_exp2f(p1[1] + 1.f), f2 = __builtin_amdgcn_exp2f(p1[2] + 1.f), f3 = __builtin_amdgcn_exp2f(p1[3] + 1.f);
      float f4 = __builtin_amdgcn_exp2f(p1[4] + 1.f), f5 = __builtin_amdgcn_exp2f(p1[5] + 1.f), f6 = __builtin_amdgcn_exp2f(p1[6] + 1.f), f7 = __builtin_amdgcn_exp2f(p1[7] + 1.f);
      asm volatile("" :: "v"(e0), "v"(e1), "v"(e2), "v"(e3), "v"(e4), "v"(e5), "v"(e6), "v"(e7), "v"(f0), "v"(f1), "v"(f2), "v"(f3), "v"(f4), "v"(f5), "v"(f6), "v"(f7)); }
#endif
    float sum = 0.f;
#if ATT_PROBE == 2
    { float junk = 0.f;
#pragma unroll
      for (int r = 0; r < 16; ++r) { junk += __builtin_amdgcn_exp2f(p0[r] + off + 1.f) + __builtin_amdgcn_exp2f(p1[r] + off + 1.f); }
      asm volatile("" :: "v"(junk)); }
#endif
#pragma unroll
    for (int r = 0; r < 16; ++r) { p0[r] = __builtin_amdgcn_exp2f(p0[r] + off); p1[r] = __builtin_amdgcn_exp2f(p1[r] + off); sum += p0[r] + p1[r]; }
    l += sum;
}
template <int DQK> __device__ __forceinline__ void exp_part_qk(const bf16x8 (&kf)[DQK / 16][2], const bf16x8 (&qf)[DQK / 16], f32x16& n0, f32x16& n1) {
    n0 = (f32x16){0}; n1 = (f32x16){0};
#pragma unroll
    for (int st = 0; st < DQK / 16; ++st) { n0 = __builtin_amdgcn_mfma_f32_32x32x16_bf16(kf[st][0], qf[st], n0, 0, 0, 0); n1 = __builtin_amdgcn_mfma_f32_32x32x16_bf16(kf[st][1], qf[st], n1, 0, 0, 0); }
}
template <int DV> __device__ __forceinline__ void pv_part(const LAS char* lds, int vs, const f32x16& p0, const f32x16& p1, f32x16 (&o)[DV / 32], int lane) {
    constexpr int VP = VPitch<DV>::v; const int hi = lane >> 5;
    const LAS char* vb = lds + vslot(vs) + (4 * hi + ((lane & 15) >> 2)) * VP + (((lane >> 4) & 1) * 16 + (lane & 3) * 4) * 2;
#pragma unroll
    for (int sub = 0; sub < 2; ++sub)
#pragma unroll
        for (int ks = 0; ks < 2; ++ks) {
            u32x4 pw;
            if (sub == 0) { pw.x = pk2(p0[8 * ks], p0[8 * ks + 1]); pw.y = pk2(p0[8 * ks + 2], p0[8 * ks + 3]); pw.z = pk2(p0[8 * ks + 4], p0[8 * ks + 5]); pw.w = pk2(p0[8 * ks + 6], p0[8 * ks + 7]); }
            else          { pw.x = pk2(p1[8 * ks], p1[8 * ks + 1]); pw.y = pk2(p1[8 * ks + 2], p1[8 * ks + 3]); pw.z = pk2(p1[8 * ks + 4], p1[8 * ks + 5]); pw.w = pk2(p1[8 * ks + 6], p1[8 * ks + 7]); }
            const bf16x8 pb = __builtin_bit_cast(bf16x8, pw);
#pragma unroll
            for (int bk = 0; bk < DV / 32; ++bk) {
                const LAS char* vp = vb + (32 * sub + 16 * ks) * VP + bk * 64;
                const s16x4 lo = vtr(vp), hi4 = vtr(vp + 8 * VP);
                const bf16x8 va = __builtin_shufflevector(lo, hi4, 0, 1, 2, 3, 4, 5, 6, 7);
                o[bk] = __builtin_amdgcn_mfma_f32_32x32x16_bf16(va, pb, o[bk], 0, 0, 0);
            }
        }
}
}
namespace att {
struct Wv { int l0, l1, q0, q1; };
__device__ __forceinline__ float headsum4(float w) {
    const float t = w + __builtin_bit_cast(float, __builtin_amdgcn_update_dpp(0, __builtin_bit_cast(int, w), 0x128  , 0xf, 0xf, false));
    auto rr = __builtin_amdgcn_permlane16_swap(__float_as_uint(t), __float_as_uint(t), false, false);
    return __uint_as_float(rr[0]) + __uint_as_float(rr[1]);
}
template <int CTRL> __device__ __forceinline__ float dppf(float v) { return __builtin_bit_cast(float, __builtin_amdgcn_update_dpp(0, __builtin_bit_cast(int, v), CTRL, 0xf, 0xf, false)); }
template <int CTRL> __device__ __forceinline__ int dppi(int v) { return __builtin_amdgcn_update_dpp(0, v, CTRL, 0xf, 0xf, false); }
__device__ __forceinline__ void imp_add(LAS char* lds, const f32x16& p0, const f32x16& p1, int kt0, float il, int ql, int lane) {
    LAS float* imp = (LAS float*)(lds + IMP); const int r32 = lane & 31, hi = lane >> 5;
#pragma unroll
    for (int sub = 0; sub < 2; ++sub)
#pragma unroll
        for (int g4 = 0; g4 < 4; ++g4) {
            const float a0 = sub ? p1[4 * g4] : p0[4 * g4], a1 = sub ? p1[4 * g4 + 1] : p0[4 * g4 + 1], a2 = sub ? p1[4 * g4 + 2] : p0[4 * g4 + 2], a3 = sub ? p1[4 * g4 + 3] : p0[4 * g4 + 3];
            float w = (a0 + a1 + a2 + 0.5f * a3) * il, w2 = 0.5f * a3 * il;
            w = headsum4(w); w2 = headsum4(w2);
            const int j = (kt0 + 32 * sub + 8 * g4 + 4 * hi) >> 2;
            if ((r32 >> 3) == 0) { atomicAdd((float*)(imp + ql * 129 + j), w); if (j + 1 < 128) atomicAdd((float*)(imp + ql * 129 + j + 1), w2); }
        }
}
template <int DQK, int DV, bool DO_PV, bool BIAS, bool WINDOWED, bool CAUSAL, bool SELM, bool IMPT = false>
__device__ __forceinline__ void run_branch(LAS char* lds, const Src& src, int t_lo, int t_hi, const Wv& wv, const Col& col, int W, int pmq, const int2* pmm,
                                           const unsigned long long sello, const unsigned long long selhi, const bf16x8 (&qf)[DQK / 16], f32x16 (&o)[DV / 32], float& m, float& l, f32x16& pA0, f32x16& pA1, int tid_in, int lane_in, float imp_il = 0.f, int imp_ql = 0) {
    int lane = lane_in; asm volatile("" : "+v"(lane));
    const int tid = (tid_in & ~63) | lane;
    unsigned long long ulo = 0ull, uhi = 0ull;
    if (SELM) { const LAS unsigned* selu = (const LAS unsigned*)(lds + SELU);
        ulo = (unsigned long long)(unsigned)__builtin_amdgcn_readfirstlane((int)selu[0]) | ((unsigned long long)(unsigned)__builtin_amdgcn_readfirstlane((int)selu[1]) << 32);
        uhi = (unsigned long long)(unsigned)__builtin_amdgcn_readfirstlane((int)selu[2]) | ((unsigned long long)(unsigned)__builtin_amdgcn_readfirstlane((int)selu[3]) << 32); }
    auto want = [&](int t) -> bool { return !SELM || ((((t < 64) ? ulo : uhi) >> (t & 63)) & 1ull); };
    auto nxt = [&](int t) -> int { ++t; while (t <= t_hi && !want(t)) ++t; return t; };
    auto classify = [&](int t) -> int { const int kt0 = t * 64; bool skip = false, allv = true;
        if (CAUSAL) { skip = kt0 > wv.l1; allv = (kt0 + 63 <= wv.l0); }
        if (WINDOWED) { skip = skip || (wv.q0 - (kt0 + 63) >= W); allv = allv && (wv.q1 - kt0 < W); }
        bool farb = true; if (BIAS) { farb = (pmq - pmm[t].y >= 128); }
        return (!skip && allv && farb) ? 1 : 2; };
    auto inc = [&](int t) -> bool { if (!SELM) return true; const unsigned long long w = (t < 64) ? sello : selhi; return (w >> (t & 63)) & 1ull; };
    int tc = t_lo - 1; tc = nxt(tc);
    if (tc > t_hi) return;
    int tn = nxt(tc), tnn = (tn <= t_hi) ? nxt(tn) : tn;
    Stage<DQK, DV> st;
    {   Stage<DQK, DV> s2;
        tile_load<DQK, DV, BIAS>(st, src, tc * 64, tid); if (tn <= t_hi) load_k<DQK, DV, BIAS>(s2, src, tn * 64, tid);
        tile_store<DQK, DV, BIAS>(st, lds, 0, tid); if (tn <= t_hi) store_k<DQK, DV, BIAS>(s2, lds, 1, tid); }
    __syncthreads();
    int ik = 0, iv = 0;
    f32x16 pB0, pB1;
    qk_part<DQK>(lds, 0, qf, pA0, pA1, lane);
#define ATT_STEP(c0, c1, n0, n1) { \
        const bool hasNN = tnn <= t_hi; \
        if (ATT_PROBE == 3) { Stage<DQK, DV> sj; if (hasNN) load_k<DQK, DV, BIAS>(sj, src, tnn * 64, tid); load_v<DQK, DV>(sj, src, tn * 64, tid); asm volatile("" :: "v"(sj.k[0]), "v"(sj.v[0])); } \
        if (hasNN) load_k<DQK, DV, BIAS>(st, src, tnn * 64, tid); \
        load_v<DQK, DV>(st, src, tn * 64, tid); \
        const int ikn = (ik == 2) ? 0 : ik + 1, iknn = (ikn == 2) ? 0 : ikn + 1; \
        if (!SELM || __builtin_amdgcn_ballot_w64(inc(tn)) != 0ull) qk_pipe<DQK>(lds, ikn, qf, n0, n1, lane);     \
        const bool incl_ = inc(tc); \
        if (!SELM || __builtin_amdgcn_ballot_w64(incl_) != 0ull) {     \
            const float off = max_part<DV, BIAS, WINDOWED, DO_PV>(lds, ik, tc * 64, classify(tc), incl_, col, W, o, m, l, c0, c1, lane); \
            bf16x8 kfd_[DQK / 16][2]; exp_part<DQK, false>(kfd_, qf, off, l, c0, c1, n0, n1, lane); \
            if (IMPT) imp_add(lds, c0, c1, tc * 64, imp_il, imp_ql, lane); \
            if (DO_PV) pv_part<DV>(lds, iv, c0, c1, o, lane); } \
        if (hasNN) store_k<DQK, DV, BIAS>(st, lds, iknn, tid); \
        store_v<DQK, DV>(st, lds, iv ^ 1, tid); \
        __syncthreads(); if (ATT_PROBE == 4) { __syncthreads(); __syncthreads(); } \
        tc = tn; tn = tnn; tnn = hasNN ? nxt(tnn) : tnn; ik = ikn; iv ^= 1; }
    bool inA = true;
    while (tn <= t_hi) {
        ATT_STEP(pA0, pA1, pB0, pB1)
        if (!(tn <= t_hi)) { inA = false; break; }
        ATT_STEP(pB0, pB1, pA0, pA1)
    }
#undef ATT_STEP
    if (!inA) { pA0 = pB0; pA1 = pB1; }
    {   const bool inclf = inc(tc);
        if (!SELM || __builtin_amdgcn_ballot_w64(inclf) != 0ull) {
            const float off = max_part<DV, BIAS, WINDOWED, DO_PV>(lds, ik, tc * 64, classify(tc), inclf, col, W, o, m, l, pA0, pA1, lane);
            bf16x8 kfd[DQK / 16][2]; exp_part<DQK, false>(kfd, qf, off, l, pA0, pA1, pB0, pB1, lane);
            if (IMPT) imp_add(lds, pA0, pA1, tc * 64, imp_il, imp_ql, lane);
            if (DO_PV) pv_part<DV>(lds, iv, pA0, pA1, o, lane); } }
    __syncthreads();
}
template <int DQK, int DV, bool DO_PV, bool BIAS, bool WINDOWED, bool CAUSAL, bool SELM>
__device__ __forceinline__ void run_branch_np(LAS char* lds, const Src& src, int t_lo, int t_hi, const Wv& wv, const Col& col, int W, int pmq, const int2* pmm,
                                           const unsigned long long sello, const unsigned long long selhi, const bf16x8 (&qf)[DQK / 16], f32x16 (&o)[DV / 32], float& m, float& l, f32x16& p0, f32x16& p1, int tid, int lane) {
    const LAS unsigned* selu = (const LAS unsigned*)(lds + SELU);
    auto want = [&](int t) -> bool { return !SELM || ((selu[t >> 5] >> (t & 31)) & 1u); };
    int t = t_lo; while (t <= t_hi && !want(t)) ++t;
    if (t > t_hi) return;
    Stage<DQK, DV> st;
    tile_load<DQK, DV, BIAS>(st, src, t * 64, tid); tile_store<DQK, DV, BIAS>(st, lds, 0, tid); __syncthreads();
    int buf = 0;
    for (;;) {
        int tn = t + 1; while (tn <= t_hi && !want(tn)) ++tn;
        const bool has = tn <= t_hi;
        if (has) tile_load<DQK, DV, BIAS>(st, src, tn * 64, tid);
        const int kt0 = t * 64;
        int mode;
        {   bool skip = false, allv = true;
            if (CAUSAL) { skip = kt0 > wv.l1; allv = (kt0 + 63 <= wv.l0); }
            if (WINDOWED) { skip = skip || (wv.q0 - (kt0 + 63) >= W); allv = allv && (wv.q1 - kt0 < W); }
            bool farb = true; if (BIAS) { farb = (pmq - pmm[t].y >= 128); }
            mode = skip ? 0 : ((allv && farb) ? 1 : 2); }
        bool incl = true;
        if (SELM) { const unsigned long long w = (t < 64) ? sello : selhi; incl = (w >> (t & 63)) & 1ull; }
        if (mode) tile_compute<DQK, DV, DO_PV, BIAS, WINDOWED>(lds, buf, kt0, mode, incl, col, W, qf, o, m, l, p0, p1, lane);
        if (has) tile_store<DQK, DV, BIAS>(st, lds, buf ^ 1, tid);
        __syncthreads();
        if (!has) break;
        t = tn; buf ^= 1;
    }
}
template <int DV> __device__ __forceinline__ void store_col(const f32x16 (&o)[DV / 32], float inv, const bf16_t* gate, bf16_t* out, int hi) {
    u32x2 gw[DV / 32][4];
#pragma unroll
    for (int bk = 0; bk < DV / 32; ++bk)
#pragma unroll
        for (int g4 = 0; g4 < 4; ++g4) gw[bk][g4] = *(const u32x2*)(gate + 32 * bk + 8 * g4 + 4 * hi);
#pragma unroll
    for (int bk = 0; bk < DV / 32; ++bk)
#pragma unroll
        for (int gp = 0; gp < 2; ++gp) {
            u32x2 w[2];
#pragma unroll
            for (int e = 0; e < 2; ++e) { const int g4 = 2 * gp + e; const u32x2 g = gw[bk][g4];
                const float g0 = __uint_as_float(g.x << 16), g1 = __uint_as_float(g.x & 0xffff0000u), g2 = __uint_as_float(g.y << 16), g3 = __uint_as_float(g.y & 0xffff0000u);
                w[e].x = pk2(o[bk][4 * g4] * inv * g0, o[bk][4 * g4 + 1] * inv * g1); w[e].y = pk2(o[bk][4 * g4 + 2] * inv * g2, o[bk][4 * g4 + 3] * inv * g3); }
            auto sx = __builtin_amdgcn_permlane32_swap(w[0].x, w[1].x, false, false); auto sy = __builtin_amdgcn_permlane32_swap(w[0].y, w[1].y, false, false);
            u32x4 v; v.x = sx[0]; v.y = sy[0]; v.z = sx[1]; v.w = sy[1];
            *(u32x4*)(out + 32 * bk + 8 * (2 * gp + hi)) = v; }
}
struct Ptrs { const bf16_t* PROJ; const bf16_t* QKV; const bf16_t* MKV; const bf16_t* KC; const bf16_t* VC; bf16_t* ATT; const int* pos; const int* cpos; const int2* pmm; const int2* cpmm; const float* sinks; int layer; };

__device__ __forceinline__ void unit_mla(LAS char* lds, const Ptrs& P, int b, int h, int qb, int tid_in, int lane_in, int wid) {
    int lane = lane_in; asm volatile("" : "+v"(lane)); const int tid = (tid_in & ~63) | lane;
    const int r32 = lane & 31, hi = lane >> 5, q0 = qb * 256, wq0 = q0 + 32 * wid, qi = wq0 + r32; const size_t row = (size_t)b * S + qi;
    bf16x8 qf[6]; { const bf16_t* qp = P.QKV + row * QKVW + h * 96 + 8 * hi;
#pragma unroll
        for (int s = 0; s < 6; ++s) qf[s] = *(const bf16x8*)(qp + 16 * s); }
    const Src src{P.QKV + (size_t)b * S * QKVW + 768 + h * 128, P.PROJ + (size_t)b * S * PE + E_KPE, P.QKV + (size_t)b * S * QKVW + 768 + h * 128 + 64, QKVW, PE, QKVW, nullptr};
    const Wv wv{wq0, wq0 + 31, wq0, wq0 + 31}; const Col col{qi, qi, 0, 0};
    f32x16 o[2] = {{0}, {0}}, p0, p1; float m = NEG, l = 0.f;
    run_branch<96, 64, true, false, false, true, false>(lds, src, 0, (q0 + 255) >> 6, wv, col, 0, 0, nullptr, 0ull, 0ull, qf, o, m, l, p0, p1, tid, lane);
    l = swapsum(l);
    store_col<64>(o, 1.f / fmaxf(l, 1e-30f), P.PROJ + row * PE + E_GMLA + h * 64, P.ATT + row * 1536 + h * 64, hi);
}
__device__ __forceinline__ void sm_update(f32x16& p0, f32x16& p1, bool near, int up, float& m, float& l, f32x16 (&o)[2]) {
    if (near) {
#pragma unroll
        for (int r = 0; r < 16; ++r) { const int ko = (r & 3) + 8 * (r >> 2); p0[r] = (ko <= up) ? p0[r] : NEG; p1[r] = (ko + 32 <= up) ? p1[r] : NEG; } }
    float a = fmaxf(fmaxf(p0[0], p0[1]), p1[0]), b = fmaxf(fmaxf(p0[2], p0[3]), p1[1]); a = fmaxf(fmaxf(a, p1[2]), p1[3]);
#pragma unroll
    for (int r = 4; r < 16; r += 4) { a = fmaxf(fmaxf(a, p0[r]), p0[r + 1]); b = fmaxf(fmaxf(b, p0[r + 2]), p0[r + 3]); a = fmaxf(fmaxf(a, p1[r]), p1[r + 1]); b = fmaxf(fmaxf(b, p1[r + 2]), p1[r + 3]); }
    const float tmax = swapmax(fmaxf(a, b));
    if (__builtin_amdgcn_ballot_w64(tmax - m > SM_THR) != 0ull) { const float mnew = fmaxf(m, tmax); const float f = __builtin_amdgcn_exp2f(m - mnew); l *= f; m = mnew;
#pragma unroll
        for (int bk = 0; bk < 2; ++bk)
#pragma unroll
            for (int r = 0; r < 16; ++r) o[bk][r] *= f; }
    const float off = (m > -1e29f) ? -m : NEG; float sum = 0.f;
#pragma unroll
    for (int r = 0; r < 16; ++r) { p0[r] = __builtin_amdgcn_exp2f(p0[r] + off); p1[r] = __builtin_amdgcn_exp2f(p1[r] + off); sum += p0[r] + p1[r]; }
    l += sum;
}
__device__ __forceinline__ void unit_mla2(LAS char* lds, const Ptrs& P, int b, int h, int qb2, int tid_in, int lane_in, int wid) {
    int lane = lane_in; asm volatile("" : "+v"(lane)); const int tid = (tid_in & ~63) | lane;
    constexpr int KP = KPitch<96>::v, VP = VPitch<64>::v;
    const int r32 = lane & 31, hi = lane >> 5, q0 = qb2 * 512, wq0 = q0 + 64 * wid, qiA = wq0 + r32, qiB = qiA + 32; const size_t rowA = (size_t)b * S + qiA;
    bf16x8 qfA[6], qfB[6]; { const bf16_t* qp = P.QKV + rowA * QKVW + h * 96 + 8 * hi;
#pragma unroll
        for (int s = 0; s < 6; ++s) { qfA[s] = *(const bf16x8*)(qp + 16 * s); qfB[s] = *(const bf16x8*)(qp + (size_t)32 * QKVW + 16 * s); } }
    const Src src{P.QKV + (size_t)b * S * QKVW + 768 + h * 128, P.PROJ + (size_t)b * S * PE + E_KPE, P.QKV + (size_t)b * S * QKVW + 768 + h * 128 + 64, QKVW, PE, QKVW, nullptr};
    f32x16 oA[2] = {{0}, {0}}, oB[2] = {{0}, {0}}; float mA = NEG, lA = 0.f, mB = NEG, lB = 0.f;
    const int T = (q0 + 511) >> 6, tw = wq0 >> 6;
    Stage<96, 64> st;
    tile_load<96, 64, false>(st, src, 0, tid); tile_store<96, 64, false>(st, lds, 0, tid); __syncthreads();
    int buf = 0;
    for (int t = 0; t <= T; ++t) {
        const bool has = t < T;
        if (has) tile_load<96, 64, false>(st, src, (t + 1) * 64, tid);
        if (t <= tw) {
            const int kt0 = t * 64; const bool near = (t == tw);
            int hl = lane >> 5; asm volatile("" : "+v"(hl));
            const LAS char* kb = lds + kslot(buf) + r32 * KP + hl * 16;
            f32x16 pA0 = {0}, pA1 = {0}, pB0 = {0}, pB1 = {0};
            __builtin_amdgcn_s_setprio(1);
#pragma unroll
            for (int s = 0; s < 6; ++s) { const bf16x8 k0 = *(const LAS bf16x8*)(kb + s * 32), k1 = *(const LAS bf16x8*)(kb + 32 * KP + s * 32);
                pA0 = __builtin_amdgcn_mfma_f32_32x32x16_bf16(k0, qfA[s], pA0, 0, 0, 0); pB0 = __builtin_amdgcn_mfma_f32_32x32x16_bf16(k0, qfB[s], pB0, 0, 0, 0);
                pA1 = __builtin_amdgcn_mfma_f32_32x32x16_bf16(k1, qfA[s], pA1, 0, 0, 0); pB1 = __builtin_amdgcn_mfma_f32_32x32x16_bf16(k1, qfB[s], pB1, 0, 0, 0); }
            __builtin_amdgcn_s_setprio(0);
            sm_update(pA0, pA1, near, qiA - kt0 - 4 * hl, mA, lA, oA);
            sm_update(pB0, pB1, near, qiB - kt0 - 4 * hl, mB, lB, oB);
            __builtin_amdgcn_s_setprio(1);
            const LAS char* vb = lds + vslot(buf) + (4 * hl + ((lane & 15) >> 2)) * VP + (((lane >> 4) & 1) * 16 + (lane & 3) * 4) * 2;
#pragma unroll
            for (int sub = 0; sub < 2; ++sub)
#pragma unroll
                for (int ks = 0; ks < 2; ++ks) {
                    u32x4 wa, wb;
                    if (sub == 0) { wa.x = pk2(pA0[8 * ks], pA0[8 * ks + 1]); wa.y = pk2(pA0[8 * ks + 2], pA0[8 * ks + 3]); wa.z = pk2(pA0[8 * ks + 4], pA0[8 * ks + 5]); wa.w = pk2(pA0[8 * ks + 6], pA0[8 * ks + 7]);
                                    wb.x = pk2(pB0[8 * ks], pB0[8 * ks + 1]); wb.y = pk2(pB0[8 * ks + 2], pB0[8 * ks + 3]); wb.z = pk2(pB0[8 * ks + 4], pB0[8 * ks + 5]); wb.w = pk2(pB0[8 * ks + 6], pB0[8 * ks + 7]); }
                    else          { wa.x = pk2(pA1[8 * ks], pA1[8 * ks + 1]); wa.y = pk2(pA1[8 * ks + 2], pA1[8 * ks + 3]); wa.z = pk2(pA1[8 * ks + 4], pA1[8 * ks + 5]); wa.w = pk2(pA1[8 * ks + 6], pA1[8 * ks + 7]);
                                    wb.x = pk2(pB1[8 * ks], pB1[8 * ks + 1]); wb.y = pk2(pB1[8 * ks + 2], pB1[8 * ks + 3]); wb.z = pk2(pB1[8 * ks + 4], pB1[8 * ks + 5]); wb.w = pk2(pB1[8 * ks + 6], pB1[8 * ks + 7]); }
                    const bf16x8 pa = __builtin_bit_cast(bf16x8, wa), pb = __builtin_bit_cast(bf16x8, wb);
#pragma unroll
                    for (int bk = 0; bk < 2; ++bk) { const LAS char* vp = vb + (32 * sub + 16 * ks) * VP + bk * 64;
                        const s16x4 lo = vtr(vp), hi4 = vtr(vp + 8 * VP); const bf16x8 va = __builtin_shufflevector(lo, hi4, 0, 1, 2, 3, 4, 5, 6, 7);
                        oA[bk] = __builtin_amdgcn_mfma_f32_32x32x16_bf16(va, pa, oA[bk], 0, 0, 0); oB[bk] = __builtin_amdgcn_mfma_f32_32x32x16_bf16(va, pb, oB[bk], 0, 0, 0); }
                }
            __builtin_amdgcn_s_setprio(0);
        }
        if (has) tile_store<96, 64, false>(st, lds, buf ^ 1, tid);
        __syncthreads();
        buf ^= 1;
    }
    lA = swapsum(lA); lB = swapsum(lB);
    store_col<64>(oA, 1.f / fmaxf(lA, 1e-30f), P.PROJ + rowA * PE + E_GMLA + h * 64, P.ATT + rowA * 1536 + h * 64, hi);
    store_col<64>(oB, 1.f / fmaxf(lB, 1e-30f), P.PROJ + (rowA + 32) * PE + E_GMLA + h * 64, P.ATT + (rowA + 32) * 1536 + h * 64, hi);
}
__device__ __forceinline__ void unit_mem(LAS char* lds, const Ptrs& P, int b, int h, int qb, int ld, int qc, int gc, int ldo, int oc, int tid_in, int lane_in, int wid) {
    int lane = lane_in; asm volatile("" : "+v"(lane)); const int tid = (tid_in & ~63) | lane;
    const int r32 = lane & 31, hi = lane >> 5, qi = qb * 256 + 32 * wid + r32; const size_t row = (size_t)b * S + qi;
    bf16x8 qf[8]; { const bf16_t* qp = P.PROJ + row * ld + qc + h * 128 + 8 * hi;
#pragma unroll
        for (int s = 0; s < 8; ++s) qf[s] = *(const bf16x8*)(qp + 16 * s); }
    const bf16_t* kv = P.MKV + (size_t)b * MEML * 4096 + P.layer * 1024 + h * 128;
    const Src src{kv, nullptr, kv + 512, 4096, 0, 4096, nullptr};
    const Wv wv{1 << 30, 1 << 30, qi, qi}; const Col col{qi, 1 << 30, 0, 0};
    f32x16 o[4] = {{0}, {0}, {0}, {0}}, p0, p1; float m = NEG, l = 0.f;
    run_branch_np<128, 128, true, false, false, false, false>(lds, src, 0, 3, wv, col, 0, 0, nullptr, 0ull, 0ull, qf, o, m, l, p0, p1, tid, lane);
    l = swapsum(l);
    store_col<128>(o, 1.f / l, P.PROJ + row * ld + gc + h * 128, P.ATT + row * ldo + oc + h * 128, hi);
}
__device__ __forceinline__ void unit_swa(LAS char* lds, const Ptrs& P, int b, int g, int qblk, int tid_in, int lane_in, int wid) {
    int lane = lane_in; asm volatile("" : "+v"(lane)); const int tid = (tid_in & ~63) | lane;
    const int r32 = lane & 31, hi = lane >> 5, q0 = qblk * 64, wq0 = q0 + 8 * wid, qi = wq0 + (r32 & 7), hc = 4 * g + (r32 >> 3); const size_t row = (size_t)b * S + qi;
    bf16x8 qf[4]; { const bf16_t* qp = P.PROJ + row * PE + E_QSWA + hc * 64 + 8 * hi;
#pragma unroll
        for (int s = 0; s < 4; ++s) qf[s] = *(const bf16x8*)(qp + 16 * s); }
    const Src src{P.PROJ + (size_t)b * S * PE + E_KSWA + g * 64, nullptr, P.PROJ + (size_t)b * S * PE + E_VSWA + g * 64, PE, 0, PE, P.pos};
    const Wv wv{wq0, wq0 + 7, wq0, wq0 + 7}; const Col col{qi, qi, P.pos[qi], hc};
    f32x16 o[2] = {{0}, {0}}, p0, p1; float m = P.sinks[hc] * LOG2E, l = hi ? 0.f : 1.f;
    run_branch<64, 64, true, true, true, true, false>(lds, src, qblk >= 2 ? qblk - 2 : 0, qblk, wv, col, 128, P.pmm[qblk].x, P.pmm, 0ull, 0ull, qf, o, m, l, p0, p1, tid, lane);
    l = swapsum(l);
    store_col<64>(o, 1.f / fmaxf(l, 1e-30f), P.PROJ + row * PE + E_GSWA + hc * 64, P.ATT + row * 1536 + 512 + hc * 64, hi);
}
__device__ __forceinline__ void unit_nsa(LAS char* lds, const Ptrs& P, int b, int g, int cur, int tid_in, int lane_in, int wid) {
    int lane = lane_in; asm volatile("" : "+v"(lane)); const int tid = (tid_in & ~63) | lane;
    const int r32 = lane & 31, hi = lane >> 5, q0 = cur * 64, ql = 8 * wid + (r32 & 7), qi = q0 + ql, hc = 4 * g + (r32 >> 3); const size_t row = (size_t)b * S + qi;
    bf16x8 qf[4]; { const bf16_t* qp = P.PROJ + row * PO + O_Q + hc * 64 + 8 * hi;
#pragma unroll
        for (int s = 0; s < 4; ++s) qf[s] = *(const bf16x8*)(qp + 16 * s); }
    LAS float* imp = (LAS float*)(lds + IMP); LAS unsigned* selws = (LAS unsigned*)(lds + SELW); LAS unsigned* selu = (LAS unsigned*)(lds + SELU);
    for (int i = tid; i < 64 * 129; i += 512) imp[i] = 0.f;
    if (tid < 4) selu[tid] = 0u;
    const int pq = P.pos[qi], pmq = P.pmm[cur].x, wq0 = q0 + 8 * wid;
    f32x16 o[2], p0, p1; unsigned long long sello = 0ull, selhi = 0ull;
#define NSA_GL (P.PROJ + ((size_t)b * S + qi) * PO + O_GL + hc * 3)
    {   const int cl = (qi >= 31) ? ((qi - 31) >> 4) : -1; const int cl0 = (wq0 >= 31) ? ((wq0 - 31) >> 4) : -1, cl1 = (wq0 + 7 >= 31) ? ((wq0 + 7 - 31) >> 4) : -1;
        const int tmax = ((q0 + 63 - 31) >> 4) >> 6;
        const Src src{P.KC + (size_t)(b * 2 + g) * 512 * 64, nullptr, P.VC + (size_t)(b * 2 + g) * 512 * 64, 64, 0, 64, P.cpos};
        const Wv wv{cl0, cl1, wq0, wq0 + 7}; const Col col{qi, cl, pq, hc};
        float m = NEG, l = 0.f; o[0] = (f32x16){0}; o[1] = (f32x16){0};
        run_branch<64, 64, false, true, false, true, false>(lds, src, 0, tmax, wv, col, 0, pmq, P.cpmm, 0ull, 0ull, qf, o, m, l, p0, p1, tid, lane);
        l = swapsum(l); const float il = 1.f / fmaxf(l, 1e-30f);
        {   float l2 = 0.f;
            run_branch<64, 64, true, true, false, true, false, true>(lds, src, 0, tmax, wv, col, 0, pmq, P.cpmm, 0ull, 0ull, qf, o, m, l2, p0, p1, tid, lane, il, ql); }
#pragma unroll
        for (int bk = 0; bk < 2; ++bk)
#pragma unroll
            for (int r = 0; r < 16; ++r) o[bk][r] *= bf2f(NSA_GL[0]) * il;
    }
    {   int lk = lane; asm volatile("" : "+v"(lk)); const int qsel = 8 * wid + (lk >> 3), s = lk & 7; unsigned mk[4] = {0, 0, 0, 0};
        if (cur <= 15) { mk[0] = (cur == 31) ? 0xffffffffu : ((1u << (cur + 1)) - 1u); }
        else {
            float v[16];
#pragma unroll
            for (int t = 0; t < 16; ++t) { const int j = 16 * s + t; v[t] = (j >= 1 && j <= cur - 2) ? imp[qsel * 129 + j] : -1.f; }
            mk[0] = 1u;
            #pragma unroll
            for (int w = 0; w < 4; ++w) { if ((cur >> 5) == w) mk[w] |= 1u << (cur & 31); if (((cur - 1) >> 5) == w) mk[w] |= 1u << ((cur - 1) & 31); }
            for (int rnd = 0; rnd < 13; ++rnd) {
                float best = v[0]; int bi = 0;
#pragma unroll
                for (int t = 1; t < 16; ++t) if (v[t] > best) { best = v[t]; bi = t; }
                int bj = 16 * s + bi;
                { const float ov = dppf<0xB1>(best); const int oj = dppi<0xB1>(bj); if (ov > best || (ov == best && oj < bj)) { best = ov; bj = oj; } }
                { const float ov = dppf<0x4E>(best); const int oj = dppi<0x4E>(bj); if (ov > best || (ov == best && oj < bj)) { best = ov; bj = oj; } }
                { const float ov = dppf<0x141>(best); const int oj = dppi<0x141>(bj); if (ov > best || (ov == best && oj < bj)) { best = ov; bj = oj; } }
                if (best >= 0.f) {
#pragma unroll
                    for (int t = 0; t < 16; ++t) if (16 * s + t == bj) v[t] = -1.f;
#pragma unroll
                    for (int w = 0; w < 4; ++w) if ((bj >> 5) == w) mk[w] |= 1u << (bj & 31);
                }
            }
        }
        if (s == 0) {
#pragma unroll
            for (int w = 0; w < 4; ++w) { selws[qsel * 4 + w] = mk[w]; atomicOr((unsigned*)(selu + w), mk[w]); } }
    }
    __syncthreads();
    sello = (unsigned long long)selws[ql * 4 + 0] | ((unsigned long long)selws[ql * 4 + 1] << 32); selhi = (unsigned long long)selws[ql * 4 + 2] | ((unsigned long long)selws[ql * 4 + 3] << 32);
#define NSA_STASH ((LAS bf16_t*)(lds + IMP) + wid * 2048 + r32 * 64 + 4 * hi)
#pragma unroll
    for (int bk = 0; bk < 2; ++bk)
#pragma unroll
        for (int g4 = 0; g4 < 4; ++g4) { u32x2 w; w.x = pk2(o[bk][4 * g4], o[bk][4 * g4 + 1]); w.y = pk2(o[bk][4 * g4 + 2], o[bk][4 * g4 + 3]); *(LAS u32x2*)(NSA_STASH + 32 * bk + 8 * g4) = w; }
    {   const Src src{P.PROJ + (size_t)b * S * PO + O_KSLC + g * 64, nullptr, P.PROJ + (size_t)b * S * PO + O_VSLC + g * 64, PO, 0, PO, P.pos};
        const Wv wv{wq0, wq0 + 7, wq0, wq0 + 7}; const Col col{qi, qi, pq, hc};
        float m = NEG, l = 0.f; o[0] = (f32x16){0}; o[1] = (f32x16){0};
        run_branch<64, 64, true, true, false, true, true>(lds, src, 0, cur, wv, col, 0, pmq, P.pmm, sello, selhi, qf, o, m, l, p0, p1, tid, lane);
        l = swapsum(l); const float il = bf2f(NSA_GL[1]) / fmaxf(l, 1e-30f);
#pragma unroll
        for (int bk = 0; bk < 2; ++bk)
#pragma unroll
            for (int g4 = 0; g4 < 4; ++g4) { const u32x2 pv = *(const LAS u32x2*)(NSA_STASH + 32 * bk + 8 * g4);
                u32x2 w; w.x = pk2(__uint_as_float(pv.x << 16) + il * o[bk][4 * g4], __uint_as_float(pv.x & 0xffff0000u) + il * o[bk][4 * g4 + 1]);
                w.y = pk2(__uint_as_float(pv.y << 16) + il * o[bk][4 * g4 + 2], __uint_as_float(pv.y & 0xffff0000u) + il * o[bk][4 * g4 + 3]); *(LAS u32x2*)(NSA_STASH + 32 * bk + 8 * g4) = w; }
    }
    {   const Src src{P.PROJ + (size_t)b * S * PO + O_KWIN + g * 64, nullptr, P.PROJ + (size_t)b * S * PO + O_VWIN + g * 64, PO, 0, PO, P.pos};
        const Wv wv{wq0, wq0 + 7, wq0, wq0 + 7}; const Col col{qi, qi, pq, hc};
        float m = NEG, l = 0.f; o[0] = (f32x16){0}; o[1] = (f32x16){0};
        run_branch<64, 64, true, true, true, true, false>(lds, src, cur >= 8 ? cur - 8 : 0, cur, wv, col, 512, pmq, P.pmm, 0ull, 0ull, qf, o, m, l, p0, p1, tid, lane);
        l = swapsum(l); const float il = bf2f(NSA_GL[2]) / fmaxf(l, 1e-30f);
#pragma unroll
        for (int bk = 0; bk < 2; ++bk)
#pragma unroll
            for (int g4 = 0; g4 < 4; ++g4) { const u32x2 pv = *(const LAS u32x2*)(NSA_STASH + 32 * bk + 8 * g4);
                o[bk][4 * g4] = __uint_as_float(pv.x << 16) + il * o[bk][4 * g4]; o[bk][4 * g4 + 1] = __uint_as_float(pv.x & 0xffff0000u) + il * o[bk][4 * g4 + 1];
                o[bk][4 * g4 + 2] = __uint_as_float(pv.y << 16) + il * o[bk][4 * g4 + 2]; o[bk][4 * g4 + 3] = __uint_as_float(pv.y & 0xffff0000u) + il * o[bk][4 * g4 + 3]; }
    }
    store_col<64>(o, 1.f, P.PROJ + ((size_t)b * S + qi) * PO + O_GNSA + hc * 64, P.ATT + ((size_t)b * S + qi) * 1024 + hc * 64, hi);
#undef NSA_GL
#undef NSA_STASH
}
}
#define XB_TMO      128
#define XB_XCNT(j)  (256  + 64 * (j))
#define XB_XSUB(j)  (1280 + 64 * (j))
#define XB_XGEN(j)  (2304 + 64 * (j))
#define XB_TOP      3328
#define XB_TOPGEN   3392
#define XCD_BAR_WORDS 3456
#define XB_SPIN_CAP (1u << 18)
__device__ __forceinline__ unsigned xb_ld(unsigned* p)              { return __hip_atomic_load(p, __ATOMIC_RELAXED, __HIP_MEMORY_SCOPE_AGENT); }
__device__ __forceinline__ unsigned xb_add(unsigned* p, unsigned v) { return __hip_atomic_fetch_add(p, v, __ATOMIC_RELAXED, __HIP_MEMORY_SCOPE_AGENT); }
__device__ __forceinline__ unsigned xb_xcc_id() { return (unsigned)__builtin_amdgcn_s_getreg((3 << 11) | 20) & 0xFu; }
#define XB_SPIN(cond, bar) do { unsigned _sp = 0; while (cond) { __builtin_amdgcn_s_sleep(1); \
    if ((++_sp & 255u) == 0u) { if (xb_ld(&(bar)[XB_TMO])) break; if (_sp > XB_SPIN_CAP) { atomicAdd(&(bar)[XB_TMO], 1u); break; } } } } while (0)
struct XcdBarrier { unsigned* bar; unsigned x; volatile LAS unsigned* st; };
__device__ __forceinline__ XcdBarrier xcd_barrier_post(unsigned* bar, volatile LAS unsigned* st, bool leader) {
    XcdBarrier b; b.bar = bar; b.x = xb_xcc_id(); b.st = st;
    if (leader) (void)xb_add(&bar[XB_XCNT(b.x)], 1u);
    return b;
}
__device__ __forceinline__ void xcd_barrier_complete(unsigned* bar, unsigned x, unsigned& nloc, unsigned& nx) {
    const unsigned G = gridDim.x * gridDim.y * gridDim.z;
    unsigned sum, cnt, mine, sp = 0u;
    for (;;) {
        sum = 0u; cnt = 0u; mine = 0u;
#pragma unroll
        for (unsigned j = 0; j < 16; ++j) { const unsigned c = xb_ld(&bar[XB_XCNT(j)]); sum += c; cnt += (c > 0u) ? 1u : 0u; mine = (j == x) ? c : mine; }
        if (sum == G) break;
        __builtin_amdgcn_s_sleep(1);
        if ((++sp & 255u) == 0u) { if (xb_ld(&bar[XB_TMO])) break; if (sp > XB_SPIN_CAP) { atomicAdd(&bar[XB_TMO], 1u); break; } }
    }
    nloc = mine > 0u ? mine : 1u; nx = cnt > 0u ? cnt : 1u;
}
__device__ __forceinline__ void xcd_barrier(const XcdBarrier& b, bool leader) {
    asm volatile("s_waitcnt vmcnt(0)" ::: "memory");
    __syncthreads();
    if (leader) {
        unsigned* bar = b.bar;
        __builtin_amdgcn_s_waitcnt(0);
        unsigned nloc = b.st[0], nx = b.st[1];
        if (nloc == 0u) { xcd_barrier_complete(bar, b.x, nloc, nx); b.st[0] = nloc; b.st[1] = nx; }
        const unsigned old = xb_add(&bar[XB_XSUB(b.x)], 1u);
        const unsigned gen = old / nloc;
        if (old + 1u == (gen + 1u) * nloc) {
            __builtin_amdgcn_fence(__ATOMIC_RELEASE, "agent");
            asm volatile("s_waitcnt vmcnt(0)" ::: "memory");
            const unsigned og = xb_add(&bar[XB_TOP], 1u);
            const unsigned tg = og / nx;
            if (og + 1u == (tg + 1u) * nx) xb_add(&bar[XB_TOPGEN], 1u);
            else XB_SPIN(xb_ld(&bar[XB_TOPGEN]) == tg, bar);
            __builtin_amdgcn_fence(__ATOMIC_ACQUIRE, "agent");
            xb_add(&bar[XB_XGEN(b.x)], 1u);
            asm volatile("s_waitcnt vmcnt(0)" ::: "memory");
        } else {
            XB_SPIN(xb_ld(&bar[XB_XGEN(b.x)]) == gen, bar);
            __builtin_amdgcn_fence(__ATOMIC_ACQUIRE, "agent");
            asm volatile("s_waitcnt vmcnt(0)" ::: "memory");
        }
    }
    __syncthreads();
}

constexpr int NWAVES = 8, RING_BYTES = 131072, MISC_OFF = 143360, LDS_BYTES = 147456;
struct Args { const void* in[23]; float* out; unsigned char* ws; int ph_lo, ph_hi, li, pad; };

template <class F> __device__ __forceinline__ void conv_item(F src, int K, bf16_t* Wt, LAS float* scr, int item, int nblk, int lane) {
    const int kb = item / nblk, nb = item % nblk, k0 = 64 * kb, n0 = 32 * nb;
    bool vec; { float ma, mb; const float* pa = src(k0, n0 + 4 * (lane & 7), ma); const float* pb = src(k0, n0 + 4 * (lane & 7) + 3, mb); vec = __builtin_amdgcn_ballot_w64(!((pa == nullptr && pb == nullptr) || (pa != nullptr && pb == pa + 3))) == 0ull; }
    if (vec) { const int kr = lane >> 3, c4 = 4 * (lane & 7);
        f32x4 f0, f1, f2, f3, f4, f5, f6, f7;
#define CV_LD(F_, I_) { float m_; const float* p_ = src(k0 + 8 * (I_) + kr, n0 + c4, m_); F_ = p_ ? __builtin_nontemporal_load((const f32x4*)p_) * m_ : (f32x4){0.f, 0.f, 0.f, 0.f}; }
        CV_LD(f0, 0) CV_LD(f1, 1) CV_LD(f2, 2) CV_LD(f3, 3) CV_LD(f4, 4) CV_LD(f5, 5) CV_LD(f6, 6) CV_LD(f7, 7)
#undef CV_LD
#define CV_ST(F_, I_) { LAS float* d_ = scr + (8 * (I_) + kr) * 33 + c4; d_[0] = F_[0]; d_[1] = F_[1]; d_[2] = F_[2]; d_[3] = F_[3]; }
        CV_ST(f0, 0) CV_ST(f1, 1) CV_ST(f2, 2) CV_ST(f3, 3) CV_ST(f4, 4) CV_ST(f5, 5) CV_ST(f6, 6) CV_ST(f7, 7)
#undef CV_ST
    } else {
#pragma unroll 8
        for (int i = 0; i < 32; ++i) { const int kk = 2 * i + (lane >> 5); float m_; const float* p_ = src(k0 + kk, n0 + (lane & 31), m_); scr[kk * 33 + (lane & 31)] = p_ ? *p_ * m_ : 0.f; }
    }
    asm volatile("s_waitcnt lgkmcnt(0)" ::: "memory");
    const int c = lane & 7;
#pragma unroll
    for (int j = 0; j < 4; ++j) { const int n = (lane >> 3) + 8 * j; const LAS float* sp = scr + (8 * c) * 33 + n;
        u32x4 o; o.x = pk2(sp[0], sp[33]); o.y = pk2(sp[2 * 33], sp[3 * 33]); o.z = pk2(sp[4 * 33], sp[5 * 33]); o.w = pk2(sp[6 * 33], sp[7 * 33]);
        *(u32x4*)(Wt + (size_t)(n0 + n) * K + k0 + 8 * c) = o; }
    asm volatile("s_waitcnt lgkmcnt(0)" ::: "memory");
}
__device__ __forceinline__ int map_even(int n, float& sc) {
    sc = 1.f;
    if (n < 256) return n; if (n < 384) return 256 + (n - 256); if (n < 512) return 1440 + (n - 384); if (n < 640) return 1568 + (n - 512);
    if (n < 672) { const int j = n - 640; return 384 + ((j & 1) ? (j >> 1) + 16 : (j >> 1)); }
    if (n < 768) return -1; if (n < 1280) return 416 + (n - 768);
    if (n < 1792) { sc = 0.125f * LOG2E; return 928 + (n - 1280); } if (n < 2304) return 1696 + (n - 1792);
    if (n < 2816) { sc = 0.08838834764831845f * LOG2E; return 2208 + (n - 2304); } return 2720 + (n - 2816);
}
__device__ __forceinline__ int map_odd(int n, float& sc) {
    sc = 1.f;
    if (n < 512) { sc = 0.125f * LOG2E; return n; } if (n < 1304) return n; if (n < 1536) return -1; if (n < 2048) return 1304 + (n - 1536);
    if (n < 2560) { sc = 0.08838834764831845f * LOG2E; return 1816 + (n - 2048); } return 2328 + (n - 2560);
}
template <bool WF32> __device__ __forceinline__ float resid_run(const u32x4 yw, const u32x4 xw, const f32x4 g0, const f32x4 g1, float rs, f32x4& r0, f32x4& r1) {
    f32x4 v0, v1;
    v0[0] = __uint_as_float(xw.x << 16) + __uint_as_float(yw.x << 16) * rs * g0[0]; v0[1] = __uint_as_float(xw.x & 0xffff0000u) + __uint_as_float(yw.x & 0xffff0000u) * rs * g0[1];
    v0[2] = __uint_as_float(xw.y << 16) + __uint_as_float(yw.y << 16) * rs * g0[2]; v0[3] = __uint_as_float(xw.y & 0xffff0000u) + __uint_as_float(yw.y & 0xffff0000u) * rs * g0[3];
    v1[0] = __uint_as_float(xw.z << 16) + __uint_as_float(yw.z << 16) * rs * g1[0]; v1[1] = __uint_as_float(xw.z & 0xffff0000u) + __uint_as_float(yw.z & 0xffff0000u) * rs * g1[1];
    v1[2] = __uint_as_float(xw.w << 16) + __uint_as_float(yw.w << 16) * rs * g1[2]; v1[3] = __uint_as_float(xw.w & 0xffff0000u) + __uint_as_float(yw.w & 0xffff0000u) * rs * g1[3];
    if (WF32) { r0 = v0; r1 = v1; }
    else { r0[0] = __uint_as_float(pk2(v0[0], v0[1])); r0[1] = __uint_as_float(pk2(v0[2], v0[3])); r0[2] = __uint_as_float(pk2(v1[0], v1[1])); r0[3] = __uint_as_float(pk2(v1[2], v1[3])); }
    return ((v0[0] * v0[0] + v0[1] * v0[1]) + (v0[2] * v0[2] + v0[3] * v0[3])) + ((v1[0] * v1[0] + v1[1] * v1[1]) + (v1[2] * v1[2] + v1[3] * v1[3]));
}
__device__ __forceinline__ float row16_sum(float v) {
    v += __builtin_bit_cast(float, __builtin_amdgcn_update_dpp(0, __builtin_bit_cast(int, v), 0xB1, 0xf, 0xf, false));
    v += __builtin_bit_cast(float, __builtin_amdgcn_update_dpp(0, __builtin_bit_cast(int, v), 0x4E, 0xf, 0xf, false));
    v += __builtin_bit_cast(float, __builtin_amdgcn_update_dpp(0, __builtin_bit_cast(int, v), 0x141, 0xf, 0xf, false));
    v += __builtin_bit_cast(float, __builtin_amdgcn_update_dpp(0, __builtin_bit_cast(int, v), 0x140, 0xf, 0xf, false));
    return v;
}
constexpr int N_PHASES = 24;
#ifndef MK_SITES
#define MK_SITES 0x1fff
#endif
#define SITE(k) (((MK_SITES) >> (k)) & 1)
#ifndef MK_UNITS
#define MK_UNITS 15
#endif
#ifndef MK_DUP
#define MK_DUP 0
#endif
#define NREP(k) ((((MK_DUP) >> (k)) & 1) ? 2 : 1)
__global__ void __launch_bounds__(NWAVES * 64, 2) mega(Args a) {
    extern __shared__ __attribute__((aligned(16))) unsigned char lds_raw[];
    LAS unsigned char* lds = (LAS unsigned char*)lds_raw;
    volatile LAS unsigned* MISC = (volatile LAS unsigned*)(lds + MISC_OFF);
    const int tid0 = threadIdx.x; const int wid0 = __builtin_amdgcn_readfirstlane(tid0 >> 6);
    const int G = gridDim.x, bx = blockIdx.x, NGW = G * NWAVES;
#define WSB() unsigned long long wz_ = 0ull; asm volatile("" : "+s"(wz_)); unsigned char* ws = a.ws + wz_;     unsigned* ctl = (unsigned*)(ws + WS_CTL); (void)ctl; \
    unsigned ones_ = ~0u; asm volatile("" : "+s"(ones_)); const int lane = (int)__builtin_amdgcn_mbcnt_hi(ones_, __builtin_amdgcn_mbcnt_lo(ones_, 0u)); int wid_ = wid0; asm volatile("" : "+s"(wid_)); const int wid = wid_, tid = wid * 64 + lane, gw = bx * NWAVES + wid; (void)tid; (void)gw
#define PTR_STATS() float* ssqx = (float*)(ws + WS_SSQX); float* ssqq = (float*)(ws + WS_SSQQ4); float* ssqkv = (float*)(ws + WS_SSQKV4); float* ssqy = (float*)(ws + WS_SSQY16); (void)ssqx; (void)ssqq; (void)ssqkv; (void)ssqy
#define PTR_ACT() bf16_t* XB = (bf16_t*)out  ; bf16_t* ATT = (bf16_t*)(ws + WS_A); bf16_t* PROJ = (bf16_t*)(ws + WS_B); bf16_t* Y = (bf16_t*)(ws + WS_B); bf16_t* QKV = (bf16_t*)(ws + WS_C); (void)XB; (void)ATT; (void)PROJ; (void)Y; (void)QKV
    float* const out = a.out;
    for (int u = tid0; u < (LDS_BYTES - MISC_OFF) / 4; u += NWAVES * 64) ((LAS unsigned*)(lds + MISC_OFF))[u] = 0u;
    __syncthreads();
    XcdBarrier bar; bar.bar = (unsigned*)(a.ws + WS_CTL) + CW_BAR + a.li * XCD_BAR_WORDS; bar.x = 0; bar.st = nullptr;
    if (!MK_PER_PHASE) bar = xcd_barrier_post((unsigned*)(a.ws + WS_CTL) + CW_BAR + a.li * XCD_BAR_WORDS, MISC + 8, tid0 == 0);
    const int lo = a.ph_lo, hi = a.ph_hi;
#define IN(k) (lo <= (k) && (k) < hi)
#define SEAM(k) do { if ((k) + 1 < hi) xcd_barrier(bar, tid == 0); } while (0)
#define Q_INIT() do { if (tid == 0) { MISC[5] = 0u; MISC[6] = 0u; } } while (0)
#define Q_NEXT(head, NQ, dst, dq) do { __syncthreads(); if (tid == 0) { unsigned q_ = MISC[5], tr_ = MISC[6]; int u_ = -1; const unsigned x_ = xb_xcc_id() & 7u; \
        while (tr_ < 8u) { const unsigned v_ = __hip_atomic_fetch_add((head) + ((x_ + q_) & 7u) * 64, 1u, __ATOMIC_RELAXED, __HIP_MEMORY_SCOPE_AGENT); if (v_ < (unsigned)(NQ)) { u_ = (int)v_; break; } ++q_; ++tr_; } \
        MISC[5] = q_; MISC[6] = tr_; MISC[4] = (unsigned)u_; MISC[7] = (x_ + q_) & 7u; } __syncthreads(); (dst) = (int)MISC[4]; (dq) = (int)MISC[7]; } while (0)
#define STAGE_LUT() do { const float* lut_ = (const float*)(ws + WS_LUT); for (int i_ = tid; i_ < 8 * 132; i_ += NWAVES * 64) ((LAS float*)(lds + att::LUTO))[i_] = lut_[i_]; __syncthreads(); } while (0)

    if (SITE(0) && IN(0)) {
        WSB(); PTR_STATS(); PTR_ACT();
        const float* x = (const float*)a.in[0]; const float* mem = (const float*)a.in[1]; const int* pos = (const int*)a.in[2]; const float* table = (const float*)a.in[3];
        const float* norm_pre = (const float*)a.in[4]; const float* mem_norm = (const float*)a.in[6]; const float* w_mem_kv = (const float*)a.in[7];
        const float* w_in_even = (const float*)a.in[8]; const float* mla_q_norm = (const float*)a.in[9]; const float* mla_kv_norm = (const float*)a.in[10]; const float* mla_w_uq = (const float*)a.in[11];
        const float* mla_w_ukv = (const float*)a.in[12]; const float* w_out_even = (const float*)a.in[14]; const float* w_in_odd = (const float*)a.in[15];
        const float* cmp_pos_k = (const float*)a.in[16]; const float* cmp_pos_v = (const float*)a.in[17]; const float* cmp_w1_k = (const float*)a.in[18]; const float* cmp_w1_v = (const float*)a.in[20]; const float* w_out_odd = (const float*)a.in[22];
        float* rstdm = (float*)(ws + WS_RSTDM); int2* pmm = (int2*)(ws + WS_PMM); int2* cpmm = pmm + 128; int* cpos = (int*)(ws + WS_CPOS);
        float2* rope = (float2*)(ws + WS_ROPE); float* lut = (float*)(ws + WS_LUT); float* pb = (float*)(ws + WS_PB);
        bf16_t* WINE = (bf16_t*)(ws + WS_WINE); bf16_t* WINO = (bf16_t*)(ws + WS_WINO); bf16_t* WOUTE = (bf16_t*)(ws + WS_WOUTE); bf16_t* WOUTO = (bf16_t*)(ws + WS_WOUTO);
        bf16_t* WMKV = (bf16_t*)(ws + WS_WMKV); bf16_t* WUP = (bf16_t*)(ws + WS_WUP); bf16_t* WC1 = (bf16_t*)(ws + WS_WC1); bf16_t* MEMB = (bf16_t*)(ws + WS_MEMB);
        LAS float* scr = (LAS float*)(lds + wid * 16384);
        constexpr int I0 = 1664, I1 = 1536, I2 = 768, I3 = 512, I4 = 512, I5 = 224, I6 = 256;
        constexpr int S1 = 2 * I0, S2 = S1 + 2 * I1, S3 = S2 + 2 * I2, S4 = S3 + 2 * I3, S5 = S4 + 4 * I4, S6 = S5 + 2 * I5, S7 = S6 + 4 * I6;
        for (int it = gw; it < S7; it += NGW) {
            if (it < S1) { const int e = it / I0, r = it % I0; const float* W = w_in_even + (size_t)e * DM * 3232; const float* gn = norm_pre + (2 * e) * DM;
                conv_item([&](int k, int n, float& mul) -> const float* { float sc; const int s = map_even(n, sc); mul = sc * gn[k]; return s < 0 ? nullptr : W + (size_t)k * 3232 + s; }, DM, WINE + (size_t)e * PE * DM, scr, r, PE / 32, lane); }
            else if (it < S2) { const int e = (it - S1) / I1, r = (it - S1) % I1; const float* W = w_in_odd + (size_t)e * DM * 2840; const float* gn = norm_pre + (2 * e + 1) * DM;
                conv_item([&](int k, int n, float& mul) -> const float* { float sc; const int s = map_odd(n, sc); mul = sc * gn[k]; return s < 0 ? nullptr : W + (size_t)k * 2840 + s; }, DM, WINO + (size_t)e * PO * DM, scr, r, PO / 32, lane); }
            else if (it < S3) { const int e = (it - S2) / I2, r = (it - S2) % I2; const float* W = w_out_even + (size_t)e * 1536 * DM;
                conv_item([&](int k, int n, float& mul) -> const float* { mul = 1.f; return W + (size_t)k * DM + n; }, 1536, WOUTE + (size_t)e * DM * 1536, scr, r, DM / 32, lane); }
            else if (it < S4) { const int e = (it - S3) / I3, r = (it - S3) % I3; const float* W = w_out_odd + (size_t)e * DM * DM;
                conv_item([&](int k, int n, float& mul) -> const float* { mul = 1.f; return W + (size_t)k * DM + n; }, DM, WOUTO + (size_t)e * DM * DM, scr, r, DM / 32, lane); }
            else if (it < S5) { const int l = (it - S4) / I4, r = (it - S4) % I4; const float* W = w_mem_kv + (size_t)l * DM * DM; const float* gn = mem_norm + l * DM;
                conv_item([&](int k, int n, float& mul) -> const float* { mul = gn[k]; return W + (size_t)k * DM + n; }, DM, WMKV + (size_t)l * DM * DM, scr, r, DM / 32, lane); }
            else if (it < S6) { const int e = (it - S5) / I5, r = (it - S5) % I5; const float* Wq = mla_w_uq + (size_t)e * 256 * 768; const float* Wk = mla_w_ukv + (size_t)e * 128 * 1024;
                const float* gq = mla_q_norm + e * 256; const float* gk = mla_kv_norm + e * 128;
                conv_item([&](int k, int n, float& mul) -> const float* {
                    if (n < 768) { const int h = n / 96, j = n % 96; const int s = (j < 64) ? n : h * 96 + 64 + (((j - 64) & 1) ? ((j - 64) >> 1) + 16 : ((j - 64) >> 1));
                        mul = (0.10206207261596575f * LOG2E) * gq[k]; return Wq + (size_t)k * 768 + s; }
                    if (k >= 128) { mul = 0.f; return nullptr; } mul = gk[k]; return Wk + (size_t)k * 1024 + (n - 768); }, 256, WUP + (size_t)e * QKVW * 256, scr, r, QKVW / 32, lane); }
            else { const int m4 = (it - S6) / I6, r = (it - S6) % I6; const float* W = ((m4 & 1) ? cmp_w1_v : cmp_w1_k) + (size_t)(m4 >> 1) * 2048 * 256;
                conv_item([&](int k, int n, float& mul) -> const float* { mul = 1.f; return W + (size_t)k * 256 + n; }, 2048, WC1 + (size_t)m4 * 256 * 2048, scr, r, 256 / 32, lane); }
        }
        for (int row = gw; row < T + NB * MEML; row += NGW) {
            const bool isx = row < T; const int r = isx ? row : row - T; const float* src = (isx ? x : mem) + (size_t)r * DM; bf16_t* dst = (isx ? XB : MEMB) + (size_t)r * DM;
            float s = 0.f; f32x4 va[2], vb[2];
#pragma unroll
            for (int jj = 0; jj < 2; ++jj) { va[jj] = __builtin_nontemporal_load((const f32x4*)(src + 8 * (lane + 64 * jj))); vb[jj] = __builtin_nontemporal_load((const f32x4*)(src + 8 * (lane + 64 * jj) + 4)); }
#pragma unroll
            for (int jj = 0; jj < 2; ++jj) { const f32x4 v = va[jj], u = vb[jj]; s += ((v[0] * v[0] + v[1] * v[1]) + (v[2] * v[2] + v[3] * v[3])) + ((u[0] * u[0] + u[1] * u[1]) + (u[2] * u[2] + u[3] * u[3]));
                u32x4 w; w.x = pk2(v[0], v[1]); w.y = pk2(v[2], v[3]); w.z = pk2(u[0], u[1]); w.w = pk2(u[2], u[3]); *(u32x4*)(dst + 8 * (lane + 64 * jj)) = w; }
            s = wave_sum(s);
            if (lane == 0) { if (isx) ssqx[r] = s; else rstdm[r] = rsqrtf(s * (1.f / DM) + EPS); }
        }
        for (int idx = bx * (NWAVES * 64) + tid; idx < S * 16; idx += G * NWAVES * 64) {
            { const int s = idx >> 4, i = idx & 15; const float inv = powf(10000.0f, -(float)i / 16.0f); const float ang = (float)pos[s] * inv; float sn, cs; sincosf(ang, &sn, &cs); rope[idx] = make_float2(cs, sn); }
            if (idx < 8 * 132) { const int h = idx / 132, d = idx % 132; int bucket;
                if (d < 16) bucket = d; else { const float lr = logf((float)d / 16.0f) / logf(8.0f); const int lg = 16 + (int)(lr * 16.0f); bucket = lg < 31 ? lg : 31; }
                lut[idx] = table[bucket * 8 + h] * LOG2E; }
            if (idx < 128) { int mn = pos[idx * 64], mx = mn; for (int i = 1; i < 64; ++i) { const int p = pos[idx * 64 + i]; mn = p < mn ? p : mn; mx = p > mx ? p : mx; } pmm[idx] = make_int2(mn, mx); }
            if (idx < 512) { const int tk = 16 * idx + 31; cpos[idx] = pos[tk < S ? tk : S - 1]; }
            if (idx < 8) { int mn = 0x7fffffff, mx = -0x7fffffff; for (int i = 0; i < 64; ++i) { const int tk = 16 * (idx * 64 + i) + 31; const int p = pos[tk < S ? tk : S - 1]; mn = p < mn ? p : mn; mx = p > mx ? p : mx; } cpmm[idx] = make_int2(mn, mx); }
        }
        for (int it = gw; it < 256; it += NGW) { const int kc = it >> 4, m4 = (it >> 2) & 3, n = (it & 3) * 64 + lane;
            const float* pe = ((m4 & 1) ? cmp_pos_v : cmp_pos_k) + (size_t)(m4 >> 1) * 2048 + kc * 128; const float* w = ((m4 & 1) ? cmp_w1_v : cmp_w1_k) + (size_t)(m4 >> 1) * 2048 * 256 + (size_t)kc * 128 * 256 + n;
            float s0 = 0.f, s1 = 0.f, s2 = 0.f, s3 = 0.f;
#pragma unroll 8
            for (int k = 0; k < 128; k += 4) { s0 += pe[k] * w[(size_t)k * 256]; s1 += pe[k + 1] * w[(size_t)(k + 1) * 256]; s2 += pe[k + 2] * w[(size_t)(k + 2) * 256]; s3 += pe[k + 3] * w[(size_t)(k + 3) * 256]; }
            pb[(kc * 4 + m4) * 256 + n] = (s0 + s1) + (s2 + s3); }
        SEAM(0);
    }
    if (SITE(1) && IN(1)) {
        WSB(); bf16_t* MEMB = (bf16_t*)(ws + WS_MEMB); bf16_t* WMKV = (bf16_t*)(ws + WS_WMKV); bf16_t* MKV = (bf16_t*)(ws + WS_MKV); float* rstdm = (float*)(ws + WS_RSTDM);
        pg8::Gemm g{MEMB, WMKV, DM, DM * 2, DM * 2, 128, 0}; pg8::StaticOrder SO; SO.init(NB * MEML / 256, 4096 / 256, G, bx);
        pg8::EpiStore E{MKV, rstdm, nullptr, 4096};
        pg8::gemm_phase<pg8::EpiStore, pg8::StaticOrder, true, true>(lds, g, SO, E, wid);
        __syncthreads();
    }
    for (int pr = 0; pr < 2; ++pr) {
        const int base = 2 + pr * 11;
        if (SITE(2) && IN(base + 0)) {
            WSB(); PTR_STATS(); PTR_ACT(); bf16_t* WINE = (bf16_t*)(ws + WS_WINE); const float2* rope = (const float2*)(ws + WS_ROPE);
            pg8::Gemm g{XB, WINE + (size_t)pr * PE * DM, DM, DM * 2, DM * 2, 128, 0}; pg8::StaticOrder SO; SO.init(T / 256, PE / 256, G, bx);
            pg8::EpiWin E{PROJ, ssqx, rope, ssqq, ssqkv, PE, 0};
            if (bx & 1) { __builtin_amdgcn_s_sleep(127); __builtin_amdgcn_s_sleep(127); }
            pg8::gemm_phase<pg8::EpiWin, pg8::StaticOrder, true, true, 2>(lds, g, SO, E, wid);
            SEAM(base + 0);
        }
        if (SITE(3) && IN(base + 1)) {
            WSB(); PTR_STATS(); PTR_ACT(); bf16_t* WUP = (bf16_t*)(ws + WS_WUP); const float2* rope = (const float2*)(ws + WS_ROPE);
            pg8::Gemm g{PROJ, WUP + (size_t)pr * QKVW * 256, 256, PE * 2, 256 * 2, 128, 3}; pg8::StaticOrder SO; SO.init(T / 256, QKVW / 256, G, bx);
            pg8::EpiUp E{QKV, ssqq, ssqkv, rope};
            pg8::gemm_phase<pg8::EpiUp, pg8::StaticOrder, true, true>(lds, g, SO, E, wid);
            SEAM(base + 1);
        }
        if (SITE(4) && IN(base + 2)) {
            WSB(); PTR_ACT(); const int* pos = (const int*)a.in[2]; const float* swa_sinks = (const float*)a.in[13]; bf16_t* MKV = (bf16_t*)(ws + WS_MKV); bf16_t* KC = (bf16_t*)(ws + WS_KC); bf16_t* VC = (bf16_t*)(ws + WS_VC);
            const int2* pmm = (const int2*)(ws + WS_PMM); const int2* cpmm = pmm + 128; const int* cpos = (const int*)(ws + WS_CPOS);
            STAGE_LUT();
            const att::Ptrs P{PROJ, QKV, MKV, KC, VC, ATT, pos, cpos, pmm, cpmm, swa_sinks + pr * 8, 2 * pr};
            unsigned* head = ctl + CW_Q + (pr * 2 + 0) * 512 + a.li * 16;
            Q_INIT();
            for (;;) { int u, xq; Q_NEXT(head, 512, u, xq); if (u < 0) break;
                if (u < 128) { const int bh = xq + 8 * (u >> 4); if (MK_UNITS & 1) att::unit_mla2((LAS char*)lds, P, bh >> 3, bh & 7, 15 - (u & 15), tid, lane, wid); }
                else if (u < 256) { const int v = u - 128, bh = xq + 8 * (v >> 5); if (MK_UNITS & 2) att::unit_mem((LAS char*)lds, P, bh >> 2, bh & 3, v & 31, PE, E_QMEM, E_GMEM, 1536, 1024, tid, lane, wid); }
                else { const int v = u - 256, bg = xq + 8 * (v >> 7); if (MK_UNITS & 4) att::unit_swa((LAS char*)lds, P, bg >> 1, bg & 1, 127 - (v & 127), tid, lane, wid); } }
            SEAM(base + 2);
        }
        if (SITE(5) && IN(base + 3)) {
            WSB(); PTR_STATS(); PTR_ACT(); bf16_t* WOUTE = (bf16_t*)(ws + WS_WOUTE);
            pg8::Gemm g{ATT, WOUTE + (size_t)pr * DM * 1536, 1536, 1536 * 2, 1536 * 2, 128, 0}; pg8::StaticOrder SO; SO.init(T / 256, DM / 256, G, bx);
            pg8::EpiStore E{Y, nullptr, ssqy, DM};
            pg8::gemm_phase<pg8::EpiStore, pg8::StaticOrder, true, true>(lds, g, SO, E, wid);
            SEAM(base + 3);
        }
#define RP_LD(Y0, Y1, X0, X1, SQ, ROW) { const size_t o_ = (size_t)(ROW) * DM + 8 * lane; Y0 = __builtin_nontemporal_load((const u32x4*)(Y + o_)); Y1 = __builtin_nontemporal_load((const u32x4*)(Y + o_ + 512)); X0 = __builtin_nontemporal_load((const u32x4*)(xh_ + o_)); X1 = __builtin_nontemporal_load((const u32x4*)(xh_ + o_ + 512));     SQ = ssqy[(size_t)(ROW) * 16 + (lane & 15)]; }
#define RP_ROW(W_, Y0, Y1, X0, X1, SQ, ROW, S2) { const float rs = rsqrtf(row16_sum(SQ) * (1.f / DM) + EPS); const size_t so_ = (size_t)(ROW) * DM + 8 * lane; f32x4 ra0_, ra1_, rb0_, rb1_; \
                    S2 = resid_run<W_>(Y0, X0, gv_[0], gv_[1], rs, ra0_, ra1_); S2 += resid_run<W_>(Y1, X1, gv_[2], gv_[3], rs, rb0_, rb1_); \
                    if (W_) { __builtin_nontemporal_store(ra0_, (f32x4*)(of_ + so_)); __builtin_nontemporal_store(ra1_, (f32x4*)(of_ + so_ + 4)); __builtin_nontemporal_store(rb0_, (f32x4*)(of_ + so_ + 512)); __builtin_nontemporal_store(rb1_, (f32x4*)(of_ + so_ + 516)); }     \
                    else { *(f32x4*)(oh_ + so_) = ra0_; *(f32x4*)(oh_ + so_ + 512) = rb0_; } }
#define RESID2(L, XINP, WF32, XOUTP) do { const float* gp_ = norm_post + (L) * DM; const bf16_t* xh_ = (const bf16_t*)(XINP); float* of_ = (float*)(XOUTP); bf16_t* oh_ = (bf16_t*)(XOUTP); \
            f32x4 gv_[4]; _Pragma("unroll") for (int j = 0; j < 4; ++j) gv_[j] = *(const f32x4*)(gp_ + 8 * (lane + 64 * (j >> 1)) + 4 * (j & 1)); \
            for (int row = gw; row < T; row += 2 * NGW) { const int rowb = row + NGW;     \
                u32x4 ay0_, ay1_, ax0_, ax1_, by0_, by1_, bx0_, bx1_; float as_, bs_, s2a_, s2b_ = 0.f; const bool hb_ = rowb < T; \
                RP_LD(ay0_, ay1_, ax0_, ax1_, as_, row) RP_LD(by0_, by1_, bx0_, bx1_, bs_, (hb_ ? rowb : row))     \
                RP_ROW(WF32, ay0_, ay1_, ax0_, ax1_, as_, row, s2a_) if (hb_) RP_ROW(WF32, by0_, by1_, bx0_, bx1_, bs_, rowb, s2b_) \
                s2a_ = wave_sum(s2a_); s2b_ = wave_sum(s2b_); if (lane == 0) { ssqx[row] = s2a_; if (hb_) ssqx[rowb] = s2b_; } } } while (0)
        if (SITE(6) && IN(base + 4)) { WSB(); PTR_STATS(); PTR_ACT(); const float* norm_post = (const float*)a.in[5]; RESID2(2 * pr, out, false, ws + WS_XR); SEAM(base + 4); }
        if (SITE(7) && IN(base + 5)) {
            WSB(); PTR_STATS(); PTR_ACT(); bf16_t* WINO = (bf16_t*)(ws + WS_WINO); const float2* rope = (const float2*)(ws + WS_ROPE);
            pg8::Gemm g{(bf16_t*)(ws + WS_XR), WINO + (size_t)pr * PO * DM, DM, DM * 2, DM * 2, 128, 0}; pg8::StaticOrder SO; SO.init(T / 256, PO / 256, G, bx);
            pg8::EpiWin E{PROJ, ssqx, rope, ssqq, ssqkv, PO, 1};
            if (bx & 1) { __builtin_amdgcn_s_sleep(127); __builtin_amdgcn_s_sleep(127); }
            pg8::gemm_phase<pg8::EpiWin, pg8::StaticOrder, true, true, 1>(lds, g, SO, E, wid);
            SEAM(base + 5);
        }
        if (SITE(8) && IN(base + 6)) { WSB(); PTR_ACT(); bf16_t* WC1 = (bf16_t*)(ws + WS_WC1); bf16_t* PART = (bf16_t*)(ws + WS_C);
            pg8::Gemm gk{PROJ + O_KCMP, WC1 + (size_t)(pr * 2) * 256 * 2048, 512, 16 * PO * 2, 2048 * 2, PO * 2, 2}; pg8::StaticOrder S1; S1.init(256, 1, G, bx);
            pg8::EpiPart Ek{PART};
            pg8::gemm_phase<pg8::EpiPart, pg8::StaticOrder, true, true>(lds, gk, S1, Ek, wid);
            SEAM(base + 6);
        }
        if (SITE(9) && IN(base + 7)) { WSB(); const bf16_t* PART = (const bf16_t*)(ws + WS_C); bf16_t* KC = (bf16_t*)(ws + WS_KC); bf16_t* VC = (bf16_t*)(ws + WS_VC); const float* pb = (const float*)(ws + WS_PB) + pr * 512;     const float* cmp_w2_k = (const float*)a.in[19]; const float* cmp_w2_v = (const float*)a.in[21];
            LAS bf16_t* w2t = (LAS bf16_t*)lds; LAS float* bsum = (LAS float*)(lds + 2 * 64 * 264 * 2);
            const float* w2k = cmp_w2_k + (size_t)pr * 256 * 64; const float* w2v = cmp_w2_v + (size_t)pr * 256 * 64;
            for (int i = tid; i < 2 * 256 * 64; i += NWAVES * 64) { const int kv_ = i >> 14, r_ = i & 16383, k_ = r_ >> 6, n_ = r_ & 63; w2t[(kv_ * 64 + n_) * 264 + k_] = f2bf((kv_ ? w2v : w2k)[r_]); }
            if (tid < 512) { const int kv_ = tid >> 8, k_ = tid & 255; float s_ = 0.f;
                for (int kc = 0; kc < 16; ++kc) s_ += pb[(kc * 4 + kv_) * 256 + k_];
                bsum[tid] = s_; }
            __syncthreads();
            if (wid < 4) { const int it = wid * 256 + bx;
                const int kv = it >> 9, row = 16 * (it & 511) + (lane & 15), kg = lane >> 4;
                const bf16_t* pp = PART + ((size_t)kv * 4 * 8192 + row) * 256 + 8 * kg; const LAS float* bp = bsum + kv * 256 + 8 * kg;
                const LAS bf16_t* wa = w2t + (size_t)(kv * 64 + (lane & 15)) * 264 + 8 * kg;
                f32x4 acc[4] = {{0.f, 0.f, 0.f, 0.f}, {0.f, 0.f, 0.f, 0.f}, {0.f, 0.f, 0.f, 0.f}, {0.f, 0.f, 0.f, 0.f}};
#pragma unroll 2
                for (int st = 0; st < 8; ++st) { const bf16_t* p0_ = pp + 32 * st;
                    const u32x4 aw = __builtin_nontemporal_load((const u32x4*)p0_), bw = __builtin_nontemporal_load((const u32x4*)(p0_ + (size_t)8192 * 256)), cw = __builtin_nontemporal_load((const u32x4*)(p0_ + (size_t)2 * 8192 * 256)), dw = __builtin_nontemporal_load((const u32x4*)(p0_ + (size_t)3 * 8192 * 256));
#define O2B_LO(W_) ((f32x4){__uint_as_float(W_.x << 16), __uint_as_float(W_.x & 0xffff0000u), __uint_as_float(W_.y << 16), __uint_as_float(W_.y & 0xffff0000u)})
#define O2B_HI(W_) ((f32x4){__uint_as_float(W_.z << 16), __uint_as_float(W_.z & 0xffff0000u), __uint_as_float(W_.w << 16), __uint_as_float(W_.w & 0xffff0000u)})
                    f32x4 h0 = ((O2B_LO(aw) + O2B_LO(bw)) + (O2B_LO(cw) + O2B_LO(dw))) + *(const LAS f32x4*)(bp + 32 * st), h1 = ((O2B_HI(aw) + O2B_HI(bw)) + (O2B_HI(cw) + O2B_HI(dw))) + *(const LAS f32x4*)(bp + 32 * st + 4);
#undef O2B_LO
#undef O2B_HI
#pragma unroll
                    for (int i = 0; i < 4; ++i) { h0[i] = silu_f(h0[i]); h1[i] = silu_f(h1[i]); }
                    u32x4 hw; hw.x = pk2(h0[0], h0[1]); hw.y = pk2(h0[2], h0[3]); hw.z = pk2(h1[0], h1[1]); hw.w = pk2(h1[2], h1[3]);
                    const bf16x8 hb = __builtin_bit_cast(bf16x8, hw);
#pragma unroll
                    for (int blk = 0; blk < 4; ++blk) { const bf16x8 wf = *(const LAS bf16x8*)(wa + (size_t)blk * 16 * 264 + 32 * st);
                        acc[blk] = __builtin_amdgcn_mfma_f32_16x16x32_bf16(wf, hb, acc[blk], 0, 0, 0); } }
                bf16_t* op = (kv ? VC : KC) + (size_t)row * 64 + 4 * kg; const bool zr = (row & 511) == 511;
#pragma unroll
                for (int blk = 0; blk < 4; ++blk) { u32x2 w; w.x = zr ? 0u : pk2(acc[blk][0], acc[blk][1]); w.y = zr ? 0u : pk2(acc[blk][2], acc[blk][3]); *(u32x2*)(op + 16 * blk) = w; } }
            __syncthreads();
            SEAM(base + 7);
        }
        if (SITE(10) && IN(base + 8)) {
            WSB(); PTR_ACT(); const int* pos = (const int*)a.in[2]; const float* swa_sinks = (const float*)a.in[13]; bf16_t* MKV = (bf16_t*)(ws + WS_MKV); bf16_t* KC = (bf16_t*)(ws + WS_KC); bf16_t* VC = (bf16_t*)(ws + WS_VC);
            const int2* pmm = (const int2*)(ws + WS_PMM); const int2* cpmm = pmm + 128; const int* cpos = (const int*)(ws + WS_CPOS);
            STAGE_LUT();
            const att::Ptrs P{PROJ, QKV, MKV, KC, VC, ATT, pos, cpos, pmm, cpmm, swa_sinks, 2 * pr + 1};
            unsigned* head = ctl + CW_Q + (pr * 2 + 1) * 512 + a.li * 16;
            Q_INIT();
            for (;;) { int u, xq; Q_NEXT(head, 384, u, xq); if (u < 0) break;
                if (u < 256) { const int bg = xq + 8 * (u >> 7); if (MK_UNITS & 8) att::unit_nsa((LAS char*)lds, P, bg >> 1, bg & 1, 127 - (u & 127), tid, lane, wid); }
                else { const int v = u - 256, bh = xq + 8 * (v >> 5); if (MK_UNITS & 2) att::unit_mem((LAS char*)lds, P, bh >> 2, bh & 3, v & 31, PO, O_QMEM, O_GMEM, 1024, 512, tid, lane, wid); } }
            SEAM(base + 8);
        }
        if (SITE(11) && IN(base + 9)) {
            WSB(); PTR_STATS(); PTR_ACT(); bf16_t* WOUTO = (bf16_t*)(ws + WS_WOUTO);
            pg8::Gemm g{ATT, WOUTO + (size_t)pr * DM * DM, DM, DM * 2, DM * 2, 128, 0}; pg8::StaticOrder SO; SO.init(T / 256, DM / 256, G, bx);
            pg8::EpiStore E{Y, nullptr, ssqy, DM};
            pg8::gemm_phase<pg8::EpiStore, pg8::StaticOrder, true, true>(lds, g, SO, E, wid);
            SEAM(base + 9);
        }
        if (SITE(12) && IN(base + 10)) { WSB(); PTR_STATS(); PTR_ACT(); const float* norm_post = (const float*)a.in[5]; if (pr == 0) RESID2(1, ws + WS_XR, false, out); else RESID2(3, ws + WS_XR, true, out); SEAM(base + 10); }
    }
}

extern "C" void kernel_launch(void* const* d_in, const int* in_sizes, int n_in, void* d_out, int out_size, void* d_ws, size_t ws_size, hipStream_t stream) {
    static int ready = 0;
    if (ready == 0) {
        if (n_in != 23 || ws_size < WS_END) { fprintf(stderr, "kernel_launch: unexpected problem (n_in %d, ws %zu)\n", n_in, ws_size); ready = -1; return; }
        if (hipFuncSetAttribute((const void*)mega, hipFuncAttributeMaxDynamicSharedMemorySize, LDS_BYTES) != hipSuccess) { fprintf(stderr, "kernel_launch: hipFuncSetAttribute failed\n"); ready = -1; return; }
        int nb = 0, dev = 0, ncu = 0;
        if (hipOccupancyMaxActiveBlocksPerMultiprocessor(&nb, (const void*)mega, NWAVES * 64, LDS_BYTES) != hipSuccess) nb = 0;
        if (hipGetDevice(&dev) != hipSuccess || hipDeviceGetAttribute(&ncu, hipDeviceAttributeMultiprocessorCount, dev) != hipSuccess) ncu = 0;
        (void)hipGetLastError();
        ready = ((long)nb * ncu >= 256) ? 1 : 2;
    }
    if (ready < 0) return;
    (void)hipMemsetAsync((char*)d_ws + WS_CTL, 0, CTL_BYTES, stream);
    Args a{};
    for (int i = 0; i < 23; ++i) a.in[i] = d_in[i];
    a.out = (float*)d_out; a.ws = (unsigned char*)d_ws;
    const int grid = 256;
#if MK_PER_PHASE
    for (int p = 0; p < N_PHASES; ++p) { a.ph_lo = p; a.ph_hi = p + 1; hipLaunchKernelGGL(mega, dim3(grid), dim3(NWAVES * 64), LDS_BYTES, stream, a); }
#elif defined(MK_PROBE)
    a.ph_lo = 0; a.ph_hi = MK_PROBE + 1; a.li = 0; hipLaunchKernelGGL(mega, dim3(grid), dim3(NWAVES * 64), LDS_BYTES, stream, a);
    a.ph_lo = MK_PROBE; a.ph_hi = MK_PROBE + 1; a.li = 1; hipLaunchKernelGGL(mega, dim3(grid), dim3(NWAVES * 64), LDS_BYTES, stream, a);
    if (MK_PROBE + 1 < N_PHASES) { a.ph_lo = MK_PROBE + 1; a.ph_hi = N_PHASES; a.li = 2; hipLaunchKernelGGL(mega, dim3(grid), dim3(NWAVES * 64), LDS_BYTES, stream, a); }
#else
    if (ready == 1) { a.ph_lo = 0; a.ph_hi = N_PHASES; hipLaunchKernelGGL(mega, dim3(grid), dim3(NWAVES * 64), LDS_BYTES, stream, a); }
    else for (int p = 0; p < N_PHASES; ++p) { a.ph_lo = p; a.ph_hi = p + 1; hipLaunchKernelGGL(mega, dim3(grid), dim3(NWAVES * 64), LDS_BYTES, stream, a); }
#endif
}
```
